# Optimizing an MI355X kernel written in HIP

```python
import jax, jax.numpy as jnp
from jax import lax
import numpy as np

D_MODEL = 2048
BATCH = 4
SEQ = 8192
DEPTH = 1

GRID_W = 64
CTX_LEN = 256
NH_A = 8
DK_A = 128
DV_A = 256
QK_A = NH_A * DK_A
V_A = NH_A * DV_A
CONV_W = 3
CHUNK = 64
M_INIT = -1e30
NH_B = 16
NKV_B = 4
HD_B = 128
Q_B = NH_B * HD_B
KV_B = NKV_B * HD_B
ROT_HALF = HD_B // 2
ROPE_THETA = 10000.0
Q_BLOCK = 128
EPS = 1e-6
ALPHA = (2 * DEPTH) ** 0.25
BETA = (8 * DEPTH) ** -0.25
KV_WIDTHS = (2 * QK_A, V_A, 4 * NH_A, KV_B, KV_B)
N_KV = 2 * QK_A + V_A + 4 * NH_A + 2 * KV_B
OUT_WIDTHS = (V_A, V_A, Q_B, Q_B, 2 * D_MODEL)
N_IN = N_KV + 2 * V_A + 2 * Q_B + 2 * D_MODEL

kernel_name = "hybrid_mlstm_gqa_dit_block"


def _split(p, widths, start=0):
    outs = []
    off = start
    for w in widths:
        outs.append(p[..., off:off + w])
        off += w
    return outs


def layer_norm(x, w=None, b=None):
    xf = x.astype(jnp.float32)
    mu = xf.mean(-1, keepdims=True)
    var = jnp.mean(jnp.square(xf - mu), -1, keepdims=True)
    y = (xf - mu) * lax.rsqrt(var + EPS)
    if w is not None:
        y = y * w.astype(jnp.float32) + b.astype(jnp.float32)
    return y.astype(x.dtype)


def rms_norm(x, w):
    xf = x.astype(jnp.float32)
    y = xf * lax.rsqrt(jnp.mean(jnp.square(xf), -1, keepdims=True) + EPS)
    return (y * w.astype(jnp.float32)).astype(x.dtype)


def dwconv_centred(x, w, b):
    T = x.shape[1]
    pad = CONV_W // 2
    xp = jnp.pad(x, ((0, 0), (pad, CONV_W - 1 - pad), (0, 0)))
    y = b
    for j in range(CONV_W):
        y = y + xp[:, j:j + T] * w[j]
    return y


def rope_tables(n):
    rows_n = n // GRID_W
    row = jnp.repeat(jnp.arange(rows_n), GRID_W).astype(jnp.float32)
    col = jnp.tile(jnp.arange(GRID_W), rows_n).astype(jnp.float32)
    inv = ROPE_THETA ** (-jnp.arange(0, ROT_HALF, 2, dtype=jnp.float32) / ROT_HALF)
    ang_r = row[:, None] * inv[None]
    ang_c = col[:, None] * inv[None]
    return (jnp.cos(ang_r), jnp.sin(ang_r), jnp.cos(ang_c), jnp.sin(ang_c))


def _rot(xh, cos, sin):
    h = xh.shape[-1] // 2
    x1, x2 = xh[..., :h], xh[..., h:]
    cos = cos[None, :, None, :]
    sin = sin[None, :, None, :]
    return jnp.concatenate([x1 * cos - x2 * sin, x1 * sin + x2 * cos], axis=-1)


def apply_rope_2d(x, rope):
    cr, sr, cc, sc = rope
    xf = x.astype(jnp.float32)
    y = jnp.concatenate([_rot(xf[..., :ROT_HALF], cr, sr),
                         _rot(xf[..., ROT_HALF:], cc, sc)], axis=-1)
    return y.astype(x.dtype)


def zero_state(b):
    return (jnp.zeros((b, NH_A, DV_A, DK_A), jnp.float32),
            jnp.zeros((b, NH_A, DK_A), jnp.float32),
            jnp.full((b, NH_A), M_INIT, jnp.float32))


def mlstm_chunked(q, k, v, log_i, log_f, state):
    B, T, H, _ = q.shape
    nc = T // CHUNK

    def to_chunks(a):
        a = a.reshape((B, nc, CHUNK, H) + a.shape[3:])
        return jnp.moveaxis(a, (1, 3), (0, 2))

    tril = jnp.tril(jnp.ones((CHUNK, CHUNK), bool))

    def step(carry, xs):
        C0, n0, m0 = carry
        qc, kc, vc, ic, fc = xs
        b = jnp.cumsum(fc, axis=-1)
        d = jnp.where(tril, b[..., :, None] - b[..., None, :] + ic[..., None, :], -jnp.inf)
        m_inter = b + m0[..., None]
        m = jnp.maximum(m_inter, d.max(-1))
        w = jnp.exp(d - m[..., None])
        a = jnp.exp(m_inter - m)
        s = jnp.einsum('bhjd,bhsd->bhjs', qc, kc) * w
        num = (a[..., None] * jnp.einsum('bhvd,bhjd->bhjv', C0, qc)
               + jnp.einsum('bhjs,bhsv->bhjv', s, vc))
        den = a * jnp.einsum('bhd,bhjd->bhj', n0, qc) + s.sum(-1)
        h = num / jnp.maximum(jnp.abs(den), jnp.exp(-m))[..., None]
        m_end = m[..., -1]
        w_end = jnp.exp(b[..., -1:] - b + ic - m_end[..., None])
        a_end = a[..., -1]
        C = a_end[..., None, None] * C0 + jnp.einsum('bhs,bhsv,bhsd->bhvd', w_end, vc, kc)
        n = a_end[..., None] * n0 + jnp.einsum('bhs,bhsd->bhd', w_end, kc)
        return (C, n, m_end), h

    xs = tuple(to_chunks(a) for a in (q, k, v, log_i, log_f))
    state, h = lax.scan(step, state, xs)
    h = jnp.moveaxis(h, (0, 2), (1, 3)).reshape(B, T, H, v.shape[-1])
    return h, state


def mlstm_final_state(k, v, log_i, log_f):
    b = jnp.cumsum(log_f, axis=1)
    g = b[:, -1:] - b + log_i
    m = g.max(axis=1)
    w = jnp.exp(g - m[:, None])
    C = jnp.einsum('bth,bthv,bthd->bhvd', w, v, k)
    n = jnp.einsum('bth,bthd->bhd', w, k)
    return (C, n, m)


def _flip(*arrs):
    return [jnp.flip(a, axis=1) for a in arrs]


def mlstm_inputs(qk_pre, v_a, if_a, conv_w, conv_b, b_if):
    B, T = v_a.shape[:2]
    qk = jax.nn.silu(dwconv_centred(qk_pre, conv_w, conv_b)).astype(jnp.float32)
    q = qk[..., :QK_A].reshape(B, T, NH_A, DK_A)
    k = qk[..., QK_A:].reshape(B, T, NH_A, DK_A) * (DK_A ** -0.5)
    v = v_a.astype(jnp.float32).reshape(B, T, NH_A, DV_A)
    gt = (if_a + b_if).astype(jnp.float32).reshape(B, T, 4, NH_A)
    fwd = (gt[:, :, 0], jax.nn.log_sigmoid(gt[:, :, 1]))
    bwd = (gt[:, :, 2], jax.nn.log_sigmoid(gt[:, :, 3]))
    return q, k, v, fwd, bwd


def attn_kv(k_b, v_b, k_norm_w, rope):
    B, T = k_b.shape[:2]
    k = rms_norm(k_b.reshape(B, T, NKV_B, HD_B), k_norm_w)
    if rope is not None:
        k = apply_rope_2d(k, rope)
    return k, v_b.reshape(B, T, NKV_B, HD_B)


def attend_blocks(q, k_all, v_all):
    B, S = q.shape[:2]
    G = NH_B // NKV_B
    nb = S // Q_BLOCK
    qb = q.reshape(B, nb, Q_BLOCK, NKV_B, G, HD_B).transpose(1, 0, 2, 3, 4, 5)
    scale = HD_B ** -0.5

    def one(qblk):
        s = jnp.einsum('bqkgd,btkd->bkgqt', qblk, k_all).astype(jnp.float32) * scale
        p = jax.nn.softmax(s, axis=-1).astype(v_all.dtype)
        return jnp.einsum('bkgqt,btkd->bqkgd', p, v_all)

    o = lax.map(one, qb)
    return o.transpose(1, 0, 2, 3, 4, 5).reshape(B, S, Q_B)


def branch_merge(h_a, o_attn, o_a, z_a, z_b, g_logits, mh_norm_w, w_ba, w_bb, w_out):
    B, T = h_a.shape[:2]
    h = rms_norm(h_a, mh_norm_w.reshape(NH_A, DV_A)).reshape(B, T, V_A)
    y_a = (jax.nn.sigmoid(o_a) * h * jax.nn.silu(z_a)) @ w_ba
    y_b = (o_attn * jax.nn.silu(z_b)) @ w_bb
    g_a, g_b = jnp.split(g_logits, 2, axis=-1)
    return (jax.nn.sigmoid(g_a) * y_a + jax.nn.sigmoid(g_b) * y_b) @ w_out


def trunk_layer(x, ctx, c, c_ctx, rope, w_mod, b_mod, w_in, b_if, conv_w, conv_b,
                mh_norm_w, q_norm_w, k_norm_w, w_ba, w_bb, w_out, ln_w, ln_b, update_ctx):
    B, S = x.shape[:2]
    T_c = ctx.shape[1]
    shift, scale, gate = [m[:, None, :] for m in jnp.split(jax.nn.silu(c) @ w_mod + b_mod, 3, axis=-1)]
    shift_c, scale_c, gate_c = jnp.split(jax.nn.silu(c_ctx) @ w_mod + b_mod, 3, axis=-1)
    u = layer_norm(x) * (1 + scale) + shift
    u_c = layer_norm(ctx) * (1 + scale_c) + shift_c
    p = u @ w_in
    p_c = u_c @ (w_in if update_ctx else w_in[:, :N_KV])

    qk_c, va_c, if_c, kb_c, vb_c = _split(p_c, KV_WIDTHS)
    qc, kc, vc, gf_c, gb_c = mlstm_inputs(qk_c, va_c, if_c, conv_w, conv_b, b_if)
    k_bc, v_bc = attn_kv(kb_c, vb_c, k_norm_w, None)
    if update_ctx:
        h_cf, st_f = mlstm_chunked(qc, kc, vc, *gf_c, zero_state(B))
        h_cb, st_b = mlstm_chunked(*_flip(qc, kc, vc, *gb_c), zero_state(B))
        h_c = (h_cf + jnp.flip(h_cb, axis=1)).astype(ctx.dtype)
        o_ac, z_ac, q_bc, z_bc, g_c = _split(p_c, OUT_WIDTHS, N_KV)
        q_bc = rms_norm(q_bc.reshape(B, T_c, NH_B, HD_B), q_norm_w)
        o_attn_c = attend_blocks(q_bc, k_bc, v_bc)
        out_c = branch_merge(h_c, o_attn_c, o_ac, z_ac, z_bc, g_c, mh_norm_w, w_ba, w_bb, w_out)
        ctx_new = layer_norm(ALPHA * ctx + gate_c * out_c, ln_w, ln_b)
    else:
        st_f = mlstm_final_state(kc, vc, *gf_c)
        st_b = mlstm_final_state(*_flip(kc, vc, *gb_c))
        ctx_new = ctx

    qk_l, va_l, if_l, kb_l, vb_l = _split(p, KV_WIDTHS)
    o_a, z_a, q_b, z_b, g_l = _split(p, OUT_WIDTHS, N_KV)
    ql, kl, vl, gf_l, gb_l = mlstm_inputs(qk_l, va_l, if_l, conv_w, conv_b, b_if)
    h_f, _ = mlstm_chunked(ql, kl, vl, *gf_l, st_f)
    h_b, _ = mlstm_chunked(*_flip(ql, kl, vl, *gb_l), st_b)
    h_l = (h_f + jnp.flip(h_b, axis=1)).astype(x.dtype)

    q_l = apply_rope_2d(rms_norm(q_b.reshape(B, S, NH_B, HD_B), q_norm_w), rope)
    k_bl, v_bl = attn_kv(kb_l, vb_l, k_norm_w, rope)
    k_all = jnp.concatenate([k_bc, k_bl], axis=1)
    v_all = jnp.concatenate([v_bc, v_bl], axis=1)
    o_attn = attend_blocks(q_l, k_all, v_all)

    out = branch_merge(h_l, o_attn, o_a, z_a, z_b, g_l, mh_norm_w, w_ba, w_bb, w_out)
    x_new = layer_norm(ALPHA * x + gate * out, ln_w, ln_b)
    return x_new, ctx_new


def setup_inputs(seed: int = 0) -> dict:
    key = jax.random.key(seed)
    ks = jax.random.split(key, 20)
    D = D_MODEL
    nrm = jax.random.normal
    b_if_i = 0.1 * nrm(ks[8], (DEPTH, 2, 1, NH_A))
    b_if_f = 3.0 + 0.5 * nrm(ks[9], (DEPTH, 2, 1, NH_A))
    b_if = jnp.concatenate([b_if_i, b_if_f], axis=2).reshape(DEPTH, 4 * NH_A)
    return {
        "x": nrm(ks[0], (BATCH, SEQ, D), jnp.float32),
        "c": nrm(ks[1], (BATCH, D), jnp.float32),
        "ctx": nrm(ks[2], (BATCH, CTX_LEN, D), jnp.float32),
        "c_ctx": nrm(ks[3], (D,), jnp.float32),
        "w_mod": 0.5 * D ** -0.5 * nrm(ks[4], (DEPTH, D, 3 * D), jnp.float32),
        "b_mod": 0.01 * nrm(ks[5], (DEPTH, 3 * D), jnp.float32),
        "w_in": D ** -0.5 * nrm(ks[6], (DEPTH, D, N_IN), jnp.float32),
        "b_if": b_if.astype(jnp.float32),
        "conv_w": CONV_W ** -0.5 * nrm(ks[7], (DEPTH, CONV_W, 2 * QK_A), jnp.float32),
        "conv_b": 0.01 * nrm(ks[10], (DEPTH, 2 * QK_A), jnp.float32),
        "mh_norm_w": 1.0 + 0.02 * nrm(ks[11], (DEPTH, V_A), jnp.float32),
        "q_norm_w": 1.0 + 0.02 * nrm(ks[12], (DEPTH, HD_B), jnp.float32),
        "k_norm_w": 1.0 + 0.02 * nrm(ks[13], (DEPTH, HD_B), jnp.float32),
        "w_branch_a": BETA * V_A ** -0.5 * nrm(ks[14], (DEPTH, V_A, D), jnp.float32),
        "w_branch_b": BETA * Q_B ** -0.5 * nrm(ks[15], (DEPTH, Q_B, D), jnp.float32),
        "w_out": BETA * D ** -0.5 * nrm(ks[16], (DEPTH, D, D), jnp.float32),
        "ln_w": 1.0 + 0.02 * nrm(ks[17], (DEPTH, D), jnp.float32),
        "ln_b": 0.01 * nrm(ks[18], (DEPTH, D), jnp.float32),
    }


def reference(x, c, ctx, c_ctx, w_mod, b_mod, w_in, b_if, conv_w, conv_b, mh_norm_w,
              q_norm_w, k_norm_w, w_branch_a, w_branch_b, w_out, ln_w, ln_b):
    rope = rope_tables(x.shape[1])
    for layer in range(DEPTH):
        x, ctx = trunk_layer(x, ctx, c, c_ctx, rope, w_mod[layer], b_mod[layer], w_in[layer],
                             b_if[layer], conv_w[layer], conv_b[layer], mh_norm_w[layer],
                             q_norm_w[layer], k_norm_w[layer], w_branch_a[layer],
                             w_branch_b[layer], w_out[layer], ln_w[layer], ln_b[layer],
                             layer < DEPTH - 1)
    return x
```

```cpp
#include <hip/hip_runtime.h>
#include <hip/hip_cooperative_groups.h>
#include <cstdio>
#include <cstdint>
namespace cg = cooperative_groups;

constexpr int DM = 2048, NB = 4, SEQ = 8192, CTXL = 256;
constexpr int M_TOK = NB * SEQ, M_CTX = NB * CTXL, M_ALL = M_TOK + M_CTX;
constexpr int SKV = CTXL + SEQ;
constexpr int N_IN = 17440, N1P = 17664;
constexpr float LN_EPS = 1e-6f;
constexpr float ALPHA_DN = 1.189207115002721f;
constexpr int LDS_BYTES = 132 * 1024;

constexpr size_t SZ_W2 = (size_t)2048 * 2048 * 2;
constexpr size_t SZ_ALL = (size_t)M_ALL * 2048 * 2;
constexpr size_t SZ_TOK = (size_t)M_TOK * 2048 * 2;
constexpr size_t SZ_KV = (size_t)NB * SKV * 512 * 2;
constexpr size_t OFF_WT_BA = 0, OFF_WT_BB = SZ_W2, OFF_WT_OUT = 2 * SZ_W2;
constexpr size_t OFF_MOD = 3 * SZ_W2;
constexpr size_t OFF_ROPE = OFF_MOD + 131072;
constexpr size_t OFF_U = OFF_ROPE + 32768;
constexpr size_t OFF_QAKA = OFF_U;
constexpr size_t OFF_QKPRE = OFF_U + SZ_ALL;
constexpr size_t OFF_HF = OFF_QKPRE, OFF_MERGED = OFF_QKPRE;
constexpr size_t OFF_OZ = OFF_QKPRE + SZ_ALL;
constexpr size_t OFF_QB = OFF_OZ + SZ_TOK;
constexpr size_t OFF_ZB = OFF_QB + SZ_TOK;
constexpr size_t OFF_TMP = OFF_ZB;
constexpr size_t OFF_VA = OFF_ZB + SZ_TOK;
constexpr size_t OFF_VALL = OFF_VA + SZ_ALL;
constexpr size_t OFF_KALL = OFF_VALL + SZ_KV;
constexpr size_t OFF_GATES = OFF_KALL + SZ_KV;
constexpr size_t OFF_KBRAW = OFF_GATES + (size_t)M_ALL * 32 * 4;
constexpr size_t OFF_HB = OFF_KBRAW;
constexpr size_t OFF_WT_IN = OFF_KBRAW + SZ_KV;
constexpr size_t WS_END = OFF_HB + SZ_TOK;
static_assert(OFF_WT_IN + (size_t)N1P * 2048 * 2 <= WS_END, "ws map");
static_assert(OFF_TMP + (size_t)M_TOK * 2048 * 4 <= OFF_VALL, "tmp map");
static_assert(OFF_U % 256 == 0 && OFF_GATES % 256 == 0 && OFF_KBRAW % 256 == 0, "align");

typedef unsigned short bf16_t;
using f32x16 = __attribute__((ext_vector_type(16))) float;
using s16x4 = __attribute__((ext_vector_type(4))) short;
using u32x2 = __attribute__((ext_vector_type(2))) unsigned;

struct Params { const float* in[18]; float* out; unsigned char* ws; };

__device__ __forceinline__ float wave_sum(float v) {
#pragma unroll
  for (int o = 32; o >= 1; o >>= 1) v += __shfl_xor(v, o);
  return v;
}
__device__ __forceinline__ float bf2f(unsigned short b) { return __uint_as_float(((unsigned)b) << 16); }
__device__ __forceinline__ float bflo(unsigned w) { return __uint_as_float(w << 16); }
__device__ __forceinline__ float bfhi(unsigned w) { return __uint_as_float(w & 0xffff0000u); }
__device__ __forceinline__ float sigmoidf_(float x) { return __builtin_amdgcn_rcpf(1.0f + __expf(-x)); }
__device__ __forceinline__ float siluf_(float x) { return x * __builtin_amdgcn_rcpf(1.0f + __expf(-x)); }
namespace pg8 {
#define PG8_LAS __attribute__((address_space(3)))
typedef unsigned short bf16_t;
typedef short bf16x8 __attribute__((ext_vector_type(8)));
typedef float f32x4 __attribute__((ext_vector_type(4)));
typedef unsigned u32x4 __attribute__((ext_vector_type(4)));
constexpr int BM = 256, BK = 64, HALF = 128, HTB = HALF * BK * 2  , STAGE_BYTES = 8 * HTB, NXCD = 8, WGM = 8;

__host__ __device__ __forceinline__ int lds_byte(int r, int c) { const int st = (r >> 4) * 2 + (c >> 5), rr = r & 15, cc = c & 31, ob = rr * 64 + cc * 2; return st * 1024 + (ob ^ (((ob >> 9) & 1) << 5)); }
__host__ __device__ __forceinline__ void stage_rc(int b, int& R, int& C) { const int st = b / 1024, sb = b % 1024, swz = sb ^ (((sb >> 9) & 1) << 5); R = (st >> 1) * 16 + swz / 64; C = (st & 1) * 32 + (swz % 64) / 2; }
__host__ __device__ __forceinline__ int perm32(int rho) { const int n = rho >> 4, i = rho & 15; return 8 * (i >> 2) + 4 * n + (i & 3); }

struct Unit { int pm, pn; };
struct Gemm { const bf16_t* A; const bf16_t* Bt; int M, N, K; };

struct StaticOrder {
    int nM, nN, nwg, G, c;
    __host__ __device__ void init(int M, int N, int G_, int c_) { nM = M / BM; nN = N / BM; nwg = nM * nN; G = G_; c = c_; }
    __host__ __device__ bool next(int i, Unit& u) const {
        const long L = (long)i * G + c; if (L >= nwg) return false;
        int wgid = (int)L; { const int q = nwg / NXCD, r = nwg % NXCD, xcd = wgid % NXCD, off = wgid / NXCD; wgid = (xcd < r ? xcd * (q + 1) : r * (q + 1) + (xcd - r) * q) + off; }
        const int nig = WGM * nN, gid = wgid / nig, fm = gid * WGM, gsz = (nM - fm) < WGM ? (nM - fm) : WGM;
        u.pm = fm + ((wgid % nig) % gsz); u.pn = (wgid % nig) / gsz; return true;
    }
    __device__ __forceinline__ void a_ready(const Unit&) const {}
    __device__ __forceinline__ void done(const Unit&) const {}
};
__device__ __forceinline__ unsigned cvt_pk_bf16(float lo, float hi) { unsigned r; asm volatile("v_cvt_pk_bf16_f32 %0, %1, %2" : "=v"(r) : "v"(lo), "v"(hi)); return r; }
template <class Epi, class Sched>
__device__ __forceinline__ void gemm_phase(PG8_LAS unsigned char* lds, const Gemm g, const Sched& S, const Epi& E) {
    int tid_l = threadIdx.x; asm volatile("" : "+v"(tid_l)); const int tid = tid_l, wid = __builtin_amdgcn_readfirstlane(tid >> 6), lane = tid & 63, wr = wid >> 2, wc = wid & 3, fr = lane & 15, fq = lane >> 4;
    const int K = g.K, nt = K / BK;
    unsigned voffA[2], voffB[2];
#pragma unroll
    for (int i = 0; i < 2; ++i) { int R, C; stage_rc(tid * 16 + i * 8192, R, C); const int Rb = Epi::PERM ? ((R & ~31) + perm32(R & 31)) : R;
        voffA[i] = (unsigned)(R * K + C) * 2u; voffB[i] = (unsigned)(Rb * K + C) * 2u; }
    const size_t kstep = (size_t)(BK * 2);
    const size_t hstep = (size_t)HALF * K * 2;
    const size_t tstep = 2 * hstep;
    const unsigned ldsw = (unsigned)wid * 1024u;
    const int aoff = lds_byte(wr * 64 + fr, fq * 8), boff = lds_byte(wc * 32 + fr, fq * 8);
#define PG8_SA(b, h) (((b) * 2 + (h)) * HTB)
#define PG8_SB(b, h) ((4 + (b) * 2 + (h)) * HTB)
#define PG8_STAGE(bufoff, gbase, voff) do { _Pragma("unroll") for (int _i = 0; _i < 2; ++_i) \
        __builtin_amdgcn_global_load_lds((const unsigned*)((const char*)(gbase) + (voff)[_i]), (PG8_LAS unsigned*)(lds + (bufoff) + ldsw + _i * 8192), 16, 0, 0); } while (0)
#define PG8_LDA(dst, b, h) do { _Pragma("unroll") for (int m = 0; m < 4; ++m) _Pragma("unroll") for (int k = 0; k < 2; ++k) dst[m][k] = *(const PG8_LAS bf16x8*)(lds + PG8_SA(b, h) + aoff + m * 2048 + k * 1024); } while (0)
#define PG8_LDB(dst, b, h) do { _Pragma("unroll") for (int n = 0; n < 2; ++n) _Pragma("unroll") for (int k = 0; k < 2; ++k) dst[n][k] = *(const PG8_LAS bf16x8*)(lds + PG8_SB(b, h) + boff + n * 2048 + k * 1024); } while (0)
#define PG8_MMA(ai, bj, At, Bt) do { __builtin_amdgcn_s_setprio(1); _Pragma("unroll") for (int m = 0; m < 4; ++m) _Pragma("unroll") for (int n = 0; n < 2; ++n) _Pragma("unroll") for (int k = 0; k < 2; ++k) \
        acc[ai][bj][m][n] = __builtin_amdgcn_mfma_f32_16x16x32_bf16(Bt[n][k], At[m][k], acc[ai][bj][m][n], 0, 0, 0); __builtin_amdgcn_s_setprio(0); } while (0)
#define PG8_WAIT_V(n) asm volatile("s_waitcnt vmcnt(" #n ")" ::: "memory")
#define PG8_WAIT_L(n) asm volatile("s_waitcnt lgkmcnt(" #n ")" ::: "memory")
#define PG8_BAR __builtin_amdgcn_s_barrier()
#define PG8_SCHED __builtin_amdgcn_sched_barrier(0)
    Unit cur, nxt; int ui = 0;
    if (!S.next(0, cur)) return;
    f32x4 acc[2][2][4][2];
#pragma unroll
    for (int a = 0; a < 2; ++a)
#pragma unroll
        for (int b = 0; b < 2; ++b)
#pragma unroll
            for (int m = 0; m < 4; ++m)
#pragma unroll
                for (int n = 0; n < 2; ++n) acc[a][b][m][n] = (f32x4){0.f, 0.f, 0.f, 0.f};
    bf16x8 At[4][2], B0[2][2], B1[2][2];
    const char* cA = (const char*)g.A + (size_t)cur.pm * tstep; const char* cB = (const char*)g.Bt + (size_t)cur.pn * tstep;
    S.a_ready(cur);
    PG8_STAGE(PG8_SB(0, 0), cB, voffB); PG8_STAGE(PG8_SA(0, 0), cA, voffA); PG8_STAGE(PG8_SB(0, 1), cB + hstep, voffB); PG8_STAGE(PG8_SA(0, 1), cA + hstep, voffA);
    if (wr == 1) PG8_BAR;
    PG8_WAIT_V(4); PG8_BAR;
    PG8_STAGE(PG8_SB(1, 0), cB + kstep, voffB); PG8_STAGE(PG8_SA(1, 0), cA + kstep, voffA); PG8_STAGE(PG8_SB(1, 1), cB + hstep + kstep, voffB);
    PG8_WAIT_V(6); PG8_BAR;
    for (;;) {
        const bool has_next = S.next(ui + 1, nxt);
        const char* nA = has_next ? (const char*)g.A + (size_t)nxt.pm * tstep : cA; const char* nB = has_next ? (const char*)g.Bt + (size_t)nxt.pn * tstep : cB;
        for (int t = 0; t < nt; t += 2) {
            const bool last = (t == nt - 2);
            const char* a1 = cA + (size_t)(t + 1) * kstep;
            const char* a2 = last ? nA : cA + (size_t)(t + 2) * kstep; const char* b2 = last ? nB : cB + (size_t)(t + 2) * kstep;
            const char* a3 = a2 + kstep; const char* b3 = b2 + kstep;
            if (last && has_next) S.a_ready(nxt);
            PG8_LDB(B0, 0, 0); PG8_SCHED; PG8_LDA(At, 0, 0); PG8_STAGE(PG8_SA(1, 1), a1 + hstep, voffA);
            PG8_WAIT_L(8); PG8_BAR; PG8_WAIT_L(0); PG8_MMA(0, 0, At, B0); PG8_BAR; PG8_SCHED;
            PG8_LDB(B1, 0, 1); PG8_STAGE(PG8_SB(0, 0), b2, voffB);
            PG8_BAR; PG8_WAIT_L(0); PG8_MMA(0, 1, At, B1); PG8_BAR;
            PG8_LDA(At, 0, 1); PG8_STAGE(PG8_SA(0, 0), a2, voffA);
            PG8_BAR; PG8_WAIT_L(0); PG8_MMA(1, 0, At, B0); PG8_BAR; PG8_SCHED;
            PG8_STAGE(PG8_SB(0, 1), b2 + hstep, voffB);
            PG8_WAIT_V(6); PG8_BAR; PG8_MMA(1, 1, At, B1); PG8_BAR;
            PG8_LDB(B0, 1, 0); PG8_SCHED; PG8_LDA(At, 1, 0); PG8_STAGE(PG8_SA(0, 1), a2 + hstep, voffA);
            PG8_WAIT_L(8); PG8_BAR; PG8_WAIT_L(0); PG8_MMA(0, 0, At, B0); PG8_BAR; PG8_SCHED;
            PG8_LDB(B1, 1, 1); PG8_STAGE(PG8_SB(1, 0), b3, voffB);
            PG8_BAR; PG8_WAIT_L(0); PG8_MMA(0, 1, At, B1); PG8_BAR;
            PG8_LDA(At, 1, 1); PG8_STAGE(PG8_SA(1, 0), a3, voffA);
            PG8_BAR; PG8_WAIT_L(0); PG8_MMA(1, 0, At, B0); PG8_BAR; PG8_SCHED;
            PG8_STAGE(PG8_SB(1, 1), b3 + hstep, voffB);
            PG8_WAIT_V(6); PG8_BAR; PG8_MMA(1, 1, At, B1); PG8_BAR;
        }
        if constexpr (!Epi::AFTER_DRAIN) { E(acc, cur, wr, wc, fr, fq); S.done(cur); }
        if (!has_next) break;
#pragma unroll
        for (int a = 0; a < 2; ++a)
#pragma unroll
            for (int b = 0; b < 2; ++b)
#pragma unroll
                for (int m = 0; m < 4; ++m)
#pragma unroll
                    for (int n = 0; n < 2; ++n) acc[a][b][m][n] = (f32x4){0.f, 0.f, 0.f, 0.f};
        cur = nxt; cA = nA; cB = nB; ++ui;
    }
    PG8_WAIT_V(0);
    if (wr == 0) PG8_BAR;
    PG8_BAR;
    if constexpr (Epi::AFTER_DRAIN) { E.fused(acc, cur, wr, wc, fr, fq, lds, wid, lane); S.done(cur); }
#undef PG8_SA
#undef PG8_SB
#undef PG8_STAGE
#undef PG8_LDA
#undef PG8_LDB
#undef PG8_MMA
#undef PG8_WAIT_V
#undef PG8_WAIT_L
#undef PG8_BAR
#undef PG8_SCHED
}
}


using pg8::f32x4; using pg8::u32x4; using pg8::bf16x8; using pg8::cvt_pk_bf16;

struct Epi1 {
  static constexpr bool PERM = true, AFTER_DRAIN = false;
  unsigned char* ws; unsigned char* dout;
  __device__ __forceinline__ void operator()(const f32x4 (&acc)[2][2][4][2], const pg8::Unit& u, int wr, int wc, int fr, int fq) const {
    const int pn = u.pn, pm = u.pm; const bool lat = pm < 128;
    const int rl = wr * 64 + fr, cl = wc * 32 + 8 * fq;
    if (pn == 20) {
      if (wc == 0) { float* G = (float*)(ws + OFF_GATES);
#pragma unroll
        for (int ai = 0; ai < 2; ++ai)
#pragma unroll
          for (int m = 0; m < 4; ++m) { float* rp = G + (size_t)(pm * 256 + ai * 128 + rl + m * 16) * 32 + 8 * fq;
            *(f32x4*)rp = acc[ai][0][m][0]; *(f32x4*)(rp + 4) = acc[ai][0][m][1]; } }
      return;
    }
    if (pn >= 21 && pn < 37) {
      if (!lat) return;
      bf16_t* O = (bf16_t*)(ws + OFF_OZ) + (pn - 21) * 128 + cl;
#pragma unroll
      for (int ai = 0; ai < 2; ++ai)
#pragma unroll
        for (int m = 0; m < 4; ++m) { const size_t row = (size_t)pm * 256 + ai * 128 + rl + m * 16;
          float r[8];
#pragma unroll
          for (int n = 0; n < 2; ++n)
#pragma unroll
            for (int e = 0; e < 4; ++e) r[n * 4 + e] = sigmoidf_(acc[ai][0][m][n][e]) * siluf_(acc[ai][1][m][n][e]);
          u32x4 w; w.x = cvt_pk_bf16(r[0], r[1]); w.y = cvt_pk_bf16(r[2], r[3]); w.z = cvt_pk_bf16(r[4], r[5]); w.w = cvt_pk_bf16(r[6], r[7]);
          *(u32x4*)(O + row * 2048) = w; }
      return;
    }
    bf16_t* O; int ld = 2048, act = 0; size_t rowbase = (size_t)pm * 256;
    if (pn < 8) { O = (bf16_t*)(ws + OFF_QKPRE) + pn * 256; }
    else if (pn < 16) { O = (bf16_t*)(ws + OFF_VA) + (pn - 8) * 256; }
    else if (pn < 18) { O = (bf16_t*)(ws + OFF_KBRAW) + (pn - 16) * 256; ld = 512; }
    else if (pn < 20) { O = (bf16_t*)(ws + OFF_VALL) + (pn - 18) * 256; ld = 512;
      rowbase = lat ? (size_t)(pm >> 5) * SKV + CTXL + (size_t)(pm & 31) * 256 : (size_t)(pm - 128) * SKV; }
    else { if (!lat) return;
      if (pn < 45) { O = (bf16_t*)(ws + OFF_QB) + (pn - 37) * 256; }
      else if (pn < 53) { O = (bf16_t*)(ws + OFF_ZB) + (pn - 45) * 256; act = 1; }
      else if (pn < 61) { O = (bf16_t*)dout + (pn - 53) * 256; act = 2; }
      else { O = (bf16_t*)dout + (size_t)M_TOK * 2048 + (pn - 61) * 256; act = 2; } }
#pragma unroll
    for (int ai = 0; ai < 2; ++ai)
#pragma unroll
      for (int m = 0; m < 4; ++m) { bf16_t* rowp = O + (rowbase + ai * 128 + rl + m * 16) * ld + cl;
#pragma unroll
        for (int bj = 0; bj < 2; ++bj) { f32x4 v0 = acc[ai][bj][m][0], v1 = acc[ai][bj][m][1];
          if (act == 1) {
#pragma unroll
            for (int e = 0; e < 4; ++e) { v0[e] = siluf_(v0[e]); v1[e] = siluf_(v1[e]); } }
          else if (act == 2) {
#pragma unroll
            for (int e = 0; e < 4; ++e) { v0[e] = sigmoidf_(v0[e]); v1[e] = sigmoidf_(v1[e]); } }
          u32x4 w; w.x = cvt_pk_bf16(v0[0], v0[1]); w.y = cvt_pk_bf16(v0[2], v0[3]); w.z = cvt_pk_bf16(v1[0], v1[1]); w.w = cvt_pk_bf16(v1[2], v1[3]);
          *(u32x4*)(rowp + bj * 128) = w; } }
  }
};
struct Epi2a {
  static constexpr bool PERM = true, AFTER_DRAIN = false;
  float* tmp; const bf16_t* sg;
  __device__ __forceinline__ void operator()(const f32x4 (&acc)[2][2][4][2], const pg8::Unit& u, int wr, int wc, int fr, int fq) const {
    const int col0 = u.pn * 256 + wc * 32 + 8 * fq;
#pragma unroll
    for (int ai = 0; ai < 2; ++ai)
#pragma unroll
      for (int m = 0; m < 4; ++m) { const size_t off = (size_t)(u.pm * 256 + ai * 128 + wr * 64 + fr + m * 16) * 2048 + col0;
#pragma unroll
        for (int bj = 0; bj < 2; ++bj) { const u32x4 s = *(const u32x4*)(sg + off + bj * 128);
          f32x4 a = acc[ai][bj][m][0], b = acc[ai][bj][m][1];
          a[0] *= bflo(s.x); a[1] *= bfhi(s.x); a[2] *= bflo(s.y); a[3] *= bfhi(s.y);
          b[0] *= bflo(s.z); b[1] *= bfhi(s.z); b[2] *= bflo(s.w); b[3] *= bfhi(s.w);
          *(f32x4*)(tmp + off + bj * 128) = a; *(f32x4*)(tmp + off + bj * 128 + 4) = b; } }
  }
};
struct Epi2b {
  static constexpr bool PERM = true, AFTER_DRAIN = false;
  const float* tmp; const bf16_t* sg; bf16_t* merged;
  __device__ __forceinline__ void operator()(const f32x4 (&acc)[2][2][4][2], const pg8::Unit& u, int wr, int wc, int fr, int fq) const {
    const int col0 = u.pn * 256 + wc * 32 + 8 * fq;
#pragma unroll
    for (int ai = 0; ai < 2; ++ai)
#pragma unroll
      for (int m = 0; m < 4; ++m) { const size_t off = (size_t)(u.pm * 256 + ai * 128 + wr * 64 + fr + m * 16) * 2048 + col0;
#pragma unroll
        for (int bj = 0; bj < 2; ++bj) { const u32x4 s = *(const u32x4*)(sg + off + bj * 128);
          const f32x4 t0 = *(const f32x4*)(tmp + off + bj * 128), t1 = *(const f32x4*)(tmp + off + bj * 128 + 4);
          f32x4 a = acc[ai][bj][m][0], b = acc[ai][bj][m][1];
          a[0] = t0[0] + a[0] * bflo(s.x); a[1] = t0[1] + a[1] * bfhi(s.x); a[2] = t0[2] + a[2] * bflo(s.y); a[3] = t0[3] + a[3] * bfhi(s.y);
          b[0] = t1[0] + b[0] * bflo(s.z); b[1] = t1[1] + b[1] * bfhi(s.z); b[2] = t1[2] + b[2] * bflo(s.w); b[3] = t1[3] + b[3] * bfhi(s.w);
          u32x4 w; w.x = cvt_pk_bf16(a[0], a[1]); w.y = cvt_pk_bf16(a[2], a[3]); w.z = cvt_pk_bf16(b[0], b[1]); w.w = cvt_pk_bf16(b[2], b[3]);
          *(u32x4*)(merged + off + bj * 128) = w; } }
  }
};
struct Epi3 {
  static constexpr bool PERM = false, AFTER_DRAIN = false;
  const float* x; const float* mod; float* y;
  __device__ __forceinline__ void operator()(const f32x4 (&acc)[2][2][4][2], const pg8::Unit& u, int wr, int wc, int fr, int fq) const {
    const int col0 = u.pn * 256 + wc * 32 + 4 * fq;
    const float* gate = mod + (size_t)(u.pm >> 5) * 6144 + 4096 + col0;
    f32x4 gv[2][2];
#pragma unroll
    for (int bj = 0; bj < 2; ++bj)
#pragma unroll
      for (int n = 0; n < 2; ++n) gv[bj][n] = *(const f32x4*)(gate + bj * 128 + n * 16);
#pragma unroll
    for (int ai = 0; ai < 2; ++ai)
#pragma unroll
      for (int m = 0; m < 4; ++m) { const size_t off = (size_t)(u.pm * 256 + ai * 128 + wr * 64 + fr + m * 16) * 2048 + col0;
#pragma unroll
        for (int bj = 0; bj < 2; ++bj)
#pragma unroll
          for (int n = 0; n < 2; ++n) { const f32x4 xv = *(const f32x4*)(x + off + bj * 128 + n * 16);
            *(f32x4*)(y + off + bj * 128 + n * 16) = xv * ALPHA_DN + gv[bj][n] * acc[ai][bj][m][n]; } }
  }
};

__device__ __forceinline__ int orig_col(int n) {
  if (n < 4096) return n;
  if (n < 4608) return 4128 + (n - 4096);
  if (n < 5120) return 4640 + (n - 4608);
  if (n < 5152) return 4096 + (n - 5120);
  if (n < 5376) return -1;
  if (n < 9472) { const int t = n - 5376, j = t >> 8, r = t & 255; return r < 128 ? 5152 + 128 * j + r : 7200 + 128 * j + (r - 128); }
  if (n < 11520) return 9248 + (n - 9472);
  if (n < 13568) return 11296 + (n - 11520);
  return 13344 + (n - 13568);
}
__device__ void phase0_prep(const Params& p, unsigned char* lds) {
  int tid_l = threadIdx.x; asm volatile("" : "+v"(tid_l)); const int tid = tid_l, wid = tid >> 6, lane = tid & 63;
  unsigned char* ws = p.ws;
  for (int idx = blockIdx.x * 512 + tid; idx < 4096; idx += gridDim.x * 512) {
    const int pos = idx >> 5, i = idx & 31; const float inv = powf(10000.0f, -(float)(2 * i) / 64.0f); const float ang = (float)pos * inv;
    float2 cs; cs.x = cosf(ang); cs.y = sinf(ang); ((float2*)(ws + OFF_ROPE))[idx] = cs; }
  float* sl = (float*)lds; float* red = sl + 5 * 2048; bool did = false;
  for (int it = blockIdx.x; it < 192; it += gridDim.x) {
    if (!did) { for (int i = tid; i < 5 * 2048; i += 512) { const int r = i >> 11, k = i & 2047; const float c = (r < 4) ? p.in[1][r * 2048 + k] : p.in[3][k]; sl[i] = c / (1.0f + expf(-c)); }
      __syncthreads(); did = true; }
    const int col = lane & 31, kh = lane >> 5, n = it * 32 + col;
    float a0 = 0.f, a1 = 0.f, a2 = 0.f, a3 = 0.f, a4 = 0.f;
    const float* wp = p.in[4] + (size_t)(wid * 256 + kh) * 6144 + n;
#pragma unroll 8
    for (int i = 0; i < 128; ++i) { const int k = wid * 256 + 2 * i + kh; const float w = wp[(size_t)(2 * i) * 6144];
      a0 += sl[k] * w; a1 += sl[2048 + k] * w; a2 += sl[4096 + k] * w; a3 += sl[6144 + k] * w; a4 += sl[8192 + k] * w; }
    a0 += __shfl_xor(a0, 32); a1 += __shfl_xor(a1, 32); a2 += __shfl_xor(a2, 32); a3 += __shfl_xor(a3, 32); a4 += __shfl_xor(a4, 32);
    if (kh == 0) { red[(wid * 5 + 0) * 32 + col] = a0; red[(wid * 5 + 1) * 32 + col] = a1; red[(wid * 5 + 2) * 32 + col] = a2; red[(wid * 5 + 3) * 32 + col] = a3; red[(wid * 5 + 4) * 32 + col] = a4; }
    __syncthreads();
    if (tid < 160) { const int r = tid >> 5, c = tid & 31; float s = 0.f;
#pragma unroll
      for (int w = 0; w < 8; ++w) s += red[(w * 5 + r) * 32 + c];
      ((float*)(ws + OFF_MOD))[r * 6144 + it * 32 + c] = s + p.in[5][it * 32 + c]; }
    __syncthreads();
  }
  __syncthreads();
  float* tile = (float*)lds;
  constexpr int NT_IN = (N1P / 64) * 32, NT = NT_IN + 3 * 1024;
  for (int t = blockIdx.x; t < NT; t += gridDim.x) {
    const float* src; bf16_t* dst; int ldsrc, n0, k0; bool perm;
    if (t < NT_IN) { src = p.in[6]; dst = (bf16_t*)(ws + OFF_WT_IN); ldsrc = N_IN; n0 = (t >> 5) * 64; k0 = (t & 31) * 64; perm = true; }
    else { int q = t - NT_IN; const int w = q >> 10; q &= 1023; src = p.in[13 + w]; dst = (bf16_t*)(ws + OFF_WT_BA + (size_t)w * SZ_W2); ldsrc = 2048; n0 = (q >> 5) * 64; k0 = (q & 31) * 64; perm = false; }
#pragma unroll
    for (int i = 0; i < 2; ++i) { const int kk = (tid >> 4) + 32 * i, nq = (tid & 15) * 4; const int oc = perm ? orig_col(n0 + nq) : n0 + nq;
      float4 v = make_float4(0.f, 0.f, 0.f, 0.f); if (oc >= 0) v = *(const float4*)(src + (size_t)(k0 + kk) * ldsrc + oc);
      float* tp = tile + kk * 65 + nq; tp[0] = v.x; tp[1] = v.y; tp[2] = v.z; tp[3] = v.w; }
    __syncthreads();
    { const int nn = tid >> 3, kq = (tid & 7) * 8; float r[8];
#pragma unroll
      for (int e = 0; e < 8; ++e) r[e] = tile[(kq + e) * 65 + nn];
      u32x4 w; w.x = cvt_pk_bf16(r[0], r[1]); w.y = cvt_pk_bf16(r[2], r[3]); w.z = cvt_pk_bf16(r[4], r[5]); w.w = cvt_pk_bf16(r[6], r[7]);
      *(u32x4*)(dst + (size_t)(n0 + nn) * 2048 + k0 + kq) = w; }
    __syncthreads();
  }
}

__device__ void phase1_ln_mod(const Params& p) {
  int tid_l = threadIdx.x; asm volatile("" : "+v"(tid_l)); const int tid = tid_l, wid = tid >> 6, lane = tid & 63;
  const float* MOD = (const float*)(p.ws + OFF_MOD); bf16_t* U = (bf16_t*)(p.ws + OFF_U);
  for (int row = blockIdx.x * 8 + wid; row < M_ALL; row += gridDim.x * 8) {
    const float* src = row < M_TOK ? p.in[0] + (size_t)row * 2048 : p.in[2] + (size_t)(row - M_TOK) * 2048;
    const float* md = MOD + (size_t)(row < M_TOK ? (row >> 13) : 4) * 6144;
    float4 v[4][2]; float s = 0.f;
#pragma unroll
    for (int g = 0; g < 4; ++g) { const float4* q = (const float4*)(src + g * 512 + lane * 8); v[g][0] = q[0]; v[g][1] = q[1];
      s += (v[g][0].x + v[g][0].y) + (v[g][0].z + v[g][0].w) + (v[g][1].x + v[g][1].y) + (v[g][1].z + v[g][1].w); }
    s = wave_sum(s); const float mu = s * (1.0f / 2048.0f); float q2 = 0.f;
#pragma unroll
    for (int g = 0; g < 4; ++g)
#pragma unroll
      for (int h = 0; h < 2; ++h) { const float a = v[g][h].x - mu, b = v[g][h].y - mu, c = v[g][h].z - mu, d = v[g][h].w - mu; q2 += (a * a + b * b) + (c * c + d * d); }
    q2 = wave_sum(q2); const float rs = rsqrtf(q2 * (1.0f / 2048.0f) + LN_EPS);
#pragma unroll
    for (int g = 0; g < 4; ++g) { const int c0 = g * 512 + lane * 8; float r[8];
#pragma unroll
      for (int h = 0; h < 2; ++h) { const float4 sh = *(const float4*)(md + c0 + 4 * h), sc = *(const float4*)(md + 2048 + c0 + 4 * h);
        r[4 * h + 0] = (v[g][h].x - mu) * rs * (1.0f + sc.x) + sh.x; r[4 * h + 1] = (v[g][h].y - mu) * rs * (1.0f + sc.y) + sh.y;
        r[4 * h + 2] = (v[g][h].z - mu) * rs * (1.0f + sc.z) + sh.z; r[4 * h + 3] = (v[g][h].w - mu) * rs * (1.0f + sc.w) + sh.w; }
      u32x4 w; w.x = cvt_pk_bf16(r[0], r[1]); w.y = cvt_pk_bf16(r[2], r[3]); w.z = cvt_pk_bf16(r[4], r[5]); w.w = cvt_pk_bf16(r[6], r[7]);
      *(u32x4*)(U + (size_t)row * 2048 + c0) = w; }
  }
}

__device__ __forceinline__ void unpack8(const u32x4 w, float* f) { f[0] = bflo(w.x); f[1] = bfhi(w.x); f[2] = bflo(w.y); f[3] = bfhi(w.y); f[4] = bflo(w.z); f[5] = bfhi(w.z); f[6] = bflo(w.w); f[7] = bfhi(w.w); }
__device__ __forceinline__ u32x4 pack8(const float* r) { u32x4 w; w.x = cvt_pk_bf16(r[0], r[1]); w.y = cvt_pk_bf16(r[2], r[3]); w.z = cvt_pk_bf16(r[4], r[5]); w.w = cvt_pk_bf16(r[6], r[7]); return w; }
__device__ __forceinline__ u32x4 norm_rope_head(const u32x4 raw, const float* nw, const float2* rope, int j, int pos_r, int pos_c) {
  float x[8]; unpack8(raw, x); float ss = 0.f;
#pragma unroll
  for (int e = 0; e < 8; ++e) ss += x[e] * x[e];
  ss += __shfl_xor(ss, 1); ss += __shfl_xor(ss, 2); ss += __shfl_xor(ss, 4); ss += __shfl_xor(ss, 8);
  const float rs = rsqrtf(ss * (1.0f / 128.0f) + LN_EPS);
  const float4 w0 = *(const float4*)(nw + 8 * j), w1 = *(const float4*)(nw + 8 * j + 4);
  x[0] *= rs * w0.x; x[1] *= rs * w0.y; x[2] *= rs * w0.z; x[3] *= rs * w0.w; x[4] *= rs * w1.x; x[5] *= rs * w1.y; x[6] *= rs * w1.z; x[7] *= rs * w1.w;
  float o[8];
  const bool is_x1 = ((j >> 2) & 1) == 0; const int pos = (j < 8) ? pos_r : pos_c; const int fi = 8 * (j & 3);
#pragma unroll
  for (int e = 0; e < 8; ++e) { const float pv = __shfl_xor(x[e], 4);
    if (pos_r >= 0) { const float2 cs = rope[pos * 32 + fi + e]; o[e] = is_x1 ? (x[e] * cs.x - pv * cs.y) : (pv * cs.y + x[e] * cs.x); }
    else o[e] = x[e]; }
  return pack8(o);
}
__device__ void phase3_elem(const Params& p) {
  int tid_l = threadIdx.x; asm volatile("" : "+v"(tid_l)); const int tid = tid_l, wid = tid >> 6, lane = tid & 63;
  unsigned char* ws = p.ws;
  { const bf16_t* X = (const bf16_t*)(ws + OFF_QKPRE); bf16_t* Y = (bf16_t*)(ws + OFF_QAKA); const float* cw = p.in[8]; const float* cb = p.in[9];
    for (size_t idx = (size_t)blockIdx.x * 512 + tid; idx < (size_t)M_ALL * 256; idx += (size_t)gridDim.x * 512) {
      const int row = (int)(idx >> 8), c8 = (int)(idx & 255) * 8;
      bool first, last; if (row < M_TOK) { const int s = row & (SEQ - 1); first = s == 0; last = s == SEQ - 1; } else { const int t = (row - M_TOK) & (CTXL - 1); first = t == 0; last = t == CTXL - 1; }
      const u32x4 z = {0u, 0u, 0u, 0u};
      const u32x4 cu = *(const u32x4*)(X + (size_t)row * 2048 + c8);
      const u32x4 pr = first ? z : *(const u32x4*)(X + (size_t)(row - 1) * 2048 + c8);
      const u32x4 nx = last ? z : *(const u32x4*)(X + (size_t)(row + 1) * 2048 + c8);
      float a[8], b[8], c[8], r[8]; unpack8(pr, a); unpack8(cu, b); unpack8(nx, c);
      const float sc = c8 >= 1024 ? 0.08838834764831845f : 1.0f;
#pragma unroll
      for (int e = 0; e < 8; ++e) { const float y = cb[c8 + e] + a[e] * cw[c8 + e] + b[e] * cw[2048 + c8 + e] + c[e] * cw[4096 + c8 + e]; r[e] = siluf_(y) * sc; }
      *(u32x4*)(Y + (size_t)row * 2048 + c8) = pack8(r); } }
  const float2* rope = (const float2*)(ws + OFF_ROPE);
  const int j = lane & 15, hl = lane >> 4;
  { const bf16_t* X = (const bf16_t*)(ws + OFF_KBRAW); bf16_t* Y = (bf16_t*)(ws + OFF_KALL);
    for (int row = blockIdx.x * 8 + wid; row < M_ALL; row += gridDim.x * 8) {
      size_t drow; int pr = -1, pc = -1;
      if (row < M_TOK) { const int b = row >> 13, s = row & (SEQ - 1); drow = (size_t)b * SKV + CTXL + s; pr = s >> 6; pc = s & 63; }
      else { const int b = (row - M_TOK) >> 8, t = (row - M_TOK) & (CTXL - 1); drow = (size_t)b * SKV + t; }
      const u32x4 raw = *(const u32x4*)(X + (size_t)row * 512 + hl * 128 + j * 8);
      *(u32x4*)(Y + drow * 512 + hl * 128 + j * 8) = norm_rope_head(raw, p.in[12], rope, j, pr, pc); } }
  { bf16_t* X = (bf16_t*)(ws + OFF_QB);
    for (int it = blockIdx.x * 8 + wid; it < M_TOK * 4; it += gridDim.x * 8) {
      const int row = it >> 2, hd = (it & 3) * 4 + hl, s = row & (SEQ - 1);
      bf16_t* q = X + (size_t)row * 2048 + hd * 128 + j * 8;
      const u32x4 raw = *(const u32x4*)q;
      *(u32x4*)q = norm_rope_head(raw, p.in[11], rope, j, s >> 6, s & 63); } }
}

__device__ void phase5_gate(const Params& p) {
  int tid_l = threadIdx.x; asm volatile("" : "+v"(tid_l)); const int tid = tid_l, wid = tid >> 6, lane = tid & 63;
  const bf16_t* HF = (const bf16_t*)(p.ws + OFF_HF); const bf16_t* HB = (const bf16_t*)(p.ws + OFF_HB); bf16_t* OZ = (bf16_t*)(p.ws + OFF_OZ);
  const float* nw = p.in[10];
  const int j = lane & 31, hl = lane >> 5;
  for (int it = blockIdx.x * 8 + wid; it < M_TOK * 4; it += gridDim.x * 8) {
    const size_t off = (size_t)(it >> 2) * 2048 + ((it & 3) * 2 + hl) * 256 + j * 8;
    float a[8], b[8], g[8], r[8]; unpack8(*(const u32x4*)(HF + off), a); unpack8(*(const u32x4*)(HB + off), b); unpack8(*(const u32x4*)(OZ + off), g);
    float ss = 0.f;
#pragma unroll
    for (int e = 0; e < 8; ++e) { a[e] += b[e]; ss += a[e] * a[e]; }
    ss += __shfl_xor(ss, 1); ss += __shfl_xor(ss, 2); ss += __shfl_xor(ss, 4); ss += __shfl_xor(ss, 8); ss += __shfl_xor(ss, 16);
    const float rs = rsqrtf(ss * (1.0f / 256.0f) + LN_EPS);
    const float* w = nw + ((it & 3) * 2 + hl) * 256 + j * 8;
#pragma unroll
    for (int e = 0; e < 8; ++e) r[e] = a[e] * rs * w[e] * g[e];
    *(u32x4*)(OZ + off) = pack8(r);
  }
}

__device__ void phase8_final_ln(const Params& p) {
  int tid_l = threadIdx.x; asm volatile("" : "+v"(tid_l)); const int tid = tid_l, wid = tid >> 6, lane = tid & 63;
  const float* lw = p.in[16]; const float* lb = p.in[17];
  for (int row = blockIdx.x * 8 + wid; row < M_TOK; row += gridDim.x * 8) {
    float4* r = (float4*)(p.out + (size_t)row * 2048);
    float4 v[8]; float s = 0.f;
#pragma unroll
    for (int i = 0; i < 8; ++i) { v[i] = r[lane + 64 * i]; s += (v[i].x + v[i].y) + (v[i].z + v[i].w); }
    s = wave_sum(s); const float mu = s * (1.f / 2048.f); float q = 0.f;
#pragma unroll
    for (int i = 0; i < 8; ++i) { const float a = v[i].x - mu, b = v[i].y - mu, c = v[i].z - mu, d = v[i].w - mu; q += (a * a + b * b) + (c * c + d * d); }
    q = wave_sum(q); const float rs = rsqrtf(q * (1.f / 2048.f) + LN_EPS);
#pragma unroll
    for (int i = 0; i < 8; ++i) { const float4 w = ((const float4*)lw)[lane + 64 * i], b = ((const float4*)lb)[lane + 64 * i];
      float4 y; y.x = (v[i].x - mu) * rs * w.x + b.x; y.y = (v[i].y - mu) * rs * w.y + b.y; y.z = (v[i].z - mu) * rs * w.z + b.z; y.w = (v[i].w - mu) * rs * w.w + b.w;
      r[lane + 64 * i] = y; }
  }
}

namespace att {
constexpr int D = 128, NW = 8, QBLK = 32, KVBLK = 64;
constexpr float SCALE = 0.088388347648318440f;
constexpr float THR = 8.f;
constexpr int LDQ = 2048, LDK = 512;
constexpr size_t SHM_V = KVBLK * D * 2, SHM_K = KVBLK * D * 2, SHM_ATTN = 2 * SHM_V + 2 * SHM_K + NW * 64 * 4;
#define KSWZ(row, colB) ((row) * 256 + ((colB) ^ (((row) & 7) << 4)))
#define SBAR() __builtin_amdgcn_sched_barrier(0)
__device__ __forceinline__ int crow(int r, int hi) { return (r & 3) + 8 * (r >> 2) + 4 * hi; }
__device__ __forceinline__ unsigned cvtpk(float lo, float hi) { unsigned r; asm volatile("v_cvt_pk_bf16_f32 %0, %1, %2" : "=v"(r) : "v"(lo), "v"(hi)); return r; }
__device__ __forceinline__ void partialSM(f32x16& p0, f32x16& p1, float& m_reg, float& mn, float& alpha) {
  constexpr float C = SCALE * 1.4426950408889634f;
  float pmax = p0[0]; for (int r = 1; r < 16; ++r) pmax = fmaxf(pmax, p0[r]); for (int r = 0; r < 16; ++r) pmax = fmaxf(pmax, p1[r]);
  { auto rr = __builtin_amdgcn_permlane32_swap(__float_as_uint(pmax), __float_as_uint(pmax), false, false);
    pmax = fmaxf(__uint_as_float(rr[0]), __uint_as_float(rr[1])); }
  if (__builtin_expect(__all(pmax - m_reg <= THR / SCALE), 1)) { mn = m_reg; alpha = 1.f; }
  else { mn = fmaxf(m_reg, pmax); alpha = __builtin_amdgcn_exp2f((m_reg - mn) * C); m_reg = mn; }
  float mnC = -mn * C;
  for (int r = 0; r < 16; ++r) p0[r] = fmaf(p0[r], C, mnC); for (int r = 0; r < 16; ++r) p1[r] = fmaf(p1[r], C, mnC);
  for (int r = 0; r < 16; ++r) p0[r] = __builtin_amdgcn_exp2f(p0[r]);
}
__device__ __forceinline__ void finishSM(f32x16& p0, f32x16& p1, float alpha, float& l_reg, bf16x8& pa0, bf16x8& pa1, bf16x8& pa2, bf16x8& pa3) {
  for (int r = 0; r < 16; ++r) p1[r] = __builtin_amdgcn_exp2f(p1[r]);
  float ps = 0; for (int r = 0; r < 16; ++r) ps += p0[r]; for (int r = 0; r < 16; ++r) ps += p1[r];
  { auto rr = __builtin_amdgcn_permlane32_swap(__float_as_uint(ps), __float_as_uint(ps), false, false);
    ps = __uint_as_float(rr[0]) + __uint_as_float(rr[1]); }
  l_reg = l_reg * alpha + ps;
#define PK4(P, BASE, OUT) do { unsigned a0 = cvtpk(P[BASE + 0], P[BASE + 1]), a1 = cvtpk(P[BASE + 2], P[BASE + 3]);   \
    unsigned b0 = cvtpk(P[BASE + 4], P[BASE + 5]), b1 = cvtpk(P[BASE + 6], P[BASE + 7]);                              \
    auto r0 = __builtin_amdgcn_permlane32_swap(a0, b0, false, false); auto r1 = __builtin_amdgcn_permlane32_swap(a1, b1, false, false); \
    u32x4 w = {r0[0], r1[0], r0[1], r1[1]}; OUT = *reinterpret_cast<bf16x8*>(&w); } while (0)
  PK4(p0, 0, pa0); PK4(p0, 8, pa1); PK4(p1, 0, pa2); PK4(p1, 8, pa3);
#undef PK4
}
__device__ __forceinline__ void qkt(f32x16& p0, f32x16& p1, const char* Ks, const bf16x8* qr, int r32, int hi) {
  p0 = f32x16{}; p1 = f32x16{};
  for (int d0 = 0; d0 < 8; ++d0) { int cb = (d0 * 16 + hi * 8) * 2;
    bf16x8 b0 = *reinterpret_cast<const bf16x8*>(Ks + KSWZ(r32, cb));
    bf16x8 b1 = *reinterpret_cast<const bf16x8*>(Ks + KSWZ(32 + r32, cb));
    p0 = __builtin_amdgcn_mfma_f32_32x32x16_bf16(b0, qr[d0], p0, 0, 0, 0);
    p1 = __builtin_amdgcn_mfma_f32_32x32x16_bf16(b1, qr[d0], p1, 0, 0, 0); }
}
__device__ __forceinline__ int v_st(int k, int c) { const int kk = (k & ~0xC) | ((k & 4) << 1) | ((k & 8) >> 1); return ((kk >> 3) * 4 + (c >> 5)) * 512 + ((kk & 7) * 32 + (c & 31)) * 2; }
__device__ __forceinline__ int v_rd_base(int lane) { return ((lane & 3) << 3) | (((lane >> 2) & 3) << 6) | (((lane >> 4) & 1) << 5) | (((lane >> 5) & 1) << 8); }
constexpr int v_rd_off(int d0, int ks, int half) { return d0 * 512 + ks * 4096 + half * 2048; }
template <int OFF> __device__ __forceinline__ s16x4 tr_read(int vb) {
  s16x4 r; asm volatile("ds_read_b64_tr_b16 %0, %1 offset:%2" : "=&v"(r) : "v"(vb), "i"(OFF) : "memory"); return r;
}
#define PKLH(L, H) (bf16x8){L[0], L[1], L[2], L[3], H[0], H[1], H[2], H[3]}
template <int D0> __device__ __forceinline__ void pv_one(f32x16& od, int vb, bf16x8 pa0, bf16x8 pa1, bf16x8 pa2, bf16x8 pa3) {
  const s16x4 l0 = tr_read<v_rd_off(D0, 0, 0)>(vb), h0 = tr_read<v_rd_off(D0, 0, 1)>(vb), l1 = tr_read<v_rd_off(D0, 1, 0)>(vb), h1 = tr_read<v_rd_off(D0, 1, 1)>(vb);
  const s16x4 l2 = tr_read<v_rd_off(D0, 2, 0)>(vb), h2 = tr_read<v_rd_off(D0, 2, 1)>(vb), l3 = tr_read<v_rd_off(D0, 3, 0)>(vb), h3 = tr_read<v_rd_off(D0, 3, 1)>(vb);
  asm volatile("s_waitcnt lgkmcnt(0)" ::: "memory"); SBAR();
  od = __builtin_amdgcn_mfma_f32_32x32x16_bf16(pa0, PKLH(l0, h0), od, 0, 0, 0);
  od = __builtin_amdgcn_mfma_f32_32x32x16_bf16(pa1, PKLH(l1, h1), od, 0, 0, 0);
  od = __builtin_amdgcn_mfma_f32_32x32x16_bf16(pa2, PKLH(l2, h2), od, 0, 0, 0);
  od = __builtin_amdgcn_mfma_f32_32x32x16_bf16(pa3, PKLH(l3, h3), od, 0, 0, 0);
}
__device__ __forceinline__ void pv_d0(f32x16* o, int vb, bf16x8 pa0, bf16x8 pa1, bf16x8 pa2, bf16x8 pa3) {
  pv_one<0>(o[0], vb, pa0, pa1, pa2, pa3); pv_one<1>(o[1], vb, pa0, pa1, pa2, pa3); pv_one<2>(o[2], vb, pa0, pa1, pa2, pa3); pv_one<3>(o[3], vb, pa0, pa1, pa2, pa3);
}
__device__ __forceinline__ void attn_dense_body(bf16_t* __restrict__ Qb, const bf16_t* __restrict__ Kh, const bf16_t* __restrict__ Vh, int seq, char* lds) {
  int tid_l = threadIdx.x; asm volatile("" : "+v"(tid_l)); const int tid = tid_l, wid = tid >> 6, lane = tid & 63, r32 = lane & 31, hi = lane >> 5;
  char* V_lds = lds; char* K_lds = lds + 2 * SHM_V;
  float* wsf = (float*)(lds + 2 * SHM_V + 2 * SHM_K) + wid * 64; float* li_l = wsf; float* al_l = wsf + 32;
  float m_reg = -1e30f, l_reg = 0; f32x16 o[4] = {}; bf16x8 qr[8];
  const bf16_t* Qw = Qb + (long)(wid * QBLK + r32) * LDQ + hi * 8;
#pragma unroll
  for (int d0 = 0; d0 < 8; ++d0) qr[d0] = *reinterpret_cast<const bf16x8*>(Qw + d0 * 16);
  const int sr = tid >> 4, sc = (tid & 15) * 8, vst0 = v_st(sr, sc), vst1 = v_st(32 + sr, sc);
  const int vb0 = (int)(uintptr_t)V_lds + v_rd_base(lane);
  struct { bf16x8 vs0, vs1, ks0, ks1; } sr_[1];
#define SLOAD(i, k0) do { sr_[i].vs0 = *reinterpret_cast<const bf16x8*>(&Vh[(long)((k0) + sr) * LDK + sc]); sr_[i].vs1 = *reinterpret_cast<const bf16x8*>(&Vh[(long)((k0) + 32 + sr) * LDK + sc]); \
    sr_[i].ks0 = *reinterpret_cast<const bf16x8*>(&Kh[(long)((k0) + sr) * LDK + sc]); sr_[i].ks1 = *reinterpret_cast<const bf16x8*>(&Kh[(long)((k0) + 32 + sr) * LDK + sc]); } while (0)
#define SWRITE(b, i) do { *(bf16x8*)(V_lds + (b) * SHM_V + vst0) = sr_[i].vs0;          \
    *(bf16x8*)(V_lds + (b) * SHM_V + vst1) = sr_[i].vs1; int kc = sc * 2;               \
    *(bf16x8*)(K_lds + (b) * SHM_K + KSWZ(sr, kc)) = sr_[i].ks0;                       \
    *(bf16x8*)(K_lds + (b) * SHM_K + KSWZ(32 + sr, kc)) = sr_[i].ks1; } while (0)
#define SWAIT() asm volatile("s_waitcnt vmcnt(0)" ::: "memory")
#define RESC(a) do { if (__any((a) < 1.f)) { if (hi == 0) al_l[r32] = (a); asm volatile("s_waitcnt lgkmcnt(0)" ::: "memory"); \
    for (int d = 0; d < 4; ++d) for (int r = 0; r < 16; ++r) o[d][r] *= al_l[crow(r, hi)]; } } while (0)
  f32x16 pA0, pA1, pB0, pB1; float mnA, mnB, alA, alB; bf16x8 pa0, pa1, pa2, pa3; const int NT = seq / KVBLK;
  constexpr int SE = 0, SO = 0;
  SLOAD(SE, 0); asm volatile("s_waitcnt vmcnt(0)" ::: "memory"); SWRITE(0, SE); __syncthreads();
  qkt(pA0, pA1, K_lds, qr, r32, hi); partialSM(pA0, pA1, m_reg, mnA, alA);
  SLOAD(SO, KVBLK);
  SWAIT(); SWRITE(1, SO); __syncthreads();
  for (int j = 1; j + 1 < NT; j += 2) {
    SBAR(); qkt(pB0, pB1, K_lds + SHM_K, qr, r32, hi);
    finishSM(pA0, pA1, alA, l_reg, pa0, pa1, pa2, pa3); SBAR();
    SLOAD(SO, (j + 1) * KVBLK); SBAR();
    pv_d0(o, vb0, pa0, pa1, pa2, pa3); partialSM(pB0, pB1, m_reg, mnB, alB);
    __syncthreads(); SWAIT(); SWRITE(0, SE);
    RESC(alB); __syncthreads();
    SBAR(); qkt(pA0, pA1, K_lds, qr, r32, hi);
    finishSM(pB0, pB1, alB, l_reg, pa0, pa1, pa2, pa3); SBAR();
    SLOAD(SE, (j + 2) * KVBLK); SBAR();
    pv_d0(o, vb0 + (int)SHM_V, pa0, pa1, pa2, pa3); partialSM(pA0, pA1, m_reg, mnA, alA);
    __syncthreads(); SWAIT(); SWRITE(1, SO);
    RESC(alA); __syncthreads();
  }
  SBAR(); qkt(pB0, pB1, K_lds + SHM_K, qr, r32, hi);
  finishSM(pA0, pA1, alA, l_reg, pa0, pa1, pa2, pa3); SBAR();
  pv_d0(o, vb0, pa0, pa1, pa2, pa3); partialSM(pB0, pB1, m_reg, mnB, alB);
  __syncthreads(); RESC(alB);
  finishSM(pB0, pB1, alB, l_reg, pa0, pa1, pa2, pa3); SBAR();
  pv_d0(o, vb0 + (int)SHM_V, pa0, pa1, pa2, pa3);
  if (hi == 0) li_l[r32] = l_reg; asm volatile("s_waitcnt lgkmcnt(0)" ::: "memory");
  float rli[16];
#pragma unroll
  for (int r = 0; r < 16; ++r) rli[r] = __builtin_amdgcn_rcpf(li_l[crow(r, hi)]);
  bf16_t* qo = Qb + (long)(wid * QBLK + 4 * hi) * LDQ + r32; const bf16_t* zo = qo + (long)((OFF_ZB - OFF_QB) / 2);
#pragma unroll
  for (int r = 0; r < 16; ++r) { const int ro = ((r & 3) + 8 * (r >> 2)) * LDQ;
    const float z0 = bf2f(zo[ro]), z1 = bf2f(zo[ro + 32]), z2 = bf2f(zo[ro + 64]), z3 = bf2f(zo[ro + 96]);
    const float v0 = o[0][r] * rli[r] * z0, v1 = o[1][r] * rli[r] * z1, v2 = o[2][r] * rli[r] * z2, v3 = o[3][r] * rli[r] * z3;
    qo[ro] = (bf16_t)(cvtpk(v0, v0) & 0xffffu); qo[ro + 32] = (bf16_t)(cvtpk(v1, v1) & 0xffffu); qo[ro + 64] = (bf16_t)(cvtpk(v2, v2) & 0xffffu); qo[ro + 96] = (bf16_t)(cvtpk(v3, v3) & 0xffffu);
    asm volatile("" ::: "memory"); }
#undef SLOAD
#undef SWRITE
#undef SWAIT
#undef RESC
}
}

namespace ml {
using att::crow; using att::cvtpk; using att::v_st; using att::v_rd_base; using att::v_rd_off; using att::tr_read;
constexpr int O_QS = 0, O_KS = 17408, O_C0 = 34816, O_KTR = 52224, O_VTR = 68608, O_SP = 84992, O_F = 94208;
constexpr int NCH = 132;
template <int KS> __device__ __forceinline__ bf16x8 trfrag(int vb) {
  const s16x4 l = tr_read<v_rd_off(0, KS, 0)>(vb), h = tr_read<v_rd_off(0, KS, 1)>(vb);
  asm volatile("s_waitcnt lgkmcnt(0)" ::: "memory");
  return PKLH(l, h);
}
__device__ __forceinline__ bf16x8 scale_frag(bf16x8 v, const float* we) {
  const u32x4 w = *reinterpret_cast<const u32x4*>(&v); float f[8]; unpack8(w, f);
  const float4 s0 = *(const float4*)we, s1 = *(const float4*)(we + 4);
  f[0] *= s0.x; f[1] *= s0.y; f[2] *= s0.z; f[3] *= s0.w; f[4] *= s1.x; f[5] *= s1.y; f[6] *= s1.z; f[7] *= s1.w;
  const u32x4 o = pack8(f); return *reinterpret_cast<const bf16x8*>(&o);
}
__device__ __forceinline__ int chunk_row0(int c, int b, bool rev) {
  if (!rev) return c < 4 ? M_TOK + b * CTXL + 64 * c : b * SEQ + 64 * (c - 4);
  return c < 4 ? M_TOK + b * CTXL + 64 * (3 - c) : b * SEQ + 64 * (131 - c);
}
__device__ void mlstm_scan(const Params& p, char* lds, int item) {
  int tid_l = threadIdx.x; asm volatile("" : "+v"(tid_l)); const int tid = tid_l, wid = __builtin_amdgcn_readfirstlane(tid >> 6), lane = tid & 63, r32 = lane & 31, hi = lane >> 5;
  const int dir = item & 1, vs = (item >> 1) & 3, bh = item >> 3, b = bh >> 3, h = bh & 7;
  const bool rev = dir != 0;
  const bf16_t* QK = (const bf16_t*)(p.ws + OFF_QAKA); const bf16_t* VA = (const bf16_t*)(p.ws + OFF_VA); const float* GT = (const float*)(p.ws + OFF_GATES);
  bf16_t* H = (bf16_t*)(p.ws + (rev ? OFF_HB : OFF_HF));
  float* F = (float*)(lds + O_F); float *G = F, *MX = F + 64, *A = F + 128, *EM = F + 192, *WE = F + 256, *NQ = F + 320, *RS = F + 384, *N0 = F + 512, *SC = F + 640;
  for (int i = tid; i < 64 * 272 / 4; i += 512) ((unsigned*)(lds + O_C0))[i] = 0u;
  if (tid < 128) N0[tid] = 0.f;
  f32x16 cacc = {}; f32x16 acc1 = {}; float nreg = 0.f, m0 = -1e30f;
  const float bi = p.in[7][dir * 16 + h], bfb = p.in[7][dir * 16 + 8 + h];
  const int qrow0 = tid >> 4, qc = (tid & 15) * 8, vrow = tid >> 3, vc = (tid & 7) * 8;
  const int jnat = rev ? 63 - lane : lane;
  bf16x8 q0, q1, k0, k1, v0; float gi = 0.f, gf = 0.f;
  { const int R0 = chunk_row0(0, b, rev); const bf16_t* qp = QK + (size_t)(R0 + qrow0) * 2048 + h * 128 + qc;
    q0 = *(const bf16x8*)qp; q1 = *(const bf16x8*)(qp + 32 * 2048); k0 = *(const bf16x8*)(qp + 1024); k1 = *(const bf16x8*)(qp + 1024 + 32 * 2048);
    v0 = *(const bf16x8*)(VA + (size_t)(R0 + vrow) * 2048 + h * 256 + vs * 64 + vc);
    if (wid == 0) { gi = GT[(size_t)(R0 + jnat) * 32 + dir * 16 + h]; gf = GT[(size_t)(R0 + jnat) * 32 + dir * 16 + 8 + h]; } }
  const int w4 = wid & 3, t_hi = w4 >> 1, t_lo = w4 & 1;
  for (int c = 0; c < NCH; ++c) {
    const int R0 = chunk_row0(c, b, rev); const bool isctx = c < 4;
    __syncthreads();
    *(bf16x8*)(lds + O_QS + qrow0 * 272 + qc * 2) = q0; *(bf16x8*)(lds + O_QS + (qrow0 + 32) * 272 + qc * 2) = q1;
    *(bf16x8*)(lds + O_KS + qrow0 * 272 + qc * 2) = k0; *(bf16x8*)(lds + O_KS + (qrow0 + 32) * 272 + qc * 2) = k1;
    *(bf16x8*)(lds + O_KTR + v_st(qrow0, qc)) = k0; *(bf16x8*)(lds + O_KTR + v_st(qrow0 + 32, qc)) = k1;
    *(bf16x8*)(lds + O_VTR + v_st(vrow, vc)) = v0;
    const float gi_c = gi, gf_c = gf;
    if (c + 1 < NCH) { const int R1 = chunk_row0(c + 1, b, rev); const bf16_t* qp = QK + (size_t)(R1 + qrow0) * 2048 + h * 128 + qc;
      q0 = *(const bf16x8*)qp; q1 = *(const bf16x8*)(qp + 32 * 2048); k0 = *(const bf16x8*)(qp + 1024); k1 = *(const bf16x8*)(qp + 1024 + 32 * 2048);
      v0 = *(const bf16x8*)(VA + (size_t)(R1 + vrow) * 2048 + h * 256 + vs * 64 + vc);
      if (wid == 0) { gi = GT[(size_t)(R1 + jnat) * 32 + dir * 16 + h]; gf = GT[(size_t)(R1 + jnat) * 32 + dir * 16 + 8 + h]; } }
    if (wid == 0) {
      const float li = gi_c + bi, xf = gf_c + bfb; const float lf = fminf(xf, 0.f) - log1pf(__expf(-fabsf(xf)));
      float bb = lf;
#pragma unroll
      for (int o = 1; o < 64; o <<= 1) { const float t = __shfl_up(bb, o); if (lane >= o) bb += t; }
      const float g = li - bb; float cm = g;
#pragma unroll
      for (int o = 1; o < 64; o <<= 1) { const float t = __shfl_up(cm, o); if (lane >= o) cm = fmaxf(cm, t); }
      const float Mx = fmaxf(m0, cm), m = bb + Mx, a = __expf(m0 - Mx), em = __expf(-m);
      const float bL = __shfl(bb, 63), ML = __shfl(Mx, 63), aend = __shfl(a, 63);
      G[jnat] = g; MX[jnat] = Mx; A[jnat] = a; EM[jnat] = em; WE[jnat] = __expf(g - ML); if (lane == 0) SC[0] = aend;
      m0 = bL + ML;
    }
    __syncthreads();
    if (wid < 4) {
      f32x16 pS = {};
      const char* ka = lds + O_KS + (32 * t_hi + r32) * 272 + hi * 16; const char* qb = lds + O_QS + (32 * t_lo + r32) * 272 + hi * 16;
#pragma unroll
      for (int d0 = 0; d0 < 8; ++d0) pS = __builtin_amdgcn_mfma_f32_32x32x16_bf16(*(const bf16x8*)(ka + d0 * 32), *(const bf16x8*)(qb + d0 * 32), pS, 0, 0, 0);
      const int j = 32 * t_lo + r32; const float mxj = MX[j]; float ps = 0.f;
#pragma unroll
      for (int r = 0; r < 16; ++r) { const int s = 32 * t_hi + crow(r, hi); const bool ok = rev ? (s >= j) : (s <= j);
        const float wv = ok ? __expf(G[s] - mxj) : 0.f; pS[r] *= wv; ps += pS[r]; }
      ps += __shfl_xor(ps, 32); if (hi == 0) RS[t_hi * 64 + j] = ps;
#pragma unroll
      for (int g4 = 0; g4 < 4; ++g4) { u32x2 w; w.x = cvtpk(pS[4 * g4], pS[4 * g4 + 1]); w.y = cvtpk(pS[4 * g4 + 2], pS[4 * g4 + 3]);
        *(u32x2*)(lds + O_SP + j * 144 + (32 * t_hi + 8 * g4 + 4 * hi) * 2) = w; }
    } else {
      acc1 = f32x16{};
      const char* ca = lds + O_C0 + (32 * t_hi + r32) * 272 + hi * 16; const char* qb = lds + O_QS + (32 * t_lo + r32) * 272 + hi * 16;
#pragma unroll
      for (int d0 = 0; d0 < 8; ++d0) acc1 = __builtin_amdgcn_mfma_f32_32x32x16_bf16(*(const bf16x8*)(ca + d0 * 32), *(const bf16x8*)(qb + d0 * 32), acc1, 0, 0, 0);
      const int t4 = tid - 256, jq = t4 >> 2, part = t4 & 3; float sum = 0.f;
      const char* qrow = lds + O_QS + jq * 272 + part * 64;
#pragma unroll
      for (int i = 0; i < 4; ++i) { float f[8]; unpack8(*(const u32x4*)(qrow + 16 * i), f);
#pragma unroll
        for (int e = 0; e < 8; ++e) sum += f[e] * N0[part * 32 + 8 * i + e]; }
      sum += __shfl_xor(sum, 1); sum += __shfl_xor(sum, 2); if (part == 0) NQ[jq] = sum;
    }
    __syncthreads();
    const float aend = SC[0];
    if (wid >= 4) {
      f32x16 acc2 = {};
      const int vbv = (int)(uintptr_t)(lds + O_VTR) + v_rd_base(lane) + t_hi * 512;
      const char* sb = lds + O_SP + (32 * t_lo + r32) * 144 + hi * 16;
      { const bf16x8 a = trfrag<0>(vbv); acc2 = __builtin_amdgcn_mfma_f32_32x32x16_bf16(a, *(const bf16x8*)(sb), acc2, 0, 0, 0); }
      { const bf16x8 a = trfrag<1>(vbv); acc2 = __builtin_amdgcn_mfma_f32_32x32x16_bf16(a, *(const bf16x8*)(sb + 32), acc2, 0, 0, 0); }
      { const bf16x8 a = trfrag<2>(vbv); acc2 = __builtin_amdgcn_mfma_f32_32x32x16_bf16(a, *(const bf16x8*)(sb + 64), acc2, 0, 0, 0); }
      { const bf16x8 a = trfrag<3>(vbv); acc2 = __builtin_amdgcn_mfma_f32_32x32x16_bf16(a, *(const bf16x8*)(sb + 96), acc2, 0, 0, 0); }
      const int j = 32 * t_lo + r32; const float aj = A[j]; const float den = aj * NQ[j] + RS[j] + RS[64 + j];
      const float inv = 1.0f / fmaxf(fabsf(den), EM[j]);
      if (!isctx) { bf16_t* hp = H + (size_t)(R0 + j) * 2048 + h * 256 + vs * 64 + 32 * t_hi + 4 * hi;
#pragma unroll
        for (int g4 = 0; g4 < 4; ++g4) { u32x2 w; w.x = cvtpk((aj * acc1[4 * g4] + acc2[4 * g4]) * inv, (aj * acc1[4 * g4 + 1] + acc2[4 * g4 + 1]) * inv);
          w.y = cvtpk((aj * acc1[4 * g4 + 2] + acc2[4 * g4 + 2]) * inv, (aj * acc1[4 * g4 + 3] + acc2[4 * g4 + 3]) * inv);
          *(u32x2*)(hp + 8 * g4) = w; } }
    }
    if (tid < 128) { float s = 0.f;
#pragma unroll 8
      for (int si = 0; si < 64; ++si) s += WE[si] * bf2f(*(const bf16_t*)(lds + O_KS + si * 272 + tid * 2));
      nreg = aend * nreg + s; N0[tid] = nreg; }
    { const int dt = wid & 3, vt2 = wid >> 2;
      const int kb = (int)(uintptr_t)(lds + O_KTR) + v_rd_base(lane) + dt * 512;
      const int vb2 = (int)(uintptr_t)(lds + O_VTR) + v_rd_base(lane) + vt2 * 512;
#pragma unroll
      for (int r = 0; r < 16; ++r) cacc[r] *= aend;
      { const bf16x8 a = trfrag<0>(kb); const bf16x8 bv = scale_frag(trfrag<0>(vb2), WE + 0 + 8 * hi); cacc = __builtin_amdgcn_mfma_f32_32x32x16_bf16(a, bv, cacc, 0, 0, 0); }
      { const bf16x8 a = trfrag<1>(kb); const bf16x8 bv = scale_frag(trfrag<1>(vb2), WE + 16 + 8 * hi); cacc = __builtin_amdgcn_mfma_f32_32x32x16_bf16(a, bv, cacc, 0, 0, 0); }
      { const bf16x8 a = trfrag<2>(kb); const bf16x8 bv = scale_frag(trfrag<2>(vb2), WE + 32 + 8 * hi); cacc = __builtin_amdgcn_mfma_f32_32x32x16_bf16(a, bv, cacc, 0, 0, 0); }
      { const bf16x8 a = trfrag<3>(kb); const bf16x8 bv = scale_frag(trfrag<3>(vb2), WE + 48 + 8 * hi); cacc = __builtin_amdgcn_mfma_f32_32x32x16_bf16(a, bv, cacc, 0, 0, 0); }
#pragma unroll
      for (int g4 = 0; g4 < 4; ++g4) { u32x2 w; w.x = cvtpk(cacc[4 * g4], cacc[4 * g4 + 1]); w.y = cvtpk(cacc[4 * g4 + 2], cacc[4 * g4 + 3]);
        *(u32x2*)(lds + O_C0 + (32 * vt2 + r32) * 272 + (32 * dt + 8 * g4 + 4 * hi) * 2) = w; }
    }
  }
  __syncthreads();
}
}

__device__ void phase4_mixers(const Params& p, char* lds) {
  for (int item = blockIdx.x; item < 256; item += gridDim.x) ml::mlstm_scan(p, lds, item);
  bf16_t* QB = (bf16_t*)(p.ws + OFF_QB);
  const bf16_t* KA = (const bf16_t*)(p.ws + OFF_KALL); const bf16_t* VAl = (const bf16_t*)(p.ws + OFF_VALL);
  for (int i = blockIdx.x; i < 2048; i += gridDim.x) {
    const int g = i >> 7, b = g >> 2, kvh = g & 3, hq = kvh * 4 + ((i >> 5) & 3), qb = i & 31;
    const size_t qoff = (size_t)(b * SEQ + qb * 256) * 2048 + hq * 128, koff = (size_t)b * SKV * 512 + kvh * 128;
    att::attn_dense_body(QB + qoff, KA + koff, VAl + koff, SKV, lds);
    __syncthreads();
  }
}

__global__ void __launch_bounds__(512, 2) fwd_megakernel(Params p) {
  extern __shared__ __attribute__((aligned(16))) unsigned char lds[];
  cg::grid_group grid = cg::this_grid();
  unsigned char* ws = p.ws;
  PG8_LAS unsigned char* lds3 = (PG8_LAS unsigned char*)lds;
  phase0_prep(p, lds);
  grid.sync();
  phase1_ln_mod(p);
  grid.sync();
  { pg8::Gemm g{(const bf16_t*)(ws + OFF_U), (const bf16_t*)(ws + OFF_WT_IN), M_ALL, N1P, 2048}; pg8::StaticOrder S; S.init(M_ALL, N1P, (int)gridDim.x, (int)blockIdx.x);
    Epi1 E{ws, (unsigned char*)p.out}; pg8::gemm_phase<Epi1, pg8::StaticOrder>(lds3, g, S, E); }
  grid.sync();
  phase3_elem(p);
  grid.sync();
  phase4_mixers(p, (char*)lds);
  grid.sync();
  phase5_gate(p);
  grid.sync();
  { pg8::Gemm g{(const bf16_t*)(ws + OFF_OZ), (const bf16_t*)(ws + OFF_WT_BA), M_TOK, 2048, 2048}; pg8::StaticOrder S; S.init(M_TOK, 2048, (int)gridDim.x, (int)blockIdx.x);
    Epi2a E{(float*)(ws + OFF_TMP), (const bf16_t*)p.out}; pg8::gemm_phase<Epi2a, pg8::StaticOrder>(lds3, g, S, E); }
  __syncthreads();
  { pg8::Gemm g{(const bf16_t*)(ws + OFF_QB), (const bf16_t*)(ws + OFF_WT_BB), M_TOK, 2048, 2048}; pg8::StaticOrder S; S.init(M_TOK, 2048, (int)gridDim.x, (int)blockIdx.x);
    Epi2b E{(const float*)(ws + OFF_TMP), (const bf16_t*)p.out + (size_t)M_TOK * 2048, (bf16_t*)(ws + OFF_MERGED)}; pg8::gemm_phase<Epi2b, pg8::StaticOrder>(lds3, g, S, E); }
  grid.sync();
  { pg8::Gemm g{(const bf16_t*)(ws + OFF_MERGED), (const bf16_t*)(ws + OFF_WT_OUT), M_TOK, 2048, 2048}; pg8::StaticOrder S; S.init(M_TOK, 2048, (int)gridDim.x, (int)blockIdx.x);
    Epi3 E{p.in[0], (const float*)(ws + OFF_MOD), p.out}; pg8::gemm_phase<Epi3, pg8::StaticOrder>(lds3, g, S, E); }
  grid.sync();
  phase8_final_ln(p);
}

extern "C" void kernel_launch(void* const* d_in, const int* in_sizes, int n_in, void* d_out, int out_size, void* d_ws, size_t ws_size, hipStream_t stream) {
  static int grid_blocks = 0;
  if (!grid_blocks) {
    if (n_in != 18 || out_size != M_TOK * DM || ws_size < WS_END) { fprintf(stderr, "kernel_launch: unexpected shapes (n_in %d out %d ws %zu need %zu)\n", n_in, out_size, ws_size, (size_t)WS_END); grid_blocks = -1; return; }
    int dev = 0, cus = 0, per_cu = 0;
    (void)hipGetDevice(&dev);
    (void)hipDeviceGetAttribute(&cus, hipDeviceAttributeMultiprocessorCount, dev);
    (void)hipFuncSetAttribute((const void*)fwd_megakernel, hipFuncAttributeMaxDynamicSharedMemorySize, LDS_BYTES);
    (void)hipOccupancyMaxActiveBlocksPerMultiprocessor(&per_cu, fwd_megakernel, 512, LDS_BYTES);
    if (per_cu < 1) per_cu = 1;
    grid_blocks = cus * per_cu;
  }
  if (grid_blocks < 0) return;
  Params p{};
  for (int i = 0; i < 18; ++i) p.in[i] = (const float*)d_in[i];
  p.out = (float*)d_out; p.ws = (unsigned char*)d_ws;
  void* args[] = {&p};
  hipError_t e = hipLaunchCooperativeKernel((void*)fwd_megakernel, dim3(grid_blocks), dim3(512), args, LDS_BYTES, stream);
  if (e != hipSuccess) fprintf(stderr, "cooperative launch failed: %s (grid %d)\n", hipGetErrorString(e), grid_blocks);
}
```

```cpp
#include <hip/hip_runtime.h>
#include <hip/hip_cooperative_groups.h>
#include <cstdio>
#include <cstdint>
namespace cg = cooperative_groups;

constexpr int DM = 2048, NB = 4, SEQ = 8192, CTXL = 256;
constexpr int M_TOK = NB * SEQ, M_CTX = NB * CTXL, M_ALL = M_TOK + M_CTX;
constexpr int SKV = CTXL + SEQ;
constexpr int N_IN = 17440, N1P = 17664;
constexpr float LN_EPS = 1e-6f;
constexpr float ALPHA_DN = 1.189207115002721f;
constexpr int LDS_BYTES = 132 * 1024;

constexpr size_t SZ_W2 = (size_t)2048 * 2048 * 2;
constexpr size_t SZ_ALL = (size_t)M_ALL * 2048 * 2;
constexpr size_t SZ_TOK = (size_t)M_TOK * 2048 * 2;
constexpr size_t SZ_KV = (size_t)NB * SKV * 512 * 2;
constexpr size_t OFF_WT_BA = 0, OFF_WT_BB = SZ_W2, OFF_WT_OUT = 2 * SZ_W2;
constexpr size_t OFF_MOD = 3 * SZ_W2;
constexpr size_t OFF_ROPE = OFF_MOD + 131072;
constexpr size_t OFF_U = OFF_ROPE + 32768;
constexpr size_t OFF_QAKA = OFF_U;
constexpr size_t OFF_QKPRE = OFF_U + SZ_ALL;
constexpr size_t OFF_HF = OFF_QKPRE, OFF_MERGED = OFF_QKPRE;
constexpr size_t OFF_OZ = OFF_QKPRE + SZ_ALL;
constexpr size_t OFF_QB = OFF_OZ + SZ_TOK;
constexpr size_t OFF_ZB = OFF_QB + SZ_TOK;
constexpr size_t OFF_TMP = OFF_ZB;
constexpr size_t OFF_VA = OFF_ZB + SZ_TOK;
constexpr size_t OFF_VALL = OFF_VA + SZ_ALL;
constexpr size_t OFF_KALL = OFF_VALL + SZ_KV;
constexpr size_t OFF_GATES = OFF_KALL + SZ_KV;
constexpr size_t OFF_KBRAW = OFF_GATES + (size_t)M_ALL * 32 * 4;
constexpr size_t OFF_HB = OFF_KBRAW;
constexpr size_t OFF_WT_IN = OFF_KBRAW + SZ_KV;
constexpr size_t WS_END = OFF_HB + SZ_TOK;
static_assert(OFF_WT_IN + (size_t)N1P * 2048 * 2 <= WS_END, "ws map");
static_assert(OFF_TMP + (size_t)M_TOK * 2048 * 4 <= OFF_VALL, "tmp map");
static_assert(OFF_U % 256 == 0 && OFF_GATES % 256 == 0 && OFF_KBRAW % 256 == 0, "align");

typedef unsigned short bf16_t;
using f32x16 = __attribute__((ext_vector_type(16))) float;
using s16x4 = __attribute__((ext_vector_type(4))) short;
using u32x2 = __attribute__((ext_vector_type(2))) unsigned;

struct Params { const float* in[18]; float* out; unsigned char* ws; };

__device__ __forceinline__ float wave_sum(float v) {
#pragma unroll
  for (int o = 32; o >= 1; o >>= 1) v += __shfl_xor(v, o);
  return v;
}
__device__ __forceinline__ float bf2f(unsigned short b) { return __uint_as_float(((unsigned)b) << 16); }
__device__ __forceinline__ float bflo(unsigned w) { return __uint_as_float(w << 16); }
__device__ __forceinline__ float bfhi(unsigned w) { return __uint_as_float(w & 0xffff0000u); }
__device__ __forceinline__ float sigmoidf_(float x) { return __builtin_amdgcn_rcpf(1.0f + __expf(-x)); }
__device__ __forceinline__ float siluf_(float x) { return x * __builtin_amdgcn_rcpf(1.0f + __expf(-x)); }
namespace pg8 {
#define PG8_LAS __attribute__((address_space(3)))
typedef unsigned short bf16_t;
typedef short bf16x8 __attribute__((ext_vector_type(8)));
typedef float f32x4 __attribute__((ext_vector_type(4)));
typedef unsigned u32x4 __attribute__((ext_vector_type(4)));
constexpr int BM = 256, BK = 64, HALF = 128, HTB = HALF * BK * 2  , STAGE_BYTES = 8 * HTB, NXCD = 8, WGM = 8;

__host__ __device__ __forceinline__ int lds_byte(int r, int c) { const int st = (r >> 4) * 2 + (c >> 5), rr = r & 15, cc = c & 31, ob = rr * 64 + cc * 2; return st * 1024 + (ob ^ (((ob >> 9) & 1) << 5)); }
__host__ __device__ __forceinline__ void stage_rc(int b, int& R, int& C) { const int st = b / 1024, sb = b % 1024, swz = sb ^ (((sb >> 9) & 1) << 5); R = (st >> 1) * 16 + swz / 64; C = (st & 1) * 32 + (swz % 64) / 2; }
__host__ __device__ __forceinline__ int perm32(int rho) { const int n = rho >> 4, i = rho & 15; return 8 * (i >> 2) + 4 * n + (i & 3); }

struct Unit { int pm, pn; };
struct Gemm { const bf16_t* A; const bf16_t* Bt; int M, N, K; };

struct StaticOrder {
    int nM, nN, nwg, G, c;
    __host__ __device__ void init(int M, int N, int G_, int c_) { nM = M / BM; nN = N / BM; nwg = nM * nN; G = G_; c = c_; }
    __host__ __device__ bool next(int i, Unit& u) const {
        const long L = (long)i * G + c; if (L >= nwg) return false;
        int wgid = (int)L; { const int q = nwg / NXCD, r = nwg % NXCD, xcd = wgid % NXCD, off = wgid / NXCD; wgid = (xcd < r ? xcd * (q + 1) : r * (q + 1) + (xcd - r) * q) + off; }
        const int nig = WGM * nN, gid = wgid / nig, fm = gid * WGM, gsz = (nM - fm) < WGM ? (nM - fm) : WGM;
        u.pm = fm + ((wgid % nig) % gsz); u.pn = (wgid % nig) / gsz; return true;
    }
    __device__ __forceinline__ void a_ready(const Unit&) const {}
    __device__ __forceinline__ void done(const Unit&) const {}
};
__device__ __forceinline__ unsigned cvt_pk_bf16(float lo, float hi) { unsigned r; asm volatile("v_cvt_pk_bf16_f32 %0, %1, %2" : "=v"(r) : "v"(lo), "v"(hi)); return r; }
template <class Epi, class Sched>
__device__ __forceinline__ void gemm_phase(PG8_LAS unsigned char* lds, const Gemm g, const Sched& S, const Epi& E) {
    int tid_l = threadIdx.x; asm volatile("" : "+v"(tid_l)); const int tid = tid_l, wid = __builtin_amdgcn_readfirstlane(tid >> 6), lane = tid & 63, wr = wid >> 2, wc = wid & 3, fr = lane & 15, fq = lane >> 4;
    const int K = g.K, nt = K / BK;
    unsigned voffA[2], voffB[2];
#pragma unroll
    for (int i = 0; i < 2; ++i) { int R, C; stage_rc(tid * 16 + i * 8192, R, C); const int Rb = Epi::PERM ? ((R & ~31) + perm32(R & 31)) : R;
        voffA[i] = (unsigned)(R * K + C) * 2u; voffB[i] = (unsigned)(Rb * K + C) * 2u; }
    const size_t kstep = (size_t)(BK * 2);
    const size_t hstep = (size_t)HALF * K * 2;
    const size_t tstep = 2 * hstep;
    const unsigned ldsw = (unsigned)wid * 1024u;
    const int aoff = lds_byte(wr * 64 + fr, fq * 8), boff = lds_byte(wc * 32 + fr, fq * 8);
#define PG8_SA(b, h) (((b) * 2 + (h)) * HTB)
#define PG8_SB(b, h) ((4 + (b) * 2 + (h)) * HTB)
#define PG8_STAGE(bufoff, gbase, voff) do { _Pragma("unroll") for (int _i = 0; _i < 2; ++_i) \
        __builtin_amdgcn_global_load_lds((const unsigned*)((const char*)(gbase) + (voff)[_i]), (PG8_LAS unsigned*)(lds + (bufoff) + ldsw + _i * 8192), 16, 0, 0); } while (0)
#define PG8_LDA(dst, b, h) do { _Pragma("unroll") for (int m = 0; m < 4; ++m) _Pragma("unroll") for (int k = 0; k < 2; ++k) dst[m][k] = *(const PG8_LAS bf16x8*)(lds + PG8_SA(b, h) + aoff + m * 2048 + k * 1024); } while (0)
#define PG8_LDB(dst, b, h) do { _Pragma("unroll") for (int n = 0; n < 2; ++n) _Pragma("unroll") for (int k = 0; k < 2; ++k) dst[n][k] = *(const PG8_LAS bf16x8*)(lds + PG8_SB(b, h) + boff + n * 2048 + k * 1024); } while (0)
#define PG8_MMA(ai, bj, At, Bt) do { __builtin_amdgcn_s_setprio(1); _Pragma("unroll") for (int m = 0; m < 4; ++m) _Pragma("unroll") for (int n = 0; n < 2; ++n) _Pragma("unroll") for (int k = 0; k < 2; ++k) \
        acc[ai][bj][m][n] = __builtin_amdgcn_mfma_f32_16x16x32_bf16(Bt[n][k], At[m][k], acc[ai][bj][m][n], 0, 0, 0); __builtin_amdgcn_s_setprio(0); } while (0)
#define PG8_WAIT_V(n) asm volatile("s_waitcnt vmcnt(" #n ")" ::: "memory")
#define PG8_WAIT_L(n) asm volatile("s_waitcnt lgkmcnt(" #n ")" ::: "memory")
#define PG8_BAR __builtin_amdgcn_s_barrier()
#define PG8_SCHED __builtin_amdgcn_sched_barrier(0)
    Unit cur, nxt; int ui = 0;
    if (!S.next(0, cur)) return;
    f32x4 acc[2][2][4][2];
#pragma unroll
    for (int a = 0; a < 2; ++a)
#pragma unroll
        for (int b = 0; b < 2; ++b)
#pragma unroll
            for (int m = 0; m < 4; ++m)
#pragma unroll
                for (int n = 0; n < 2; ++n) acc[a][b][m][n] = (f32x4){0.f, 0.f, 0.f, 0.f};
    bf16x8 At[4][2], B0[2][2], B1[2][2];
    const char* cA = (const char*)g.A + (size_t)cur.pm * tstep; const char* cB = (const char*)g.Bt + (size_t)cur.pn * tstep;
    S.a_ready(cur);
    PG8_STAGE(PG8_SB(0, 0), cB, voffB); PG8_STAGE(PG8_SA(0, 0), cA, voffA); PG8_STAGE(PG8_SB(0, 1), cB + hstep, voffB); PG8_STAGE(PG8_SA(0, 1), cA + hstep, voffA);
    if (wr == 1) PG8_BAR;
    PG8_WAIT_V(4); PG8_BAR;
    PG8_STAGE(PG8_SB(1, 0), cB + kstep, voffB); PG8_STAGE(PG8_SA(1, 0), cA + kstep, voffA); PG8_STAGE(PG8_SB(1, 1), cB + hstep + kstep, voffB);
    PG8_WAIT_V(6); PG8_BAR;
    for (;;) {
        const bool has_next = S.next(ui + 1, nxt);
        const char* nA = has_next ? (const char*)g.A + (size_t)nxt.pm * tstep : cA; const char* nB = has_next ? (const char*)g.Bt + (size_t)nxt.pn * tstep : cB;
        for (int t = 0; t < nt; t += 2) {
            const bool last = (t == nt - 2);
            const char* a1 = cA + (size_t)(t + 1) * kstep;
            const char* a2 = last ? nA : cA + (size_t)(t + 2) * kstep; const char* b2 = last ? nB : cB + (size_t)(t + 2) * kstep;
            const char* a3 = a2 + kstep; const char* b3 = b2 + kstep;
            if (last && has_next) S.a_ready(nxt);
            PG8_LDB(B0, 0, 0); PG8_SCHED; PG8_LDA(At, 0, 0); PG8_STAGE(PG8_SA(1, 1), a1 + hstep, voffA);
            PG8_WAIT_L(8); PG8_BAR; PG8_WAIT_L(0); PG8_MMA(0, 0, At, B0); PG8_BAR; PG8_SCHED;
            PG8_LDB(B1, 0, 1); PG8_STAGE(PG8_SB(0, 0), b2, voffB);
            PG8_BAR; PG8_WAIT_L(0); PG8_MMA(0, 1, At, B1); PG8_BAR;
            PG8_LDA(At, 0, 1); PG8_STAGE(PG8_SA(0, 0), a2, voffA);
            PG8_BAR; PG8_WAIT_L(0); PG8_MMA(1, 0, At, B0); PG8_BAR; PG8_SCHED;
            PG8_STAGE(PG8_SB(0, 1), b2 + hstep, voffB);
            PG8_WAIT_V(6); PG8_BAR; PG8_MMA(1, 1, At, B1); PG8_BAR;
            PG8_LDB(B0, 1, 0); PG8_SCHED; PG8_LDA(At, 1, 0); PG8_STAGE(PG8_SA(0, 1), a2 + hstep, voffA);
            PG8_WAIT_L(8); PG8_BAR; PG8_WAIT_L(0); PG8_MMA(0, 0, At, B0); PG8_BAR; PG8_SCHED;
            PG8_LDB(B1, 1, 1); PG8_STAGE(PG8_SB(1, 0), b3, voffB);
            PG8_BAR; PG8_WAIT_L(0); PG8_MMA(0, 1, At, B1); PG8_BAR;
            PG8_LDA(At, 1, 1); PG8_STAGE(PG8_SA(1, 0), a3, voffA);
            PG8_BAR; PG8_WAIT_L(0); PG8_MMA(1, 0, At, B0); PG8_BAR; PG8_SCHED;
            PG8_STAGE(PG8_SB(1, 1), b3 + hstep, voffB);
            PG8_WAIT_V(6); PG8_BAR; PG8_MMA(1, 1, At, B1); PG8_BAR;
        }
        if constexpr (!Epi::AFTER_DRAIN) { E(acc, cur, wr, wc, fr, fq); S.done(cur); }
        if (!has_next) break;
#pragma unroll
        for (int a = 0; a < 2; ++a)
#pragma unroll
            for (int b = 0; b < 2; ++b)
#pragma unroll
                for (int m = 0; m < 4; ++m)
#pragma unroll
                    for (int n = 0; n < 2; ++n) acc[a][b][m][n] = (f32x4){0.f, 0.f, 0.f, 0.f};
        cur = nxt; cA = nA; cB = nB; ++ui;
    }
    PG8_WAIT_V(0);
    if (wr == 0) PG8_BAR;
    PG8_BAR;
    if constexpr (Epi::AFTER_DRAIN) { E.fused(acc, cur, wr, wc, fr, fq, lds, wid, lane); S.done(cur); }
#undef PG8_SA
#undef PG8_SB
#undef PG8_STAGE
#undef PG8_LDA
#undef PG8_LDB
#undef PG8_MMA
#undef PG8_WAIT_V
#undef PG8_WAIT_L
#undef PG8_BAR
#undef PG8_SCHED
}
}


using pg8::f32x4; using pg8::u32x4; using pg8::bf16x8; using pg8::cvt_pk_bf16;

struct Epi1 {
  static constexpr bool PERM = true, AFTER_DRAIN = false;
  unsigned char* ws; unsigned char* dout;
  __device__ __forceinline__ void operator()(const f32x4 (&acc)[2][2][4][2], const pg8::Unit& u, int wr, int wc, int fr, int fq) const {
    const int pn = u.pn, pm = u.pm; const bool lat = pm < 128;
    const int rl = wr * 64 + fr, cl = wc * 32 + 8 * fq;
    if (pn == 20) {
      if (wc == 0) { float* G = (float*)(ws + OFF_GATES);
#pragma unroll
        for (int ai = 0; ai < 2; ++ai)
#pragma unroll
          for (int m = 0; m < 4; ++m) { float* rp = G + (size_t)(pm * 256 + ai * 128 + rl + m * 16) * 32 + 8 * fq;
            *(f32x4*)rp = acc[ai][0][m][0]; *(f32x4*)(rp + 4) = acc[ai][0][m][1]; } }
      return;
    }
    if (pn >= 21 && pn < 37) {
      if (!lat) return;
      bf16_t* O = (bf16_t*)(ws + OFF_OZ) + (pn - 21) * 128 + cl;
#pragma unroll
      for (int ai = 0; ai < 2; ++ai)
#pragma unroll
        for (int m = 0; m < 4; ++m) { const size_t row = (size_t)pm * 256 + ai * 128 + rl + m * 16;
          float r[8];
#pragma unroll
          for (int n = 0; n < 2; ++n)
#pragma unroll
            for (int e = 0; e < 4; ++e) r[n * 4 + e] = sigmoidf_(acc[ai][0][m][n][e]) * siluf_(acc[ai][1][m][n][e]);
          u32x4 w; w.x = cvt_pk_bf16(r[0], r[1]); w.y = cvt_pk_bf16(r[2], r[3]); w.z = cvt_pk_bf16(r[4], r[5]); w.w = cvt_pk_bf16(r[6], r[7]);
          *(u32x4*)(O + row * 2048) = w; }
      return;
    }
    bf16_t* O; int ld = 2048, act = 0; size_t rowbase = (size_t)pm * 256;
    if (pn < 8) { O = (bf16_t*)(ws + OFF_QKPRE) + pn * 256; }
    else if (pn < 16) { O = (bf16_t*)(ws + OFF_VA) + (pn - 8) * 256; }
    else if (pn < 18) { O = (bf16_t*)(ws + OFF_KBRAW) + (pn - 16) * 256; ld = 512; }
    else if (pn < 20) { O = (bf16_t*)(ws + OFF_VALL) + (pn - 18) * 256; ld = 512;
      rowbase = lat ? (size_t)(pm >> 5) * SKV + CTXL + (size_t)(pm & 31) * 256 : (size_t)(pm - 128) * SKV; }
    else { if (!lat) return;
      if (pn < 45) { O = (bf16_t*)(ws + OFF_QB) + (pn - 37) * 256; }
      else if (pn < 53) { O = (bf16_t*)(ws + OFF_ZB) + (pn - 45) * 256; act = 1; }
      else if (pn < 61) { O = (bf16_t*)dout + (pn - 53) * 256; act = 2; }
      else { O = (bf16_t*)dout + (size_t)M_TOK * 2048 + (pn - 61) * 256; act = 2; } }
#pragma unroll
    for (int ai = 0; ai < 2; ++ai)
#pragma unroll
      for (int m = 0; m < 4; ++m) { bf16_t* rowp = O + (rowbase + ai * 128 + rl + m * 16) * ld + cl;
#pragma unroll
        for (int bj = 0; bj < 2; ++bj) { f32x4 v0 = acc[ai][bj][m][0], v1 = acc[ai][bj][m][1];
          if (act == 1) {
#pragma unroll
            for (int e = 0; e < 4; ++e) { v0[e] = siluf_(v0[e]); v1[e] = siluf_(v1[e]); } }
          else if (act == 2) {
#pragma unroll
            for (int e = 0; e < 4; ++e) { v0[e] = sigmoidf_(v0[e]); v1[e] = sigmoidf_(v1[e]); } }
          u32x4 w; w.x = cvt_pk_bf16(v0[0], v0[1]); w.y = cvt_pk_bf16(v0[2], v0[3]); w.z = cvt_pk_bf16(v1[0], v1[1]); w.w = cvt_pk_bf16(v1[2], v1[3]);
          *(u32x4*)(rowp + bj * 128) = w; } }
  }
};
struct Epi2a {
  static constexpr bool PERM = true, AFTER_DRAIN = false;
  float* tmp; const bf16_t* sg;
  __device__ __forceinline__ void operator()(const f32x4 (&acc)[2][2][4][2], const pg8::Unit& u, int wr, int wc, int fr, int fq) const {
    const int col0 = u.pn * 256 + wc * 32 + 8 * fq;
#pragma unroll
    for (int ai = 0; ai < 2; ++ai)
#pragma unroll
      for (int m = 0; m < 4; ++m) { const size_t off = (size_t)(u.pm * 256 + ai * 128 + wr * 64 + fr + m * 16) * 2048 + col0;
#pragma unroll
        for (int bj = 0; bj < 2; ++bj) { const u32x4 s = *(const u32x4*)(sg + off + bj * 128);
          f32x4 a = acc[ai][bj][m][0], b = acc[ai][bj][m][1];
          a[0] *= bflo(s.x); a[1] *= bfhi(s.x); a[2] *= bflo(s.y); a[3] *= bfhi(s.y);
          b[0] *= bflo(s.z); b[1] *= bfhi(s.z); b[2] *= bflo(s.w); b[3] *= bfhi(s.w);
          *(f32x4*)(tmp + off + bj * 128) = a; *(f32x4*)(tmp + off + bj * 128 + 4) = b; } }
  }
};
struct Epi2b {
  static constexpr bool PERM = true, AFTER_DRAIN = false;
  const float* tmp; const bf16_t* sg; bf16_t* merged;
  __device__ __forceinline__ void operator()(const f32x4 (&acc)[2][2][4][2], const pg8::Unit& u, int wr, int wc, int fr, int fq) const {
    const int col0 = u.pn * 256 + wc * 32 + 8 * fq;
#pragma unroll
    for (int ai = 0; ai < 2; ++ai)
#pragma unroll
      for (int m = 0; m < 4; ++m) { const size_t off = (size_t)(u.pm * 256 + ai * 128 + wr * 64 + fr + m * 16) * 2048 + col0;
#pragma unroll
        for (int bj = 0; bj < 2; ++bj) { const u32x4 s = *(const u32x4*)(sg + off + bj * 128);
          const f32x4 t0 = *(const f32x4*)(tmp + off + bj * 128), t1 = *(const f32x4*)(tmp + off + bj * 128 + 4);
          f32x4 a = acc[ai][bj][m][0], b = acc[ai][bj][m][1];
          a[0] = t0[0] + a[0] * bflo(s.x); a[1] = t0[1] + a[1] * bfhi(s.x); a[2] = t0[2] + a[2] * bflo(s.y); a[3] = t0[3] + a[3] * bfhi(s.y);
          b[0] = t1[0] + b[0] * bflo(s.z); b[1] = t1[1] + b[1] * bfhi(s.z); b[2] = t1[2] + b[2] * bflo(s.w); b[3] = t1[3] + b[3] * bfhi(s.w);
          u32x4 w; w.x = cvt_pk_bf16(a[0], a[1]); w.y = cvt_pk_bf16(a[2], a[3]); w.z = cvt_pk_bf16(b[0], b[1]); w.w = cvt_pk_bf16(b[2], b[3]);
          *(u32x4*)(merged + off + bj * 128) = w; } }
  }
};
struct Epi3 {
  static constexpr bool PERM = false, AFTER_DRAIN = false;
  const float* x; const float* mod; float* y;
  __device__ __forceinline__ void operator()(const f32x4 (&acc)[2][2][4][2], const pg8::Unit& u, int wr, int wc, int fr, int fq) const {
    const int col0 = u.pn * 256 + wc * 32 + 4 * fq;
    const float* gate = mod + (size_t)(u.pm >> 5) * 6144 + 4096 + col0;
    f32x4 gv[2][2];
#pragma unroll
    for (int bj = 0; bj < 2; ++bj)
#pragma unroll
      for (int n = 0; n < 2; ++n) gv[bj][n] = *(const f32x4*)(gate + bj * 128 + n * 16);
#pragma unroll
    for (int ai = 0; ai < 2; ++ai)
#pragma unroll
      for (int m = 0; m < 4; ++m) { const size_t off = (size_t)(u.pm * 256 + ai * 128 + wr * 64 + fr + m * 16) * 2048 + col0;
#pragma unroll
        for (int bj = 0; bj < 2; ++bj)
#pragma unroll
          for (int n = 0; n < 2; ++n) { const f32x4 xv = *(const f32x4*)(x + off + bj * 128 + n * 16);
            *(f32x4*)(y + off + bj * 128 + n * 16) = xv * ALPHA_DN + gv[bj][n] * acc[ai][bj][m][n]; } }
  }
};

__device__ __forceinline__ int orig_col(int n) {
  if (n < 4096) return n;
  if (n < 4608) return 4128 + (n - 4096);
  if (n < 5120) return 4640 + (n - 4608);
  if (n < 5152) return 4096 + (n - 5120);
  if (n < 5376) return -1;
  if (n < 9472) { const int t = n - 5376, j = t >> 8, r = t & 255; return r < 128 ? 5152 + 128 * j + r : 7200 + 128 * j + (r - 128); }
  if (n < 11520) return 9248 + (n - 9472);
  if (n < 13568) return 11296 + (n - 11520);
  return 13344 + (n - 13568);
}
__device__ void phase0_prep(const Params& p, unsigned char* lds) {
  int tid_l = threadIdx.x; asm volatile("" : "+v"(tid_l)); const int tid = tid_l, wid = tid >> 6, lane = tid & 63;
  unsigned char* ws = p.ws;
  for (int idx = blockIdx.x * 512 + tid; idx < 4096; idx += gridDim.x * 512) {
    const int pos = idx >> 5, i = idx & 31; const float inv = powf(10000.0f, -(float)(2 * i) / 64.0f); const float ang = (float)pos * inv;
    float2 cs; cs.x = cosf(ang); cs.y = sinf(ang); ((float2*)(ws + OFF_ROPE))[idx] = cs; }
  float* sl = (float*)lds; float* red = sl + 5 * 2048; bool did = false;
  for (int it = blockIdx.x; it < 192; it += gridDim.x) {
    if (!did) { for (int i = tid; i < 5 * 2048; i += 512) { const int r = i >> 11, k = i & 2047; const float c = (r < 4) ? p.in[1][r * 2048 + k] : p.in[3][k]; sl[i] = c / (1.0f + expf(-c)); }
      __syncthreads(); did = true; }
    const int col = lane & 31, kh = lane >> 5, n = it * 32 + col;
    float a0 = 0.f, a1 = 0.f, a2 = 0.f, a3 = 0.f, a4 = 0.f;
    const float* wp = p.in[4] + (size_t)(wid * 256 + kh) * 6144 + n;
#pragma unroll 8
    for (int i = 0; i < 128; ++i) { const int k = wid * 256 + 2 * i + kh; const float w = wp[(size_t)(2 * i) * 6144];
      a0 += sl[k] * w; a1 += sl[2048 + k] * w; a2 += sl[4096 + k] * w; a3 += sl[6144 + k] * w; a4 += sl[8192 + k] * w; }
    a0 += __shfl_xor(a0, 32); a1 += __shfl_xor(a1, 32); a2 += __shfl_xor(a2, 32); a3 += __shfl_xor(a3, 32); a4 += __shfl_xor(a4, 32);
    if (kh == 0) { red[(wid * 5 + 0) * 32 + col] = a0; red[(wid * 5 + 1) * 32 + col] = a1; red[(wid * 5 + 2) * 32 + col] = a2; red[(wid * 5 + 3) * 32 + col] = a3; red[(wid * 5 + 4) * 32 + col] = a4; }
    __syncthreads();
    if (tid < 160) { const int r = tid >> 5, c = tid & 31; float s = 0.f;
#pragma unroll
      for (int w = 0; w < 8; ++w) s += red[(w * 5 + r) * 32 + c];
      ((float*)(ws + OFF_MOD))[r * 6144 + it * 32 + c] = s + p.in[5][it * 32 + c]; }
    __syncthreads();
  }
  __syncthreads();
  float* tile = (float*)lds;
  constexpr int NT_IN = (N1P / 64) * 32, NT = NT_IN + 3 * 1024;
  for (int t = blockIdx.x; t < NT; t += gridDim.x) {
    const float* src; bf16_t* dst; int ldsrc, n0, k0; bool perm;
    if (t < NT_IN) { src = p.in[6]; dst = (bf16_t*)(ws + OFF_WT_IN); ldsrc = N_IN; n0 = (t >> 5) * 64; k0 = (t & 31) * 64; perm = true; }
    else { int q = t - NT_IN; const int w = q >> 10; q &= 1023; src = p.in[13 + w]; dst = (bf16_t*)(ws + OFF_WT_BA + (size_t)w * SZ_W2); ldsrc = 2048; n0 = (q >> 5) * 64; k0 = (q & 31) * 64; perm = false; }
#pragma unroll
    for (int i = 0; i < 2; ++i) { const int kk = (tid >> 4) + 32 * i, nq = (tid & 15) * 4; const int oc = perm ? orig_col(n0 + nq) : n0 + nq;
      float4 v = make_float4(0.f, 0.f, 0.f, 0.f); if (oc >= 0) v = *(const float4*)(src + (size_t)(k0 + kk) * ldsrc + oc);
      float* tp = tile + kk * 65 + nq; tp[0] = v.x; tp[1] = v.y; tp[2] = v.z; tp[3] = v.w; }
    __syncthreads();
    { const int nn = tid >> 3, kq = (tid & 7) * 8; float r[8];
#pragma unroll
      for (int e = 0; e < 8; ++e) r[e] = tile[(kq + e) * 65 + nn];
      u32x4 w; w.x = cvt_pk_bf16(r[0], r[1]); w.y = cvt_pk_bf16(r[2], r[3]); w.z = cvt_pk_bf16(r[4], r[5]); w.w = cvt_pk_bf16(r[6], r[7]);
      *(u32x4*)(dst + (size_t)(n0 + nn) * 2048 + k0 + kq) = w; }
    __syncthreads();
  }
}

__device__ void phase1_ln_mod(const Params& p) {
  int tid_l = threadIdx.x; asm volatile("" : "+v"(tid_l)); const int tid = tid_l, wid = tid >> 6, lane = tid & 63;
  const float* MOD = (const float*)(p.ws + OFF_MOD); bf16_t* U = (bf16_t*)(p.ws + OFF_U);
  for (int row = blockIdx.x * 8 + wid; row < M_ALL; row += gridDim.x * 8) {
    const float* src = row < M_TOK ? p.in[0] + (size_t)row * 2048 : p.in[2] + (size_t)(row - M_TOK) * 2048;
    const float* md = MOD + (size_t)(row < M_TOK ? (row >> 13) : 4) * 6144;
    float4 v[4][2]; float s = 0.f;
#pragma unroll
    for (int g = 0; g < 4; ++g) { const float4* q = (const float4*)(src + g * 512 + lane * 8); v[g][0] = q[0]; v[g][1] = q[1];
      s += (v[g][0].x + v[g][0].y) + (v[g][0].z + v[g][0].w) + (v[g][1].x + v[g][1].y) + (v[g][1].z + v[g][1].w); }
    s = wave_sum(s); const float mu = s * (1.0f / 2048.0f); float q2 = 0.f;
#pragma unroll
    for (int g = 0; g < 4; ++g)
#pragma unroll
      for (int h = 0; h < 2; ++h) { const float a = v[g][h].x - mu, b = v[g][h].y - mu, c = v[g][h].z - mu, d = v[g][h].w - mu; q2 += (a * a + b * b) + (c * c + d * d); }
    q2 = wave_sum(q2); const float rs = rsqrtf(q2 * (1.0f / 2048.0f) + LN_EPS);
#pragma unroll
    for (int g = 0; g < 4; ++g) { const int c0 = g * 512 + lane * 8; float r[8];
#pragma unroll
      for (int h = 0; h < 2; ++h) { const float4 sh = *(const float4*)(md + c0 + 4 * h), sc = *(const float4*)(md + 2048 + c0 + 4 * h);
        r[4 * h + 0] = (v[g][h].x - mu) * rs * (1.0f + sc.x) + sh.x; r[4 * h + 1] = (v[g][h].y - mu) * rs * (1.0f + sc.y) + sh.y;
        r[4 * h + 2] = (v[g][h].z - mu) * rs * (1.0f + sc.z) + sh.z; r[4 * h + 3] = (v[g][h].w - mu) * rs * (1.0f + sc.w) + sh.w; }
      u32x4 w; w.x = cvt_pk_bf16(r[0], r[1]); w.y = cvt_pk_bf16(r[2], r[3]); w.z = cvt_pk_bf16(r[4], r[5]); w.w = cvt_pk_bf16(r[6], r[7]);
      *(u32x4*)(U + (size_t)row * 2048 + c0) = w; }
  }
}

__device__ __forceinline__ void unpack8(const u32x4 w, float* f) { f[0] = bflo(w.x); f[1] = bfhi(w.x); f[2] = bflo(w.y); f[3] = bfhi(w.y); f[4] = bflo(w.z); f[5] = bfhi(w.z); f[6] = bflo(w.w); f[7] = bfhi(w.w); }
__device__ __forceinline__ u32x4 pack8(const float* r) { u32x4 w; w.x = cvt_pk_bf16(r[0], r[1]); w.y = cvt_pk_bf16(r[2], r[3]); w.z = cvt_pk_bf16(r[4], r[5]); w.w = cvt_pk_bf16(r[6], r[7]); return w; }
__device__ __forceinline__ u32x4 norm_rope_head(const u32x4 raw, const float* nw, const float2* rope, int j, int pos_r, int pos_c) {
  float x[8]; unpack8(raw, x); float ss = 0.f;
#pragma unroll
  for (int e = 0; e < 8; ++e) ss += x[e] * x[e];
  ss += __shfl_xor(ss, 1); ss += __shfl_xor(ss, 2); ss += __shfl_xor(ss, 4); ss += __shfl_xor(ss, 8);
  const float rs = rsqrtf(ss * (1.0f / 128.0f) + LN_EPS);
  const float4 w0 = *(const float4*)(nw + 8 * j), w1 = *(const float4*)(nw + 8 * j + 4);
  x[0] *= rs * w0.x; x[1] *= rs * w0.y; x[2] *= rs * w0.z; x[3] *= rs * w0.w; x[4] *= rs * w1.x; x[5] *= rs * w1.y; x[6] *= rs * w1.z; x[7] *= rs * w1.w;
  float o[8];
  const bool is_x1 = ((j >> 2) & 1) == 0; const int pos = (j < 8) ? pos_r : pos_c; const int fi = 8 * (j & 3);
#pragma unroll
  for (int e = 0; e < 8; ++e) { const float pv = __shfl_xor(x[e], 4);
    if (pos_r >= 0) { const float2 cs = rope[pos * 32 + fi + e]; o[e] = is_x1 ? (x[e] * cs.x - pv * cs.y) : (pv * cs.y + x[e] * cs.x); }
    else o[e] = x[e]; }
  return pack8(o);
}
__device__ void phase3_elem(const Params& p) {
  int tid_l = threadIdx.x; asm volatile("" : "+v"(tid_l)); const int tid = tid_l, wid = tid >> 6, lane = tid & 63;
  unsigned char* ws = p.ws;
  { const bf16_t* X = (const bf16_t*)(ws + OFF_QKPRE); bf16_t* Y = (bf16_t*)(ws + OFF_QAKA); const float* cw = p.in[8]; const float* cb = p.in[9];
    for (size_t idx = (size_t)blockIdx.x * 512 + tid; idx < (size_t)M_ALL * 256; idx += (size_t)gridDim.x * 512) {
      const int row = (int)(idx >> 8), c8 = (int)(idx & 255) * 8;
      bool first, last; if (row < M_TOK) { const int s = row & (SEQ - 1); first = s == 0; last = s == SEQ - 1; } else { const int t = (row - M_TOK) & (CTXL - 1); first = t == 0; last = t == CTXL - 1; }
      const u32x4 z = {0u, 0u, 0u, 0u};
      const u32x4 cu = *(const u32x4*)(X + (size_t)row * 2048 + c8);
      const u32x4 pr = first ? z : *(const u32x4*)(X + (size_t)(row - 1) * 2048 + c8);
      const u32x4 nx = last ? z : *(const u32x4*)(X + (size_t)(row + 1) * 2048 + c8);
      float a[8], b[8], c[8], r[8]; unpack8(pr, a); unpack8(cu, b); unpack8(nx, c);
      const float sc = c8 >= 1024 ? 0.08838834764831845f : 1.0f;
#pragma unroll
      for (int e = 0; e < 8; ++e) { const float y = cb[c8 + e] + a[e] * cw[c8 + e] + b[e] * cw[2048 + c8 + e] + c[e] * cw[4096 + c8 + e]; r[e] = siluf_(y) * sc; }
      *(u32x4*)(Y + (size_t)row * 2048 + c8) = pack8(r); } }
  const float2* rope = (const float2*)(ws + OFF_ROPE);
  const int j = lane & 15, hl = lane >> 4;
  { const bf16_t* X = (const bf16_t*)(ws + OFF_KBRAW); bf16_t* Y = (bf16_t*)(ws + OFF_KALL);
    for (int row = blockIdx.x * 8 + wid; row < M_ALL; row += gridDim.x * 8) {
      size_t drow; int pr = -1, pc = -1;
      if (row < M_TOK) { const int b = row >> 13, s = row & (SEQ - 1); drow = (size_t)b * SKV + CTXL + s; pr = s >> 6; pc = s & 63; }
      else { const int b = (row - M_TOK) >> 8, t = (row - M_TOK) & (CTXL - 1); drow = (size_t)b * SKV + t; }
      const u32x4 raw = *(const u32x4*)(X + (size_t)row * 512 + hl * 128 + j * 8);
      *(u32x4*)(Y + drow * 512 + hl * 128 + j * 8) = norm_rope_head(raw, p.in[12], rope, j, pr, pc); } }
  { bf16_t* X = (bf16_t*)(ws + OFF_QB);
    for (int it = blockIdx.x * 8 + wid; it < M_TOK * 4; it += gridDim.x * 8) {
      const int row = it >> 2, hd = (it & 3) * 4 + hl, s = row & (SEQ - 1);
      bf16_t* q = X + (size_t)row * 2048 + hd * 128 + j * 8;
      const u32x4 raw = *(const u32x4*)q;
      *(u32x4*)q = norm_rope_head(raw, p.in[11], rope, j, s >> 6, s & 63); } }
}

__device__ void phase5_gate(const Params& p) {
  int tid_l = threadIdx.x; asm volatile("" : "+v"(tid_l)); const int tid = tid_l, wid = tid >> 6, lane = tid & 63;
  const bf16_t* HF = (const bf16_t*)(p.ws + OFF_HF); const bf16_t* HB = (const bf16_t*)(p.ws + OFF_HB); bf16_t* OZ = (bf16_t*)(p.ws + OFF_OZ);
  const float* nw = p.in[10];
  const int j = lane & 31, hl = lane >> 5;
  for (int it = blockIdx.x * 8 + wid; it < M_TOK * 4; it += gridDim.x * 8) {
    const size_t off = (size_t)(it >> 2) * 2048 + ((it & 3) * 2 + hl) * 256 + j * 8;
    float a[8], b[8], g[8], r[8]; unpack8(*(const u32x4*)(HF + off), a); unpack8(*(const u32x4*)(HB + off), b); unpack8(*(const u32x4*)(OZ + off), g);
    float ss = 0.f;
#pragma unroll
    for (int e = 0; e < 8; ++e) { a[e] += b[e]; ss += a[e] * a[e]; }
    ss += __shfl_xor(ss, 1); ss += __shfl_xor(ss, 2); ss += __shfl_xor(ss, 4); ss += __shfl_xor(ss, 8); ss += __shfl_xor(ss, 16);
    const float rs = rsqrtf(ss * (1.0f / 256.0f) + LN_EPS);
    const float* w = nw + ((it & 3) * 2 + hl) * 256 + j * 8;
#pragma unroll
    for (int e = 0; e < 8; ++e) r[e] = a[e] * rs * w[e] * g[e];
    *(u32x4*)(OZ + off) = pack8(r);
  }
}

__device__ void phase8_final_ln(const Params& p) {
  int tid_l = threadIdx.x; asm volatile("" : "+v"(tid_l)); const int tid = tid_l, wid = tid >> 6, lane = tid & 63;
  const float* lw = p.in[16]; const float* lb = p.in[17];
  for (int row = blockIdx.x * 8 + wid; row < M_TOK; row += gridDim.x * 8) {
    float4* r = (float4*)(p.out + (size_t)row * 2048);
    float4 v[8]; float s = 0.f;
#pragma unroll
    for (int i = 0; i < 8; ++i) { v[i] = r[lane + 64 * i]; s += (v[i].x + v[i].y) + (v[i].z + v[i].w); }
    s = wave_sum(s); const float mu = s * (1.f / 2048.f); float q = 0.f;
#pragma unroll
    for (int i = 0; i < 8; ++i) { const float a = v[i].x - mu, b = v[i].y - mu, c = v[i].z - mu, d = v[i].w - mu; q += (a * a + b * b) + (c * c + d * d); }
    q = wave_sum(q); const float rs = rsqrtf(q * (1.f / 2048.f) + LN_EPS);
#pragma unroll
    for (int i = 0; i < 8; ++i) { const float4 w = ((const float4*)lw)[lane + 64 * i], b = ((const float4*)lb)[lane + 64 * i];
      float4 y; y.x = (v[i].x - mu) * rs * w.x + b.x; y.y = (v[i].y - mu) * rs * w.y + b.y; y.z = (v[i].z - mu) * rs * w.z + b.z; y.w = (v[i].w - mu) * rs * w.w + b.w;
      r[lane + 64 * i] = y; }
  }
}

namespace att {
constexpr int D = 128, NW = 8, QBLK = 32, KVBLK = 64;
constexpr float SCALE = 0.088388347648318440f;
constexpr float THR = 8.f;
constexpr int LDQ = 2048, LDK = 512;
constexpr size_t SHM_V = KVBLK * D * 2, SHM_K = KVBLK * D * 2, SHM_ATTN = 2 * SHM_V + 2 * SHM_K + NW * 64 * 4;
#define KSWZ(row, colB) ((row) * 256 + ((colB) ^ (((row) & 7) << 4)))
#define SBAR() __builtin_amdgcn_sched_barrier(0)
__device__ __forceinline__ int crow(int r, int hi) { return (r & 3) + 8 * (r >> 2) + 4 * hi; }
__device__ __forceinline__ unsigned cvtpk(float lo, float hi) { unsigned r; asm volatile("v_cvt_pk_bf16_f32 %0, %1, %2" : "=v"(r) : "v"(lo), "v"(hi)); return r; }
__device__ __forceinline__ void partialSM(f32x16& p0, f32x16& p1, float& m_reg, float& mn, float& alpha) {
  constexpr float C = SCALE * 1.4426950408889634f;
  float pmax = p0[0]; for (int r = 1; r < 16; ++r) pmax = fmaxf(pmax, p0[r]); for (int r = 0; r < 16; ++r) pmax = fmaxf(pmax, p1[r]);
  { auto rr = __builtin_amdgcn_permlane32_swap(__float_as_uint(pmax), __float_as_uint(pmax), false, false);
    pmax = fmaxf(__uint_as_float(rr[0]), __uint_as_float(rr[1])); }
  if (__builtin_expect(__all(pmax - m_reg <= THR / SCALE), 1)) { mn = m_reg; alpha = 1.f; }
  else { mn = fmaxf(m_reg, pmax); alpha = __builtin_amdgcn_exp2f((m_reg - mn) * C); m_reg = mn; }
  float mnC = -mn * C;
  for (int r = 0; r < 16; ++r) p0[r] = fmaf(p0[r], C, mnC); for (int r = 0; r < 16; ++r) p1[r] = fmaf(p1[r], C, mnC);
  for (int r = 0; r < 16; ++r) p0[r] = __builtin_amdgcn_exp2f(p0[r]);
}
__device__ __forceinline__ void finishSM(f32x16& p0, f32x16& p1, float alpha, float& l_reg, bf16x8& pa0, bf16x8& pa1, bf16x8& pa2, bf16x8& pa3) {
  for (int r = 0; r < 16; ++r) p1[r] = __builtin_amdgcn_exp2f(p1[r]);
  float ps = 0; for (int r = 0; r < 16; ++r) ps += p0[r]; for (int r = 0; r < 16; ++r) ps += p1[r];
  { auto rr = __builtin_amdgcn_permlane32_swap(__float_as_uint(ps), __float_as_uint(ps), false, false);
    ps = __uint_as_float(rr[0]) + __uint_as_float(rr[1]); }
  l_reg = l_reg * alpha + ps;
#define PK4(P, BASE, OUT) do { unsigned a0 = cvtpk(P[BASE + 0], P[BASE + 1]), a1 = cvtpk(P[BASE + 2], P[BASE + 3]);   \
    unsigned b0 = cvtpk(P[BASE + 4], P[BASE + 5]), b1 = cvtpk(P[BASE + 6], P[BASE + 7]);                              \
    auto r0 = __builtin_amdgcn_permlane32_swap(a0, b0, false, false); auto r1 = __builtin_amdgcn_permlane32_swap(a1, b1, false, false); \
    u32x4 w = {r0[0], r1[0], r0[1], r1[1]}; OUT = *reinterpret_cast<bf16x8*>(&w); } while (0)
  PK4(p0, 0, pa0); PK4(p0, 8, pa1); PK4(p1, 0, pa2); PK4(p1, 8, pa3);
#undef PK4
}
__device__ __forceinline__ void qkt(f32x16& p0, f32x16& p1, const char* Ks, const bf16x8* qr, int r32, int hi) {
  p0 = f32x16{}; p1 = f32x16{};
  for (int d0 = 0; d0 < 8; ++d0) { int cb = (d0 * 16 + hi * 8) * 2;
    bf16x8 b0 = *reinterpret_cast<const bf16x8*>(Ks + KSWZ(r32, cb));
    bf16x8 b1 = *reinterpret_cast<const bf16x8*>(Ks + KSWZ(32 + r32, cb));
    p0 = __builtin_amdgcn_mfma_f32_32x32x16_bf16(b0, qr[d0], p0, 0, 0, 0);
    p1 = __builtin_amdgcn_mfma_f32_32x32x16_bf16(b1, qr[d0], p1, 0, 0, 0); }
}
__device__ __forceinline__ int v_st(int k, int c) { const int kk = (k & ~0xC) | ((k & 4) << 1) | ((k & 8) >> 1); return ((kk >> 3) * 4 + (c >> 5)) * 512 + ((kk & 7) * 32 + (c & 31)) * 2; }
__device__ __forceinline__ int v_rd_base(int lane) { return ((lane & 3) << 3) | (((lane >> 2) & 3) << 6) | (((lane >> 4) & 1) << 5) | (((lane >> 5) & 1) << 8); }
constexpr int v_rd_off(int d0, int ks, int half) { return d0 * 512 + ks * 4096 + half * 2048; }
template <int OFF> __device__ __forceinline__ s16x4 tr_read(int vb) {
  s16x4 r; asm volatile("ds_read_b64_tr_b16 %0, %1 offset:%2" : "=&v"(r) : "v"(vb), "i"(OFF) : "memory"); return r;
}
#define PKLH(L, H) (bf16x8){L[0], L[1], L[2], L[3], H[0], H[1], H[2], H[3]}
template <int D0> __device__ __forceinline__ void pv_one(f32x16& od, int vb, bf16x8 pa0, bf16x8 pa1, bf16x8 pa2, bf16x8 pa3) {
  const s16x4 l0 = tr_read<v_rd_off(D0, 0, 0)>(vb), h0 = tr_read<v_rd_off(D0, 0, 1)>(vb), l1 = tr_read<v_rd_off(D0, 1, 0)>(vb), h1 = tr_read<v_rd_off(D0, 1, 1)>(vb);
  const s16x4 l2 = tr_read<v_rd_off(D0, 2, 0)>(vb), h2 = tr_read<v_rd_off(D0, 2, 1)>(vb), l3 = tr_read<v_rd_off(D0, 3, 0)>(vb), h3 = tr_read<v_rd_off(D0, 3, 1)>(vb);
  asm volatile("s_waitcnt lgkmcnt(0)" ::: "memory"); SBAR();
  od = __builtin_amdgcn_mfma_f32_32x32x16_bf16(pa0, PKLH(l0, h0), od, 0, 0, 0);
  od = __builtin_amdgcn_mfma_f32_32x32x16_bf16(pa1, PKLH(l1, h1), od, 0, 0, 0);
  od = __builtin_amdgcn_mfma_f32_32x32x16_bf16(pa2, PKLH(l2, h2), od, 0, 0, 0);
  od = __builtin_amdgcn_mfma_f32_32x32x16_bf16(pa3, PKLH(l3, h3), od, 0, 0, 0);
}
__device__ __forceinline__ void pv_d0(f32x16* o, int vb, bf16x8 pa0, bf16x8 pa1, bf16x8 pa2, bf16x8 pa3) {
  pv_one<0>(o[0], vb, pa0, pa1, pa2, pa3); pv_one<1>(o[1], vb, pa0, pa1, pa2, pa3); pv_one<2>(o[2], vb, pa0, pa1, pa2, pa3); pv_one<3>(o[3], vb, pa0, pa1, pa2, pa3);
}
__device__ __forceinline__ void attn_dense_body(bf16_t* __restrict__ Qb, const bf16_t* __restrict__ Kh, const bf16_t* __restrict__ Vh, int seq, char* lds) {
  int tid_l = threadIdx.x; asm volatile("" : "+v"(tid_l)); const int tid = tid_l, wid = tid >> 6, lane = tid & 63, r32 = lane & 31, hi = lane >> 5;
  char* V_lds = lds; char* K_lds = lds + 2 * SHM_V;
  float* wsf = (float*)(lds + 2 * SHM_V + 2 * SHM_K) + wid * 64; float* li_l = wsf; float* al_l = wsf + 32;
  float m_reg = -1e30f, l_reg = 0; f32x16 o[4] = {}; bf16x8 qr[8];
  const bf16_t* Qw = Qb + (long)(wid * QBLK + r32) * LDQ + hi * 8;
#pragma unroll
  for (int d0 = 0; d0 < 8; ++d0) qr[d0] = *reinterpret_cast<const bf16x8*>(Qw + d0 * 16);
  const int sr = tid >> 4, sc = (tid & 15) * 8, vst0 = v_st(sr, sc), vst1 = v_st(32 + sr, sc);
  const int vb0 = (int)(uintptr_t)V_lds + v_rd_base(lane);
  struct { bf16x8 vs0, vs1, ks0, ks1; } sr_[1];
#define SLOAD(i, k0) do { sr_[i].vs0 = *reinterpret_cast<const bf16x8*>(&Vh[(long)((k0) + sr) * LDK + sc]); sr_[i].vs1 = *reinterpret_cast<const bf16x8*>(&Vh[(long)((k0) + 32 + sr) * LDK + sc]); \
    sr_[i].ks0 = *reinterpret_cast<const bf16x8*>(&Kh[(long)((k0) + sr) * LDK + sc]); sr_[i].ks1 = *reinterpret_cast<const bf16x8*>(&Kh[(long)((k0) + 32 + sr) * LDK + sc]); } while (0)
#define SWRITE(b, i) do { *(bf16x8*)(V_lds + (b) * SHM_V + vst0) = sr_[i].vs0;          \
    *(bf16x8*)(V_lds + (b) * SHM_V + vst1) = sr_[i].vs1; int kc = sc * 2;               \
    *(bf16x8*)(K_lds + (b) * SHM_K + KSWZ(sr, kc)) = sr_[i].ks0;                       \
    *(bf16x8*)(K_lds + (b) * SHM_K + KSWZ(32 + sr, kc)) = sr_[i].ks1; } while (0)
#define SWAIT() asm volatile("s_waitcnt vmcnt(0)" ::: "memory")
#define RESC(a) do { if (__any((a) < 1.f)) { if (hi == 0) al_l[r32] = (a); asm volatile("s_waitcnt lgkmcnt(0)" ::: "memory"); \
    for (int d = 0; d < 4; ++d) for (int r = 0; r < 16; ++r) o[d][r] *= al_l[crow(r, hi)]; } } while (0)
  f32x16 pA0, pA1, pB0, pB1; float mnA, mnB, alA, alB; bf16x8 pa0, pa1, pa2, pa3; const int NT = seq / KVBLK;
  constexpr int SE = 0, SO = 0;
  SLOAD(SE, 0); asm volatile("s_waitcnt vmcnt(0)" ::: "memory"); SWRITE(0, SE); __syncthreads();
  qkt(pA0, pA1, K_lds, qr, r32, hi); partialSM(pA0, pA1, m_reg, mnA, alA);
  SLOAD(SO, KVBLK);
  SWAIT(); SWRITE(1, SO); __syncthreads();
  for (int j = 1; j + 1 < NT; j += 2) {
    SBAR(); qkt(pB0, pB1, K_lds + SHM_K, qr, r32, hi);
    finishSM(pA0, pA1, alA, l_reg, pa0, pa1, pa2, pa3); SBAR();
    SLOAD(SO, (j + 1) * KVBLK); SBAR();
    pv_d0(o, vb0, pa0, pa1, pa2, pa3); partialSM(pB0, pB1, m_reg, mnB, alB);
    __syncthreads(); SWAIT(); SWRITE(0, SE);
    RESC(alB); __syncthreads();
    SBAR(); qkt(pA0, pA1, K_lds, qr, r32, hi);
    finishSM(pB0, pB1, alB, l_reg, pa0, pa1, pa2, pa3); SBAR();
    SLOAD(SE, (j + 2) * KVBLK); SBAR();
    pv_d0(o, vb0 + (int)SHM_V, pa0, pa1, pa2, pa3); partialSM(pA0, pA1, m_reg, mnA, alA);
    __syncthreads(); SWAIT(); SWRITE(1, SO);
    RESC(alA); __syncthreads();
  }
  SBAR(); qkt(pB0, pB1, K_lds + SHM_K, qr, r32, hi);
  finishSM(pA0, pA1, alA, l_reg, pa0, pa1, pa2, pa3); SBAR();
  pv_d0(o, vb0, pa0, pa1, pa2, pa3); partialSM(pB0, pB1, m_reg, mnB, alB);
  __syncthreads(); RESC(alB);
  finishSM(pB0, pB1, alB, l_reg, pa0, pa1, pa2, pa3); SBAR();
  pv_d0(o, vb0 + (int)SHM_V, pa0, pa1, pa2, pa3);
  if (hi == 0) li_l[r32] = l_reg; asm volatile("s_waitcnt lgkmcnt(0)" ::: "memory");
  float rli[16];
#pragma unroll
  for (int r = 0; r < 16; ++r) rli[r] = __builtin_amdgcn_rcpf(li_l[crow(r, hi)]);
  bf16_t* qo = Qb + (long)(wid * QBLK + 4 * hi) * LDQ + r32; const bf16_t* zo = qo + (long)((OFF_ZB - OFF_QB) / 2);
#pragma unroll
  for (int r = 0; r < 16; ++r) { const int ro = ((r & 3) + 8 * (r >> 2)) * LDQ;
    const float z0 = bf2f(zo[ro]), z1 = bf2f(zo[ro + 32]), z2 = bf2f(zo[ro + 64]), z3 = bf2f(zo[ro + 96]);
    const float v0 = o[0][r] * rli[r] * z0, v1 = o[1][r] * rli[r] * z1, v2 = o[2][r] * rli[r] * z2, v3 = o[3][r] * rli[r] * z3;
    qo[ro] = (bf16_t)(cvtpk(v0, v0) & 0xffffu); qo[ro + 32] = (bf16_t)(cvtpk(v1, v1) & 0xffffu); qo[ro + 64] = (bf16_t)(cvtpk(v2, v2) & 0xffffu); qo[ro + 96] = (bf16_t)(cvtpk(v3, v3) & 0xffffu);
    asm volatile("" ::: "memory"); }
#undef SLOAD
#undef SWRITE
#undef SWAIT
#undef RESC
}
}

namespace ml {
using att::crow; using att::cvtpk; using att::v_st; using att::v_rd_base; using att::v_rd_off; using att::tr_read;
constexpr int O_QS = 0, O_KS = 17408, O_C0 = 34816, O_KTR = 52224, O_VTR = 68608, O_SP = 84992, O_F = 94208;
constexpr int NCH = 132;
template <int KS> __device__ __forceinline__ bf16x8 trfrag(int vb) {
  const s16x4 l = tr_read<v_rd_off(0, KS, 0)>(vb), h = tr_read<v_rd_off(0, KS, 1)>(vb);
  asm volatile("s_waitcnt lgkmcnt(0)" ::: "memory"); SBAR();
  return PKLH(l, h);
}
__device__ __forceinline__ bf16x8 scale_frag(bf16x8 v, const float* we) {
  const u32x4 w = *reinterpret_cast<const u32x4*>(&v); float f[8]; unpack8(w, f);
  const float4 s0 = *(const float4*)we, s1 = *(const float4*)(we + 4);
  f[0] *= s0.x; f[1] *= s0.y; f[2] *= s0.z; f[3] *= s0.w; f[4] *= s1.x; f[5] *= s1.y; f[6] *= s1.z; f[7] *= s1.w;
  const u32x4 o = pack8(f); return *reinterpret_cast<const bf16x8*>(&o);
}
__device__ __forceinline__ int chunk_row0(int c, int b, bool rev) {
  if (!rev) return c < 4 ? M_TOK + b * CTXL + 64 * c : b * SEQ + 64 * (c - 4);
  return c < 4 ? M_TOK + b * CTXL + 64 * (3 - c) : b * SEQ + 64 * (131 - c);
}
__device__ void mlstm_scan(const Params& p, char* lds, int item) {
  int tid_l = threadIdx.x; asm volatile("" : "+v"(tid_l)); const int tid = tid_l, wid = __builtin_amdgcn_readfirstlane(tid >> 6), lane = tid & 63, r32 = lane & 31, hi = lane >> 5;
  const int dir = item & 1, vs = (item >> 1) & 3, bh = item >> 3, b = bh >> 3, h = bh & 7;
  const bool rev = dir != 0;
  const bf16_t* QK = (const bf16_t*)(p.ws + OFF_QAKA); const bf16_t* VA = (const bf16_t*)(p.ws + OFF_VA); const float* GT = (const float*)(p.ws + OFF_GATES);
  bf16_t* H = (bf16_t*)(p.ws + (rev ? OFF_HB : OFF_HF));
  float* F = (float*)(lds + O_F); float *G = F, *MX = F + 64, *A = F + 128, *EM = F + 192, *WE = F + 256, *NQ = F + 320, *RS = F + 384, *N0 = F + 512, *SC = F + 640;
  for (int i = tid; i < 64 * 272 / 4; i += 512) ((unsigned*)(lds + O_C0))[i] = 0u;
  if (tid < 128) N0[tid] = 0.f;
  f32x16 cacc = {}; f32x16 acc1 = {}; float nreg = 0.f, m0 = -1e30f;
  const float bi = p.in[7][dir * 16 + h], bfb = p.in[7][dir * 16 + 8 + h];
  const int qrow0 = tid >> 4, qc = (tid & 15) * 8, vrow = tid >> 3, vc = (tid & 7) * 8;
  const int jnat = 63 - lane; const bool flip = !rev;
  bf16x8 q0, q1, k0, k1, v0; float gi = 0.f, gf = 0.f;
  { const int R0 = chunk_row0(0, b, rev); const bf16_t* qp = QK + (size_t)(R0 + qrow0) * 2048 + h * 128 + qc;
    q0 = *(const bf16x8*)qp; q1 = *(const bf16x8*)(qp + 32 * 2048); k0 = *(const bf16x8*)(qp + 1024); k1 = *(const bf16x8*)(qp + 1024 + 32 * 2048);
    v0 = *(const bf16x8*)(VA + (size_t)(R0 + vrow) * 2048 + h * 256 + vs * 64 + vc);
    if (wid == 0) { gi = GT[(size_t)(R0 + (flip ? lane : jnat)) * 32 + dir * 16 + h]; gf = GT[(size_t)(R0 + (flip ? lane : jnat)) * 32 + dir * 16 + 8 + h]; } }
  const int w4 = wid & 3, t_hi = w4 >> 1, t_lo = w4 & 1;
  for (int c = 0; c < NCH; ++c) {
    const int R0 = chunk_row0(c, b, rev); const bool isctx = c < 4;
    __syncthreads();
    { const int ra = flip ? 63 - qrow0 : qrow0, rb = flip ? 31 - qrow0 : qrow0 + 32, rv = flip ? 63 - vrow : vrow;
    *(bf16x8*)(lds + O_QS + ra * 272 + qc * 2) = q0; *(bf16x8*)(lds + O_QS + rb * 272 + qc * 2) = q1;
    *(bf16x8*)(lds + O_KS + ra * 272 + qc * 2) = k0; *(bf16x8*)(lds + O_KS + rb * 272 + qc * 2) = k1;
    *(bf16x8*)(lds + O_KTR + v_st(ra, qc)) = k0; *(bf16x8*)(lds + O_KTR + v_st(rb, qc)) = k1;
    *(bf16x8*)(lds + O_VTR + v_st(rv, vc)) = v0; }
    const float gi_c = gi, gf_c = gf;
    if (c + 1 < NCH) { const int R1 = chunk_row0(c + 1, b, rev); const bf16_t* qp = QK + (size_t)(R1 + qrow0) * 2048 + h * 128 + qc;
      q0 = *(const bf16x8*)qp; q1 = *(const bf16x8*)(qp + 32 * 2048); k0 = *(const bf16x8*)(qp + 1024); k1 = *(const bf16x8*)(qp + 1024 + 32 * 2048);
      v0 = *(const bf16x8*)(VA + (size_t)(R1 + vrow) * 2048 + h * 256 + vs * 64 + vc);
      if (wid == 0) { gi = GT[(size_t)(R1 + (flip ? lane : jnat)) * 32 + dir * 16 + h]; gf = GT[(size_t)(R1 + (flip ? lane : jnat)) * 32 + dir * 16 + 8 + h]; } }
    if (wid == 0) {
      const float li = gi_c + bi, xf = gf_c + bfb; const float lf = fminf(xf, 0.f) - log1pf(__expf(-fabsf(xf)));
      float bb = lf;
#pragma unroll
      for (int o = 1; o < 64; o <<= 1) { const float t = __shfl_up(bb, o); if (lane >= o) bb += t; }
      const float g = li - bb; float cm = g;
#pragma unroll
      for (int o = 1; o < 64; o <<= 1) { const float t = __shfl_up(cm, o); if (lane >= o) cm = fmaxf(cm, t); }
      const float Mx = fmaxf(m0, cm), m = bb + Mx, a = __expf(m0 - Mx), em = __expf(-m);
      const float bL = __shfl(bb, 63), ML = __shfl(Mx, 63), aend = __shfl(a, 63);
      G[jnat] = g; MX[jnat] = Mx; A[jnat] = a; EM[jnat] = em; WE[jnat] = __expf(g - ML); if (lane == 0) SC[0] = aend;
      m0 = bL + ML;
    }
    __syncthreads();
    if (wid < 4) {
      f32x16 pS = {};
      const char* ka = lds + O_KS + (32 * t_hi + r32) * 272 + hi * 16; const char* qb = lds + O_QS + (32 * t_lo + r32) * 272 + hi * 16;
#pragma unroll
      for (int d0 = 0; d0 < 8; ++d0) pS = __builtin_amdgcn_mfma_f32_32x32x16_bf16(*(const bf16x8*)(ka + d0 * 32), *(const bf16x8*)(qb + d0 * 32), pS, 0, 0, 0);
      const int j = 32 * t_lo + r32; const float mxj = MX[j]; float ps = 0.f;
#pragma unroll
      for (int r = 0; r < 16; ++r) { const int s = 32 * t_hi + crow(r, hi); const bool ok = (s >= j);
        const float wv = ok ? __expf(G[s] - mxj) : 0.f; pS[r] *= wv; ps += pS[r]; }
      ps += __shfl_xor(ps, 32); if (hi == 0) RS[t_hi * 64 + j] = ps;
#pragma unroll
      for (int g4 = 0; g4 < 4; ++g4) { u32x2 w; w.x = cvtpk(pS[4 * g4], pS[4 * g4 + 1]); w.y = cvtpk(pS[4 * g4 + 2], pS[4 * g4 + 3]);
        *(u32x2*)(lds + O_SP + j * 144 + (32 * t_hi + 8 * g4 + 4 * hi) * 2) = w; }
    } else {
      acc1 = f32x16{};
      const char* ca = lds + O_C0 + (32 * t_hi + r32) * 272 + hi * 16; const char* qb = lds + O_QS + (32 * t_lo + r32) * 272 + hi * 16;
#pragma unroll
      for (int d0 = 0; d0 < 8; ++d0) acc1 = __builtin_amdgcn_mfma_f32_32x32x16_bf16(*(const bf16x8*)(ca + d0 * 32), *(const bf16x8*)(qb + d0 * 32), acc1, 0, 0, 0);
      const int t4 = tid - 256, jq = t4 >> 2, part = t4 & 3; float sum = 0.f;
      const char* qrow = lds + O_QS + jq * 272 + part * 64;
#pragma unroll
      for (int i = 0; i < 4; ++i) { float f[8]; unpack8(*(const u32x4*)(qrow + 16 * i), f);
#pragma unroll
        for (int e = 0; e < 8; ++e) sum += f[e] * N0[part * 32 + 8 * i + e]; }
      sum += __shfl_xor(sum, 1); sum += __shfl_xor(sum, 2); if (part == 0) NQ[jq] = sum;
    }
    __syncthreads();
    const float aend = SC[0];
    if (wid >= 4) {
      f32x16 acc2 = {};
      const int vbv = (int)(uintptr_t)(lds + O_VTR) + v_rd_base(lane) + t_hi * 512;
      const char* sb = lds + O_SP + (32 * t_lo + r32) * 144 + hi * 16;
      { const bf16x8 a = trfrag<0>(vbv); acc2 = __builtin_amdgcn_mfma_f32_32x32x16_bf16(a, *(const bf16x8*)(sb), acc2, 0, 0, 0); }
      { const bf16x8 a = trfrag<1>(vbv); acc2 = __builtin_amdgcn_mfma_f32_32x32x16_bf16(a, *(const bf16x8*)(sb + 32), acc2, 0, 0, 0); }
      { const bf16x8 a = trfrag<2>(vbv); acc2 = __builtin_amdgcn_mfma_f32_32x32x16_bf16(a, *(const bf16x8*)(sb + 64), acc2, 0, 0, 0); }
      { const bf16x8 a = trfrag<3>(vbv); acc2 = __builtin_amdgcn_mfma_f32_32x32x16_bf16(a, *(const bf16x8*)(sb + 96), acc2, 0, 0, 0); }
      const int j = 32 * t_lo + r32; const float aj = A[j]; const float den = aj * NQ[j] + RS[j] + RS[64 + j];
      const float inv = 1.0f / fmaxf(fabsf(den), EM[j]);
      if (!isctx) { bf16_t* hp = H + (size_t)(R0 + (flip ? 63 - j : j)) * 2048 + h * 256 + vs * 64 + 32 * t_hi + 4 * hi;
#pragma unroll
        for (int g4 = 0; g4 < 4; ++g4) { u32x2 w; w.x = cvtpk((aj * acc1[4 * g4] + acc2[4 * g4]) * inv, (aj * acc1[4 * g4 + 1] + acc2[4 * g4 + 1]) * inv);
          w.y = cvtpk((aj * acc1[4 * g4 + 2] + acc2[4 * g4 + 2]) * inv, (aj * acc1[4 * g4 + 3] + acc2[4 * g4 + 3]) * inv);
          *(u32x2*)(hp + 8 * g4) = w; } }
    }
    if (tid < 128) { float s = 0.f;
#pragma unroll 8
      for (int si = 0; si < 64; ++si) s += WE[si] * bf2f(*(const bf16_t*)(lds + O_KS + si * 272 + tid * 2));
      nreg = aend * nreg + s; N0[tid] = nreg; }
    { const int dt = wid & 3, vt2 = wid >> 2;
      const int kb = (int)(uintptr_t)(lds + O_KTR) + v_rd_base(lane) + dt * 512;
      const int vb2 = (int)(uintptr_t)(lds + O_VTR) + v_rd_base(lane) + vt2 * 512;
#pragma unroll
      for (int r = 0; r < 16; ++r) cacc[r] *= aend;
      { const bf16x8 a = trfrag<0>(kb); const bf16x8 bv = scale_frag(trfrag<0>(vb2), WE + 0 + 8 * hi); cacc = __builtin_amdgcn_mfma_f32_32x32x16_bf16(a, bv, cacc, 0, 0, 0); }
      { const bf16x8 a = trfrag<1>(kb); const bf16x8 bv = scale_frag(trfrag<1>(vb2), WE + 16 + 8 * hi); cacc = __builtin_amdgcn_mfma_f32_32x32x16_bf16(a, bv, cacc, 0, 0, 0); }
      { const bf16x8 a = trfrag<2>(kb); const bf16x8 bv = scale_frag(trfrag<2>(vb2), WE + 32 + 8 * hi); cacc = __builtin_amdgcn_mfma_f32_32x32x16_bf16(a, bv, cacc, 0, 0, 0); }
      { const bf16x8 a = trfrag<3>(kb); const bf16x8 bv = scale_frag(trfrag<3>(vb2), WE + 48 + 8 * hi); cacc = __builtin_amdgcn_mfma_f32_32x32x16_bf16(a, bv, cacc, 0, 0, 0); }
#pragma unroll
      for (int g4 = 0; g4 < 4; ++g4) { u32x2 w; w.x = cvtpk(cacc[4 * g4], cacc[4 * g4 + 1]); w.y = cvtpk(cacc[4 * g4 + 2], cacc[4 * g4 + 3]);
        *(u32x2*)(lds + O_C0 + (32 * vt2 + r32) * 272 + (32 * dt + 8 * g4 + 4 * hi) * 2) = w; }
    }
  }
  __syncthreads();
}
}

__device__ void phase4_mixers(const Params& p, char* lds) {
  for (int item = blockIdx.x; item < 256; item += gridDim.x) ml::mlstm_scan(p, lds, item);
  bf16_t* QB = (bf16_t*)(p.ws + OFF_QB);
  const bf16_t* KA = (const bf16_t*)(p.ws + OFF_KALL); const bf16_t* VAl = (const bf16_t*)(p.ws + OFF_VALL);
  for (int i = blockIdx.x; i < 2048; i += gridDim.x) {
    const int g = i >> 7, b = g >> 2, kvh = g & 3, hq = kvh * 4 + ((i >> 5) & 3), qb = i & 31;
    const size_t qoff = (size_t)(b * SEQ + qb * 256) * 2048 + hq * 128, koff = (size_t)b * SKV * 512 + kvh * 128;
    att::attn_dense_body(QB + qoff, KA + koff, VAl + koff, SKV, lds);
    __syncthreads();
  }
}

#define GRID_SYNC() do { asm volatile("s_waitcnt vmcnt(0) lgkmcnt(0)" ::: "memory"); grid.sync(); } while (0)
__global__ void __launch_bounds__(512, 2) fwd_megakernel(Params p) {
  extern __shared__ __attribute__((aligned(16))) unsigned char lds[];
  cg::grid_group grid = cg::this_grid();
  unsigned char* ws = p.ws;
  PG8_LAS unsigned char* lds3 = (PG8_LAS unsigned char*)lds;
  phase0_prep(p, lds);
  GRID_SYNC();
  phase1_ln_mod(p);
  GRID_SYNC();
  { pg8::Gemm g{(const bf16_t*)(ws + OFF_U), (const bf16_t*)(ws + OFF_WT_IN), M_ALL, N1P, 2048}; pg8::StaticOrder S; S.init(M_ALL, N1P, (int)gridDim.x, (int)blockIdx.x);
    Epi1 E{ws, (unsigned char*)p.out}; pg8::gemm_phase<Epi1, pg8::StaticOrder>(lds3, g, S, E); }
  GRID_SYNC();
  phase3_elem(p);
  GRID_SYNC();
  phase4_mixers(p, (char*)lds);
  GRID_SYNC();
  phase5_gate(p);
  GRID_SYNC();
  { pg8::Gemm g{(const bf16_t*)(ws + OFF_OZ), (const bf16_t*)(ws + OFF_WT_BA), M_TOK, 2048, 2048}; pg8::StaticOrder S; S.init(M_TOK, 2048, (int)gridDim.x, (int)blockIdx.x);
    Epi2a E{(float*)(ws + OFF_TMP), (const bf16_t*)p.out}; pg8::gemm_phase<Epi2a, pg8::StaticOrder>(lds3, g, S, E); }
  __syncthreads();
  { pg8::Gemm g{(const bf16_t*)(ws + OFF_QB), (const bf16_t*)(ws + OFF_WT_BB), M_TOK, 2048, 2048}; pg8::StaticOrder S; S.init(M_TOK, 2048, (int)gridDim.x, (int)blockIdx.x);
    Epi2b E{(const float*)(ws + OFF_TMP), (const bf16_t*)p.out + (size_t)M_TOK * 2048, (bf16_t*)(ws + OFF_MERGED)}; pg8::gemm_phase<Epi2b, pg8::StaticOrder>(lds3, g, S, E); }
  GRID_SYNC();
  { pg8::Gemm g{(const bf16_t*)(ws + OFF_MERGED), (const bf16_t*)(ws + OFF_WT_OUT), M_TOK, 2048, 2048}; pg8::StaticOrder S; S.init(M_TOK, 2048, (int)gridDim.x, (int)blockIdx.x);
    Epi3 E{p.in[0], (const float*)(ws + OFF_MOD), p.out}; pg8::gemm_phase<Epi3, pg8::StaticOrder>(lds3, g, S, E); }
  GRID_SYNC();
  phase8_final_ln(p);
}

extern "C" void kernel_launch(void* const* d_in, const int* in_sizes, int n_in, void* d_out, int out_size, void* d_ws, size_t ws_size, hipStream_t stream) {
  static int grid_blocks = 0;
  if (!grid_blocks) {
    if (n_in != 18 || out_size != M_TOK * DM || ws_size < WS_END) { fprintf(stderr, "kernel_launch: unexpected shapes (n_in %d out %d ws %zu need %zu)\n", n_in, out_size, ws_size, (size_t)WS_END); grid_blocks = -1; return; }
    int dev = 0, cus = 0, per_cu = 0;
    (void)hipGetDevice(&dev);
    (void)hipDeviceGetAttribute(&cus, hipDeviceAttributeMultiprocessorCount, dev);
    (void)hipFuncSetAttribute((const void*)fwd_megakernel, hipFuncAttributeMaxDynamicSharedMemorySize, LDS_BYTES);
    (void)hipOccupancyMaxActiveBlocksPerMultiprocessor(&per_cu, fwd_megakernel, 512, LDS_BYTES);
    if (per_cu < 1) per_cu = 1;
    grid_blocks = cus * per_cu;
  }
  if (grid_blocks < 0) return;
  Params p{};
  for (int i = 0; i < 18; ++i) p.in[i] = (const float*)d_in[i];
  p.out = (float*)d_out; p.ws = (unsigned char*)d_ws;
  void* args[] = {&p};
  hipError_t e = hipLaunchCooperativeKernel((void*)fwd_megakernel, dim3(grid_blocks), dim3(512), args, LDS_BYTES, stream);
  if (e != hipSuccess) fprintf(stderr, "cooperative launch failed: %s (grid %d)\n", hipGetErrorString(e), grid_blocks);
}
```

```cpp
#include <hip/hip_runtime.h>
#include <hip/hip_cooperative_groups.h>
#include <cstdio>
#include <cstdint>
namespace cg = cooperative_groups;

constexpr int DM = 2048, NB = 4, SEQ = 8192, CTXL = 256;
constexpr int M_TOK = NB * SEQ, M_CTX = NB * CTXL, M_ALL = M_TOK + M_CTX;
constexpr int SKV = CTXL + SEQ;
constexpr int N_IN = 17440, N1P = 17664;
constexpr float LN_EPS = 1e-6f;
constexpr float ALPHA_DN = 1.189207115002721f;
constexpr int LDS_BYTES = 132 * 1024;

constexpr size_t SZ_W2 = (size_t)2048 * 2048 * 2;
constexpr size_t SZ_ALL = (size_t)M_ALL * 2048 * 2;
constexpr size_t SZ_TOK = (size_t)M_TOK * 2048 * 2;
constexpr size_t SZ_KV = (size_t)NB * SKV * 512 * 2;
constexpr size_t OFF_WT_BA = 0, OFF_WT_BB = SZ_W2, OFF_WT_OUT = 2 * SZ_W2;
constexpr size_t OFF_MOD = 3 * SZ_W2;
constexpr size_t OFF_ROPE = OFF_MOD + 131072;
constexpr size_t OFF_U = OFF_ROPE + 32768;
constexpr size_t OFF_QAKA = OFF_U;
constexpr size_t OFF_QKPRE = OFF_U + SZ_ALL;
constexpr size_t OFF_HF = OFF_QKPRE, OFF_MERGED = OFF_QKPRE;
constexpr size_t OFF_OZ = OFF_QKPRE + SZ_ALL;
constexpr size_t OFF_QB = OFF_OZ + SZ_TOK;
constexpr size_t OFF_ZB = OFF_QB + SZ_TOK;
constexpr size_t OFF_TMP = OFF_ZB;
constexpr size_t OFF_VA = OFF_ZB + SZ_TOK;
constexpr size_t OFF_VALL = OFF_VA + SZ_ALL;
constexpr size_t OFF_KALL = OFF_VALL + SZ_KV;
constexpr size_t OFF_GATES = OFF_KALL + SZ_KV;
constexpr size_t OFF_KBRAW = OFF_GATES + (size_t)M_ALL * 32 * 4;
constexpr size_t OFF_HB = OFF_KBRAW;
constexpr size_t OFF_WT_IN = OFF_KBRAW + SZ_KV;
constexpr size_t WS_END = OFF_HB + SZ_TOK;
static_assert(OFF_WT_IN + (size_t)N1P * 2048 * 2 <= WS_END, "ws map");
static_assert(OFF_TMP + (size_t)M_TOK * 2048 * 4 <= OFF_VALL, "tmp map");
static_assert(OFF_U % 256 == 0 && OFF_GATES % 256 == 0 && OFF_KBRAW % 256 == 0, "align");

typedef unsigned short bf16_t;
using f32x16 = __attribute__((ext_vector_type(16))) float;
using s16x4 = __attribute__((ext_vector_type(4))) short;
using u32x2 = __attribute__((ext_vector_type(2))) unsigned;

struct Params { const float* in[18]; float* out; unsigned char* ws; };

__device__ __forceinline__ float wave_sum(float v) {
#pragma unroll
  for (int o = 32; o >= 1; o >>= 1) v += __shfl_xor(v, o);
  return v;
}
__device__ __forceinline__ float bf2f(unsigned short b) { return __uint_as_float(((unsigned)b) << 16); }
__device__ __forceinline__ float bflo(unsigned w) { return __uint_as_float(w << 16); }
__device__ __forceinline__ float bfhi(unsigned w) { return __uint_as_float(w & 0xffff0000u); }
__device__ __forceinline__ float sigmoidf_(float x) { return __builtin_amdgcn_rcpf(1.0f + __expf(-x)); }
__device__ __forceinline__ float siluf_(float x) { return x * __builtin_amdgcn_rcpf(1.0f + __expf(-x)); }
namespace pg8 {
#define PG8_LAS __attribute__((address_space(3)))
typedef unsigned short bf16_t;
typedef short bf16x8 __attribute__((ext_vector_type(8)));
typedef float f32x4 __attribute__((ext_vector_type(4)));
typedef unsigned u32x4 __attribute__((ext_vector_type(4)));
constexpr int BM = 256, BK = 64, HALF = 128, HTB = HALF * BK * 2  , STAGE_BYTES = 8 * HTB, NXCD = 8, WGM = 8;

__host__ __device__ __forceinline__ int lds_byte(int r, int c) { const int st = (r >> 4) * 2 + (c >> 5), rr = r & 15, cc = c & 31, ob = rr * 64 + cc * 2; return st * 1024 + (ob ^ (((ob >> 9) & 1) << 5)); }
__host__ __device__ __forceinline__ void stage_rc(int b, int& R, int& C) { const int st = b / 1024, sb = b % 1024, swz = sb ^ (((sb >> 9) & 1) << 5); R = (st >> 1) * 16 + swz / 64; C = (st & 1) * 32 + (swz % 64) / 2; }
__host__ __device__ __forceinline__ int perm32(int rho) { const int n = rho >> 4, i = rho & 15; return 8 * (i >> 2) + 4 * n + (i & 3); }

struct Unit { int pm, pn; };
struct Gemm { const bf16_t* A; const bf16_t* Bt; int M, N, K; };

struct StaticOrder {
    int nM, nN, nwg, G, c;
    __host__ __device__ void init(int M, int N, int G_, int c_) { nM = M / BM; nN = N / BM; nwg = nM * nN; G = G_; c = c_; }
    __host__ __device__ bool next(int i, Unit& u) const {
        const long L = (long)i * G + c; if (L >= nwg) return false;
        int wgid = (int)L; { const int q = nwg / NXCD, r = nwg % NXCD, xcd = wgid % NXCD, off = wgid / NXCD; wgid = (xcd < r ? xcd * (q + 1) : r * (q + 1) + (xcd - r) * q) + off; }
        const int nig = WGM * nN, gid = wgid / nig, fm = gid * WGM, gsz = (nM - fm) < WGM ? (nM - fm) : WGM;
        u.pm = fm + ((wgid % nig) % gsz); u.pn = (wgid % nig) / gsz; return true;
    }
    __device__ __forceinline__ void a_ready(const Unit&) const {}
    __device__ __forceinline__ void done(const Unit&) const {}
};
__device__ __forceinline__ unsigned cvt_pk_bf16(float lo, float hi) { unsigned r; asm volatile("v_cvt_pk_bf16_f32 %0, %1, %2" : "=v"(r) : "v"(lo), "v"(hi)); return r; }
template <class Epi, class Sched>
__device__ __forceinline__ void gemm_phase(PG8_LAS unsigned char* lds, const Gemm g, const Sched& S, const Epi& E) {
    int tid_l = threadIdx.x; asm volatile("" : "+v"(tid_l)); const int tid = tid_l, wid = __builtin_amdgcn_readfirstlane(tid >> 6), lane = tid & 63, wr = wid >> 2, wc = wid & 3, fr = lane & 15, fq = lane >> 4;
    const int K = g.K, nt = K / BK;
    unsigned voffA[2], voffB[2];
#pragma unroll
    for (int i = 0; i < 2; ++i) { int R, C; stage_rc(tid * 16 + i * 8192, R, C); const int Rb = Epi::PERM ? ((R & ~31) + perm32(R & 31)) : R;
        voffA[i] = (unsigned)(R * K + C) * 2u; voffB[i] = (unsigned)(Rb * K + C) * 2u; }
    const size_t kstep = (size_t)(BK * 2);
    const size_t hstep = (size_t)HALF * K * 2;
    const size_t tstep = 2 * hstep;
    const unsigned ldsw = (unsigned)wid * 1024u;
    const int aoff = lds_byte(wr * 64 + fr, fq * 8), boff = lds_byte(wc * 32 + fr, fq * 8);
#define PG8_SA(b, h) (((b) * 2 + (h)) * HTB)
#define PG8_SB(b, h) ((4 + (b) * 2 + (h)) * HTB)
#define PG8_STAGE(bufoff, gbase, voff) do { _Pragma("unroll") for (int _i = 0; _i < 2; ++_i) \
        __builtin_amdgcn_global_load_lds((const unsigned*)((const char*)(gbase) + (voff)[_i]), (PG8_LAS unsigned*)(lds + (bufoff) + ldsw + _i * 8192), 16, 0, 0); } while (0)
#define PG8_LDA(dst, b, h) do { _Pragma("unroll") for (int m = 0; m < 4; ++m) _Pragma("unroll") for (int k = 0; k < 2; ++k) dst[m][k] = *(const PG8_LAS bf16x8*)(lds + PG8_SA(b, h) + aoff + m * 2048 + k * 1024); } while (0)
#define PG8_LDB(dst, b, h) do { _Pragma("unroll") for (int n = 0; n < 2; ++n) _Pragma("unroll") for (int k = 0; k < 2; ++k) dst[n][k] = *(const PG8_LAS bf16x8*)(lds + PG8_SB(b, h) + boff + n * 2048 + k * 1024); } while (0)
#define PG8_MMA(ai, bj, At, Bt) do { __builtin_amdgcn_s_setprio(1); _Pragma("unroll") for (int m = 0; m < 4; ++m) _Pragma("unroll") for (int n = 0; n < 2; ++n) _Pragma("unroll") for (int k = 0; k < 2; ++k) \
        acc[ai][bj][m][n] = __builtin_amdgcn_mfma_f32_16x16x32_bf16(Bt[n][k], At[m][k], acc[ai][bj][m][n], 0, 0, 0); __builtin_amdgcn_s_setprio(0); } while (0)
#define PG8_WAIT_V(n) asm volatile("s_waitcnt vmcnt(" #n ")" ::: "memory")
#define PG8_WAIT_L(n) asm volatile("s_waitcnt lgkmcnt(" #n ")" ::: "memory")
#define PG8_BAR __builtin_amdgcn_s_barrier()
#define PG8_SCHED __builtin_amdgcn_sched_barrier(0)
    Unit cur, nxt; int ui = 0;
    if (!S.next(0, cur)) return;
    f32x4 acc[2][2][4][2];
#pragma unroll
    for (int a = 0; a < 2; ++a)
#pragma unroll
        for (int b = 0; b < 2; ++b)
#pragma unroll
            for (int m = 0; m < 4; ++m)
#pragma unroll
                for (int n = 0; n < 2; ++n) acc[a][b][m][n] = (f32x4){0.f, 0.f, 0.f, 0.f};
    bf16x8 At[4][2], B0[2][2], B1[2][2];
    const char* cA = (const char*)g.A + (size_t)cur.pm * tstep; const char* cB = (const char*)g.Bt + (size_t)cur.pn * tstep;
    S.a_ready(cur);
    PG8_STAGE(PG8_SB(0, 0), cB, voffB); PG8_STAGE(PG8_SA(0, 0), cA, voffA); PG8_STAGE(PG8_SB(0, 1), cB + hstep, voffB); PG8_STAGE(PG8_SA(0, 1), cA + hstep, voffA);
    if (wr == 1) PG8_BAR;
    PG8_WAIT_V(4); PG8_BAR;
    PG8_STAGE(PG8_SB(1, 0), cB + kstep, voffB); PG8_STAGE(PG8_SA(1, 0), cA + kstep, voffA); PG8_STAGE(PG8_SB(1, 1), cB + hstep + kstep, voffB);
    PG8_WAIT_V(6); PG8_BAR;
    for (;;) {
        const bool has_next = S.next(ui + 1, nxt);
        const char* nA = has_next ? (const char*)g.A + (size_t)nxt.pm * tstep : cA; const char* nB = has_next ? (const char*)g.Bt + (size_t)nxt.pn * tstep : cB;
        for (int t = 0; t < nt; t += 2) {
            const bool last = (t == nt - 2);
            const char* a1 = cA + (size_t)(t + 1) * kstep;
            const char* a2 = last ? nA : cA + (size_t)(t + 2) * kstep; const char* b2 = last ? nB : cB + (size_t)(t + 2) * kstep;
            const char* a3 = a2 + kstep; const char* b3 = b2 + kstep;
            if (last && has_next) S.a_ready(nxt);
            PG8_LDB(B0, 0, 0); PG8_SCHED; PG8_LDA(At, 0, 0); PG8_STAGE(PG8_SA(1, 1), a1 + hstep, voffA);
            PG8_WAIT_L(8); PG8_BAR; PG8_WAIT_L(0); PG8_MMA(0, 0, At, B0); PG8_BAR; PG8_SCHED;
            PG8_LDB(B1, 0, 1); PG8_STAGE(PG8_SB(0, 0), b2, voffB);
            PG8_BAR; PG8_WAIT_L(0); PG8_MMA(0, 1, At, B1); PG8_BAR;
            PG8_LDA(At, 0, 1); PG8_STAGE(PG8_SA(0, 0), a2, voffA);
            PG8_BAR; PG8_WAIT_L(0); PG8_MMA(1, 0, At, B0); PG8_BAR; PG8_SCHED;
            PG8_STAGE(PG8_SB(0, 1), b2 + hstep, voffB);
            PG8_WAIT_V(6); PG8_BAR; PG8_MMA(1, 1, At, B1); PG8_BAR;
            PG8_LDB(B0, 1, 0); PG8_SCHED; PG8_LDA(At, 1, 0); PG8_STAGE(PG8_SA(0, 1), a2 + hstep, voffA);
            PG8_WAIT_L(8); PG8_BAR; PG8_WAIT_L(0); PG8_MMA(0, 0, At, B0); PG8_BAR; PG8_SCHED;
            PG8_LDB(B1, 1, 1); PG8_STAGE(PG8_SB(1, 0), b3, voffB);
            PG8_BAR; PG8_WAIT_L(0); PG8_MMA(0, 1, At, B1); PG8_BAR;
            PG8_LDA(At, 1, 1); PG8_STAGE(PG8_SA(1, 0), a3, voffA);
            PG8_BAR; PG8_WAIT_L(0); PG8_MMA(1, 0, At, B0); PG8_BAR; PG8_SCHED;
            PG8_STAGE(PG8_SB(1, 1), b3 + hstep, voffB);
            PG8_WAIT_V(6); PG8_BAR; PG8_MMA(1, 1, At, B1); PG8_BAR;
        }
        if constexpr (!Epi::AFTER_DRAIN) { E(acc, cur, wr, wc, fr, fq); S.done(cur); }
        if (!has_next) break;
#pragma unroll
        for (int a = 0; a < 2; ++a)
#pragma unroll
            for (int b = 0; b < 2; ++b)
#pragma unroll
                for (int m = 0; m < 4; ++m)
#pragma unroll
                    for (int n = 0; n < 2; ++n) acc[a][b][m][n] = (f32x4){0.f, 0.f, 0.f, 0.f};
        cur = nxt; cA = nA; cB = nB; ++ui;
    }
    PG8_WAIT_V(0);
    if (wr == 0) PG8_BAR;
    PG8_BAR;
    if constexpr (Epi::AFTER_DRAIN) { E.fused(acc, cur, wr, wc, fr, fq, lds, wid, lane); S.done(cur); }
#undef PG8_SA
#undef PG8_SB
#undef PG8_STAGE
#undef PG8_LDA
#undef PG8_LDB
#undef PG8_MMA
#undef PG8_WAIT_V
#undef PG8_WAIT_L
#undef PG8_BAR
#undef PG8_SCHED
}
}


using pg8::f32x4; using pg8::u32x4; using pg8::bf16x8; using pg8::cvt_pk_bf16;

struct Epi1 {
  static constexpr bool PERM = true, AFTER_DRAIN = false;
  unsigned char* ws; unsigned char* dout;
  __device__ __forceinline__ void operator()(const f32x4 (&acc)[2][2][4][2], const pg8::Unit& u, int wr, int wc, int fr, int fq) const {
    const int pn = u.pn, pm = u.pm; const bool lat = pm < 128;
    const int rl = wr * 64 + fr, cl = wc * 32 + 8 * fq;
    if (pn == 20) {
      if (wc == 0) { float* G = (float*)(ws + OFF_GATES);
#pragma unroll
        for (int ai = 0; ai < 2; ++ai)
#pragma unroll
          for (int m = 0; m < 4; ++m) { float* rp = G + (size_t)(pm * 256 + ai * 128 + rl + m * 16) * 32 + 8 * fq;
            *(f32x4*)rp = acc[ai][0][m][0]; *(f32x4*)(rp + 4) = acc[ai][0][m][1]; } }
      return;
    }
    if (pn >= 21 && pn < 37) {
      if (!lat) return;
      bf16_t* O = (bf16_t*)(ws + OFF_OZ) + (pn - 21) * 128 + cl;
#pragma unroll
      for (int ai = 0; ai < 2; ++ai)
#pragma unroll
        for (int m = 0; m < 4; ++m) { const size_t row = (size_t)pm * 256 + ai * 128 + rl + m * 16;
          float r[8];
#pragma unroll
          for (int n = 0; n < 2; ++n)
#pragma unroll
            for (int e = 0; e < 4; ++e) r[n * 4 + e] = sigmoidf_(acc[ai][0][m][n][e]) * siluf_(acc[ai][1][m][n][e]);
          u32x4 w; w.x = cvt_pk_bf16(r[0], r[1]); w.y = cvt_pk_bf16(r[2], r[3]); w.z = cvt_pk_bf16(r[4], r[5]); w.w = cvt_pk_bf16(r[6], r[7]);
          *(u32x4*)(O + row * 2048) = w; }
      return;
    }
    bf16_t* O; int ld = 2048, act = 0; size_t rowbase = (size_t)pm * 256;
    if (pn < 8) { O = (bf16_t*)(ws + OFF_QKPRE) + pn * 256; }
    else if (pn < 16) { O = (bf16_t*)(ws + OFF_VA) + (pn - 8) * 256; }
    else if (pn < 18) { O = (bf16_t*)(ws + OFF_KBRAW) + (pn - 16) * 256; ld = 512; }
    else if (pn < 20) { O = (bf16_t*)(ws + OFF_VALL) + (pn - 18) * 256; ld = 512;
      rowbase = lat ? (size_t)(pm >> 5) * SKV + CTXL + (size_t)(pm & 31) * 256 : (size_t)(pm - 128) * SKV; }
    else { if (!lat) return;
      if (pn < 45) { O = (bf16_t*)(ws + OFF_QB) + (pn - 37) * 256; }
      else if (pn < 53) { O = (bf16_t*)(ws + OFF_ZB) + (pn - 45) * 256; act = 1; }
      else if (pn < 61) { O = (bf16_t*)dout + (pn - 53) * 256; act = 2; }
      else { O = (bf16_t*)dout + (size_t)M_TOK * 2048 + (pn - 61) * 256; act = 2; } }
#pragma unroll
    for (int ai = 0; ai < 2; ++ai)
#pragma unroll
      for (int m = 0; m < 4; ++m) { bf16_t* rowp = O + (rowbase + ai * 128 + rl + m * 16) * ld + cl;
#pragma unroll
        for (int bj = 0; bj < 2; ++bj) { f32x4 v0 = acc[ai][bj][m][0], v1 = acc[ai][bj][m][1];
          if (act == 1) {
#pragma unroll
            for (int e = 0; e < 4; ++e) { v0[e] = siluf_(v0[e]); v1[e] = siluf_(v1[e]); } }
          else if (act == 2) {
#pragma unroll
            for (int e = 0; e < 4; ++e) { v0[e] = sigmoidf_(v0[e]); v1[e] = sigmoidf_(v1[e]); } }
          u32x4 w; w.x = cvt_pk_bf16(v0[0], v0[1]); w.y = cvt_pk_bf16(v0[2], v0[3]); w.z = cvt_pk_bf16(v1[0], v1[1]); w.w = cvt_pk_bf16(v1[2], v1[3]);
          *(u32x4*)(rowp + bj * 128) = w; } }
  }
};
struct Epi2a {
  static constexpr bool PERM = true, AFTER_DRAIN = false;
  bf16_t* tmp; const bf16_t* sg;
  __device__ __forceinline__ void operator()(const f32x4 (&acc)[2][2][4][2], const pg8::Unit& u, int wr, int wc, int fr, int fq) const {
    const int col0 = u.pn * 256 + wc * 32 + 8 * fq;
#pragma unroll
    for (int ai = 0; ai < 2; ++ai)
#pragma unroll
      for (int m = 0; m < 4; ++m) { const size_t off = (size_t)(u.pm * 256 + ai * 128 + wr * 64 + fr + m * 16) * 2048 + col0;
#pragma unroll
        for (int bj = 0; bj < 2; ++bj) { const u32x4 s = *(const u32x4*)(sg + off + bj * 128);
          f32x4 a = acc[ai][bj][m][0], b = acc[ai][bj][m][1];
          a[0] *= bflo(s.x); a[1] *= bfhi(s.x); a[2] *= bflo(s.y); a[3] *= bfhi(s.y);
          b[0] *= bflo(s.z); b[1] *= bfhi(s.z); b[2] *= bflo(s.w); b[3] *= bfhi(s.w);
          u32x4 w; w.x = cvt_pk_bf16(a[0], a[1]); w.y = cvt_pk_bf16(a[2], a[3]); w.z = cvt_pk_bf16(b[0], b[1]); w.w = cvt_pk_bf16(b[2], b[3]);
          *(u32x4*)(tmp + off + bj * 128) = w; } }
  }
};
struct Epi2b {
  static constexpr bool PERM = true, AFTER_DRAIN = false;
  const bf16_t* tmp; const bf16_t* sg; bf16_t* merged;
  __device__ __forceinline__ void operator()(const f32x4 (&acc)[2][2][4][2], const pg8::Unit& u, int wr, int wc, int fr, int fq) const {
    const int col0 = u.pn * 256 + wc * 32 + 8 * fq;
#pragma unroll
    for (int ai = 0; ai < 2; ++ai)
#pragma unroll
      for (int m = 0; m < 4; ++m) { const size_t off = (size_t)(u.pm * 256 + ai * 128 + wr * 64 + fr + m * 16) * 2048 + col0;
#pragma unroll
        for (int bj = 0; bj < 2; ++bj) { const u32x4 s = *(const u32x4*)(sg + off + bj * 128);
          const u32x4 tw = *(const u32x4*)(tmp + off + bj * 128); const f32x4 t0 = {bflo(tw.x), bfhi(tw.x), bflo(tw.y), bfhi(tw.y)}, t1 = {bflo(tw.z), bfhi(tw.z), bflo(tw.w), bfhi(tw.w)};
          f32x4 a = acc[ai][bj][m][0], b = acc[ai][bj][m][1];
          a[0] = t0[0] + a[0] * bflo(s.x); a[1] = t0[1] + a[1] * bfhi(s.x); a[2] = t0[2] + a[2] * bflo(s.y); a[3] = t0[3] + a[3] * bfhi(s.y);
          b[0] = t1[0] + b[0] * bflo(s.z); b[1] = t1[1] + b[1] * bfhi(s.z); b[2] = t1[2] + b[2] * bflo(s.w); b[3] = t1[3] + b[3] * bfhi(s.w);
          u32x4 w; w.x = cvt_pk_bf16(a[0], a[1]); w.y = cvt_pk_bf16(a[2], a[3]); w.z = cvt_pk_bf16(b[0], b[1]); w.w = cvt_pk_bf16(b[2], b[3]);
          *(u32x4*)(merged + off + bj * 128) = w; } }
  }
};
struct Epi3 {
  static constexpr bool PERM = false, AFTER_DRAIN = false;
  const float* x; const float* mod; float* y;
  __device__ __forceinline__ void operator()(const f32x4 (&acc)[2][2][4][2], const pg8::Unit& u, int wr, int wc, int fr, int fq) const {
    const int col0 = u.pn * 256 + wc * 32 + 4 * fq;
    const float* gate = mod + (size_t)(u.pm >> 5) * 6144 + 4096 + col0;
    f32x4 gv[2][2];
#pragma unroll
    for (int bj = 0; bj < 2; ++bj)
#pragma unroll
      for (int n = 0; n < 2; ++n) gv[bj][n] = *(const f32x4*)(gate + bj * 128 + n * 16);
#pragma unroll
    for (int ai = 0; ai < 2; ++ai)
#pragma unroll
      for (int m = 0; m < 4; ++m) { const size_t off = (size_t)(u.pm * 256 + ai * 128 + wr * 64 + fr + m * 16) * 2048 + col0;
#pragma unroll
        for (int bj = 0; bj < 2; ++bj)
#pragma unroll
          for (int n = 0; n < 2; ++n) { const f32x4 xv = *(const f32x4*)(x + off + bj * 128 + n * 16);
            *(f32x4*)(y + off + bj * 128 + n * 16) = xv * ALPHA_DN + gv[bj][n] * acc[ai][bj][m][n]; } }
  }
};

struct InProjOrder {
  pg8::StaticOrder base; int G, c;
  __device__ void init(int G_, int c_) { base.init(M_TOK, N1P, G_, c_); G = G_; c = c_; }
  __device__ bool next(int i, pg8::Unit& u) const {
    const long L = (long)i * G + c; if (L < base.nwg) return base.next(i, u);
    const int r = (int)(L - base.nwg); if (r >= 4 * 21) return false;
    u.pm = 128 + (r & 3); u.pn = r >> 2; return true; }
  __device__ __forceinline__ void a_ready(const pg8::Unit&) const {}
  __device__ __forceinline__ void done(const pg8::Unit&) const {}
};

__device__ __forceinline__ int orig_col(int n) {
  if (n < 4096) return n;
  if (n < 4608) return 4128 + (n - 4096);
  if (n < 5120) return 4640 + (n - 4608);
  if (n < 5152) return 4096 + (n - 5120);
  if (n < 5376) return -1;
  if (n < 9472) { const int t = n - 5376, j = t >> 8, r = t & 255; return r < 128 ? 5152 + 128 * j + r : 7200 + 128 * j + (r - 128); }
  if (n < 11520) return 9248 + (n - 9472);
  if (n < 13568) return 11296 + (n - 11520);
  return 13344 + (n - 13568);
}
__device__ void phase0_prep(const Params& p, unsigned char* lds) {
  int tid_l = threadIdx.x; asm volatile("" : "+v"(tid_l)); const int tid = tid_l, wid = tid >> 6, lane = tid & 63;
  unsigned char* ws = p.ws;
  for (int idx = blockIdx.x * 512 + tid; idx < 4096; idx += gridDim.x * 512) {
    const int pos = idx >> 5, i = idx & 31; const float inv = powf(10000.0f, -(float)(2 * i) / 64.0f); const float ang = (float)pos * inv;
    float2 cs; cs.x = cosf(ang); cs.y = sinf(ang); ((float2*)(ws + OFF_ROPE))[idx] = cs; }
  float* sl = (float*)lds; float* red = sl + 5 * 2048; bool did = false;
  for (int it = blockIdx.x; it < 192; it += gridDim.x) {
    if (!did) { for (int i = tid; i < 5 * 2048; i += 512) { const int r = i >> 11, k = i & 2047; const float c = (r < 4) ? p.in[1][r * 2048 + k] : p.in[3][k]; sl[i] = c / (1.0f + expf(-c)); }
      __syncthreads(); did = true; }
    const int col = lane & 31, kh = lane >> 5, n = it * 32 + col;
    float a0 = 0.f, a1 = 0.f, a2 = 0.f, a3 = 0.f, a4 = 0.f;
    const float* wp = p.in[4] + (size_t)(wid * 256 + kh) * 6144 + n;
#pragma unroll 8
    for (int i = 0; i < 128; ++i) { const int k = wid * 256 + 2 * i + kh; const float w = wp[(size_t)(2 * i) * 6144];
      a0 += sl[k] * w; a1 += sl[2048 + k] * w; a2 += sl[4096 + k] * w; a3 += sl[6144 + k] * w; a4 += sl[8192 + k] * w; }
    a0 += __shfl_xor(a0, 32); a1 += __shfl_xor(a1, 32); a2 += __shfl_xor(a2, 32); a3 += __shfl_xor(a3, 32); a4 += __shfl_xor(a4, 32);
    if (kh == 0) { red[(wid * 5 + 0) * 32 + col] = a0; red[(wid * 5 + 1) * 32 + col] = a1; red[(wid * 5 + 2) * 32 + col] = a2; red[(wid * 5 + 3) * 32 + col] = a3; red[(wid * 5 + 4) * 32 + col] = a4; }
    __syncthreads();
    if (tid < 160) { const int r = tid >> 5, c = tid & 31; float s = 0.f;
#pragma unroll
      for (int w = 0; w < 8; ++w) s += red[(w * 5 + r) * 32 + c];
      ((float*)(ws + OFF_MOD))[r * 6144 + it * 32 + c] = s + p.in[5][it * 32 + c]; }
    __syncthreads();
  }
  __syncthreads();
  float* tile = (float*)lds;
  constexpr int NT_IN = (N1P / 64) * 32, NT = NT_IN + 3 * 1024;
  for (int t = blockIdx.x; t < NT; t += gridDim.x) {
    const float* src; bf16_t* dst; int ldsrc, n0, k0; bool perm;
    if (t < NT_IN) { src = p.in[6]; dst = (bf16_t*)(ws + OFF_WT_IN); ldsrc = N_IN; n0 = (t >> 5) * 64; k0 = (t & 31) * 64; perm = true; }
    else { int q = t - NT_IN; const int w = q >> 10; q &= 1023; src = p.in[13 + w]; dst = (bf16_t*)(ws + OFF_WT_BA + (size_t)w * SZ_W2); ldsrc = 2048; n0 = (q >> 5) * 64; k0 = (q & 31) * 64; perm = false; }
#pragma unroll
    for (int i = 0; i < 2; ++i) { const int kk = (tid >> 4) + 32 * i, nq = (tid & 15) * 4; const int oc = perm ? orig_col(n0 + nq) : n0 + nq;
      float4 v = make_float4(0.f, 0.f, 0.f, 0.f); if (oc >= 0) v = *(const float4*)(src + (size_t)(k0 + kk) * ldsrc + oc);
      float* tp = tile + kk * 65 + nq; tp[0] = v.x; tp[1] = v.y; tp[2] = v.z; tp[3] = v.w; }
    __syncthreads();
    { const int nn = tid >> 3, kq = (tid & 7) * 8; float r[8];
#pragma unroll
      for (int e = 0; e < 8; ++e) r[e] = tile[(kq + e) * 65 + nn];
      u32x4 w; w.x = cvt_pk_bf16(r[0], r[1]); w.y = cvt_pk_bf16(r[2], r[3]); w.z = cvt_pk_bf16(r[4], r[5]); w.w = cvt_pk_bf16(r[6], r[7]);
      *(u32x4*)(dst + (size_t)(n0 + nn) * 2048 + k0 + kq) = w; }
    __syncthreads();
  }
}

__device__ void phase1_ln_mod(const Params& p) {
  int tid_l = threadIdx.x; asm volatile("" : "+v"(tid_l)); const int tid = tid_l, wid = tid >> 6, lane = tid & 63;
  const float* MOD = (const float*)(p.ws + OFF_MOD); bf16_t* U = (bf16_t*)(p.ws + OFF_U);
  for (int row = blockIdx.x * 8 + wid; row < M_ALL; row += gridDim.x * 8) {
    const float* src = row < M_TOK ? p.in[0] + (size_t)row * 2048 : p.in[2] + (size_t)(row - M_TOK) * 2048;
    const float* md = MOD + (size_t)(row < M_TOK ? (row >> 13) : 4) * 6144;
    float4 v[4][2]; float s = 0.f;
#pragma unroll
    for (int g = 0; g < 4; ++g) { const float4* q = (const float4*)(src + g * 512 + lane * 8); v[g][0] = q[0]; v[g][1] = q[1];
      s += (v[g][0].x + v[g][0].y) + (v[g][0].z + v[g][0].w) + (v[g][1].x + v[g][1].y) + (v[g][1].z + v[g][1].w); }
    s = wave_sum(s); const float mu = s * (1.0f / 2048.0f); float q2 = 0.f;
#pragma unroll
    for (int g = 0; g < 4; ++g)
#pragma unroll
      for (int h = 0; h < 2; ++h) { const float a = v[g][h].x - mu, b = v[g][h].y - mu, c = v[g][h].z - mu, d = v[g][h].w - mu; q2 += (a * a + b * b) + (c * c + d * d); }
    q2 = wave_sum(q2); const float rs = rsqrtf(q2 * (1.0f / 2048.0f) + LN_EPS);
#pragma unroll
    for (int g = 0; g < 4; ++g) { const int c0 = g * 512 + lane * 8; float r[8];
#pragma unroll
      for (int h = 0; h < 2; ++h) { const float4 sh = *(const float4*)(md + c0 + 4 * h), sc = *(const float4*)(md + 2048 + c0 + 4 * h);
        r[4 * h + 0] = (v[g][h].x - mu) * rs * (1.0f + sc.x) + sh.x; r[4 * h + 1] = (v[g][h].y - mu) * rs * (1.0f + sc.y) + sh.y;
        r[4 * h + 2] = (v[g][h].z - mu) * rs * (1.0f + sc.z) + sh.z; r[4 * h + 3] = (v[g][h].w - mu) * rs * (1.0f + sc.w) + sh.w; }
      u32x4 w; w.x = cvt_pk_bf16(r[0], r[1]); w.y = cvt_pk_bf16(r[2], r[3]); w.z = cvt_pk_bf16(r[4], r[5]); w.w = cvt_pk_bf16(r[6], r[7]);
      *(u32x4*)(U + (size_t)row * 2048 + c0) = w; }
  }
}

__device__ __forceinline__ void unpack8(const u32x4 w, float* f) { f[0] = bflo(w.x); f[1] = bfhi(w.x); f[2] = bflo(w.y); f[3] = bfhi(w.y); f[4] = bflo(w.z); f[5] = bfhi(w.z); f[6] = bflo(w.w); f[7] = bfhi(w.w); }
__device__ __forceinline__ u32x4 pack8(const float* r) { u32x4 w; w.x = cvt_pk_bf16(r[0], r[1]); w.y = cvt_pk_bf16(r[2], r[3]); w.z = cvt_pk_bf16(r[4], r[5]); w.w = cvt_pk_bf16(r[6], r[7]); return w; }
__device__ __forceinline__ u32x4 norm_rope_head(const u32x4 raw, const float* nw, const float2* rope, int j, int pos_r, int pos_c) {
  float x[8]; unpack8(raw, x); float ss = 0.f;
#pragma unroll
  for (int e = 0; e < 8; ++e) ss += x[e] * x[e];
  ss += __shfl_xor(ss, 1); ss += __shfl_xor(ss, 2); ss += __shfl_xor(ss, 4); ss += __shfl_xor(ss, 8);
  const float rs = rsqrtf(ss * (1.0f / 128.0f) + LN_EPS);
  const float4 w0 = *(const float4*)(nw + 8 * j), w1 = *(const float4*)(nw + 8 * j + 4);
  x[0] *= rs * w0.x; x[1] *= rs * w0.y; x[2] *= rs * w0.z; x[3] *= rs * w0.w; x[4] *= rs * w1.x; x[5] *= rs * w1.y; x[6] *= rs * w1.z; x[7] *= rs * w1.w;
  float o[8];
  const bool is_x1 = ((j >> 2) & 1) == 0; const int pos = (j < 8) ? pos_r : pos_c; const int fi = 8 * (j & 3);
#pragma unroll
  for (int e = 0; e < 8; ++e) { const float pv = __shfl_xor(x[e], 4);
    if (pos_r >= 0) { const float2 cs = rope[pos * 32 + fi + e]; o[e] = is_x1 ? (x[e] * cs.x - pv * cs.y) : (pv * cs.y + x[e] * cs.x); }
    else o[e] = x[e]; }
  return pack8(o);
}
__device__ void phase3_elem(const Params& p) {
  int tid_l = threadIdx.x; asm volatile("" : "+v"(tid_l)); const int tid = tid_l, wid = tid >> 6, lane = tid & 63;
  unsigned char* ws = p.ws;
  { const bf16_t* X = (const bf16_t*)(ws + OFF_QKPRE); bf16_t* Y = (bf16_t*)(ws + OFF_QAKA); const float* cw = p.in[8]; const float* cb = p.in[9];
    for (size_t idx = (size_t)blockIdx.x * 512 + tid; idx < (size_t)M_ALL * 256; idx += (size_t)gridDim.x * 512) {
      const int row = (int)(idx >> 8), c8 = (int)(idx & 255) * 8;
      bool first, last; if (row < M_TOK) { const int s = row & (SEQ - 1); first = s == 0; last = s == SEQ - 1; } else { const int t = (row - M_TOK) & (CTXL - 1); first = t == 0; last = t == CTXL - 1; }
      const u32x4 z = {0u, 0u, 0u, 0u};
      const u32x4 cu = *(const u32x4*)(X + (size_t)row * 2048 + c8);
      const u32x4 pr = first ? z : *(const u32x4*)(X + (size_t)(row - 1) * 2048 + c8);
      const u32x4 nx = last ? z : *(const u32x4*)(X + (size_t)(row + 1) * 2048 + c8);
      float a[8], b[8], c[8], r[8]; unpack8(pr, a); unpack8(cu, b); unpack8(nx, c);
      const float sc = c8 >= 1024 ? 0.08838834764831845f : 1.0f;
#pragma unroll
      for (int e = 0; e < 8; ++e) { const float y = cb[c8 + e] + a[e] * cw[c8 + e] + b[e] * cw[2048 + c8 + e] + c[e] * cw[4096 + c8 + e]; r[e] = siluf_(y) * sc; }
      *(u32x4*)(Y + (size_t)row * 2048 + c8) = pack8(r); } }
  const float2* rope = (const float2*)(ws + OFF_ROPE);
  const int j = lane & 15, hl = lane >> 4;
  { const bf16_t* X = (const bf16_t*)(ws + OFF_KBRAW); bf16_t* Y = (bf16_t*)(ws + OFF_KALL);
    for (int row = blockIdx.x * 8 + wid; row < M_ALL; row += gridDim.x * 8) {
      size_t drow; int pr = -1, pc = -1;
      if (row < M_TOK) { const int b = row >> 13, s = row & (SEQ - 1); drow = (size_t)b * SKV + CTXL + s; pr = s >> 6; pc = s & 63; }
      else { const int b = (row - M_TOK) >> 8, t = (row - M_TOK) & (CTXL - 1); drow = (size_t)b * SKV + t; }
      const u32x4 raw = *(const u32x4*)(X + (size_t)row * 512 + hl * 128 + j * 8);
      *(u32x4*)(Y + drow * 512 + hl * 128 + j * 8) = norm_rope_head(raw, p.in[12], rope, j, pr, pc); } }
  { bf16_t* X = (bf16_t*)(ws + OFF_QB);
    for (int it = blockIdx.x * 8 + wid; it < M_TOK * 4; it += gridDim.x * 8) {
      const int row = it >> 2, hd = (it & 3) * 4 + hl, s = row & (SEQ - 1);
      bf16_t* q = X + (size_t)row * 2048 + hd * 128 + j * 8;
      const u32x4 raw = *(const u32x4*)q;
      *(u32x4*)q = norm_rope_head(raw, p.in[11], rope, j, s >> 6, s & 63); } }
}

__device__ void phase5_gate(const Params& p) {
  int tid_l = threadIdx.x; asm volatile("" : "+v"(tid_l)); const int tid = tid_l, wid = tid >> 6, lane = tid & 63;
  const bf16_t* HF = (const bf16_t*)(p.ws + OFF_HF); const bf16_t* HB = (const bf16_t*)(p.ws + OFF_HB); bf16_t* OZ = (bf16_t*)(p.ws + OFF_OZ);
  const float* nw = p.in[10];
  const int j = lane & 31, hl = lane >> 5;
  for (int it = blockIdx.x * 8 + wid; it < M_TOK * 4; it += gridDim.x * 8) {
    const size_t off = (size_t)(it >> 2) * 2048 + ((it & 3) * 2 + hl) * 256 + j * 8;
    float a[8], b[8], g[8], r[8]; unpack8(*(const u32x4*)(HF + off), a); unpack8(*(const u32x4*)(HB + off), b); unpack8(*(const u32x4*)(OZ + off), g);
    float ss = 0.f;
#pragma unroll
    for (int e = 0; e < 8; ++e) { a[e] += b[e]; ss += a[e] * a[e]; }
    ss += __shfl_xor(ss, 1); ss += __shfl_xor(ss, 2); ss += __shfl_xor(ss, 4); ss += __shfl_xor(ss, 8); ss += __shfl_xor(ss, 16);
    const float rs = rsqrtf(ss * (1.0f / 256.0f) + LN_EPS);
    const float* w = nw + ((it & 3) * 2 + hl) * 256 + j * 8;
#pragma unroll
    for (int e = 0; e < 8; ++e) r[e] = a[e] * rs * w[e] * g[e];
    *(u32x4*)(OZ + off) = pack8(r);
  }
}

__device__ void phase8_final_ln(const Params& p) {
  int tid_l = threadIdx.x; asm volatile("" : "+v"(tid_l)); const int tid = tid_l, wid = tid >> 6, lane = tid & 63;
  const float* lw = p.in[16]; const float* lb = p.in[17];
  for (int row = blockIdx.x * 8 + wid; row < M_TOK; row += gridDim.x * 8) {
    float4* r = (float4*)(p.out + (size_t)row * 2048);
    float4 v[8]; float s = 0.f;
#pragma unroll
    for (int i = 0; i < 8; ++i) { v[i] = r[lane + 64 * i]; s += (v[i].x + v[i].y) + (v[i].z + v[i].w); }
    s = wave_sum(s); const float mu = s * (1.f / 2048.f); float q = 0.f;
#pragma unroll
    for (int i = 0; i < 8; ++i) { const float a = v[i].x - mu, b = v[i].y - mu, c = v[i].z - mu, d = v[i].w - mu; q += (a * a + b * b) + (c * c + d * d); }
    q = wave_sum(q); const float rs = rsqrtf(q * (1.f / 2048.f) + LN_EPS);
#pragma unroll
    for (int i = 0; i < 8; ++i) { const float4 w = ((const float4*)lw)[lane + 64 * i], b = ((const float4*)lb)[lane + 64 * i];
      float4 y; y.x = (v[i].x - mu) * rs * w.x + b.x; y.y = (v[i].y - mu) * rs * w.y + b.y; y.z = (v[i].z - mu) * rs * w.z + b.z; y.w = (v[i].w - mu) * rs * w.w + b.w;
      r[lane + 64 * i] = y; }
  }
}

namespace att {
constexpr int D = 128, NW = 8, QBLK = 32, KVBLK = 64;
constexpr float SCALE = 0.088388347648318440f;
constexpr float THR = 8.f;
constexpr int LDQ = 2048, LDK = 512;
constexpr size_t SHM_V = KVBLK * D * 2, SHM_K = KVBLK * D * 2, SHM_ATTN = 2 * SHM_V + 2 * SHM_K + NW * 64 * 4;
#define KSWZ(row, colB) ((row) * 256 + ((colB) ^ (((row) & 7) << 4)))
#define SBAR() __builtin_amdgcn_sched_barrier(0)
__device__ __forceinline__ int crow(int r, int hi) { return (r & 3) + 8 * (r >> 2) + 4 * hi; }
__device__ __forceinline__ unsigned cvtpk(float lo, float hi) { unsigned r; asm volatile("v_cvt_pk_bf16_f32 %0, %1, %2" : "=v"(r) : "v"(lo), "v"(hi)); return r; }
__device__ __forceinline__ void partialSM(f32x16& p0, f32x16& p1, float& m_reg, float& mn, float& alpha) {
  constexpr float C = SCALE * 1.4426950408889634f;
  float pmax = p0[0]; for (int r = 1; r < 16; ++r) pmax = fmaxf(pmax, p0[r]); for (int r = 0; r < 16; ++r) pmax = fmaxf(pmax, p1[r]);
  { auto rr = __builtin_amdgcn_permlane32_swap(__float_as_uint(pmax), __float_as_uint(pmax), false, false);
    pmax = fmaxf(__uint_as_float(rr[0]), __uint_as_float(rr[1])); }
  if (__builtin_expect(__all(pmax - m_reg <= THR / SCALE), 1)) { mn = m_reg; alpha = 1.f; }
  else { mn = fmaxf(m_reg, pmax); alpha = __builtin_amdgcn_exp2f((m_reg - mn) * C); m_reg = mn; }
  float mnC = -mn * C;
  for (int r = 0; r < 16; ++r) p0[r] = fmaf(p0[r], C, mnC); for (int r = 0; r < 16; ++r) p1[r] = fmaf(p1[r], C, mnC);
  for (int r = 0; r < 16; ++r) p0[r] = __builtin_amdgcn_exp2f(p0[r]);
}
__device__ __forceinline__ void finishSM(f32x16& p0, f32x16& p1, float alpha, float& l_reg, bf16x8& pa0, bf16x8& pa1, bf16x8& pa2, bf16x8& pa3) {
  for (int r = 0; r < 16; ++r) p1[r] = __builtin_amdgcn_exp2f(p1[r]);
  float ps = 0; for (int r = 0; r < 16; ++r) ps += p0[r]; for (int r = 0; r < 16; ++r) ps += p1[r];
  { auto rr = __builtin_amdgcn_permlane32_swap(__float_as_uint(ps), __float_as_uint(ps), false, false);
    ps = __uint_as_float(rr[0]) + __uint_as_float(rr[1]); }
  l_reg = l_reg * alpha + ps;
#define PK4(P, BASE, OUT) do { unsigned a0 = cvtpk(P[BASE + 0], P[BASE + 1]), a1 = cvtpk(P[BASE + 2], P[BASE + 3]);   \
    unsigned b0 = cvtpk(P[BASE + 4], P[BASE + 5]), b1 = cvtpk(P[BASE + 6], P[BASE + 7]);                              \
    auto r0 = __builtin_amdgcn_permlane32_swap(a0, b0, false, false); auto r1 = __builtin_amdgcn_permlane32_swap(a1, b1, false, false); \
    u32x4 w = {r0[0], r1[0], r0[1], r1[1]}; OUT = *reinterpret_cast<bf16x8*>(&w); } while (0)
  PK4(p0, 0, pa0); PK4(p0, 8, pa1); PK4(p1, 0, pa2); PK4(p1, 8, pa3);
#undef PK4
}
__device__ __forceinline__ void qkt(f32x16& p0, f32x16& p1, const char* Ks, const bf16x8* qr, int r32, int hi) {
  p0 = f32x16{}; p1 = f32x16{};
  for (int d0 = 0; d0 < 8; ++d0) { int cb = (d0 * 16 + hi * 8) * 2;
    bf16x8 b0 = *reinterpret_cast<const bf16x8*>(Ks + KSWZ(r32, cb));
    bf16x8 b1 = *reinterpret_cast<const bf16x8*>(Ks + KSWZ(32 + r32, cb));
    p0 = __builtin_amdgcn_mfma_f32_32x32x16_bf16(b0, qr[d0], p0, 0, 0, 0);
    p1 = __builtin_amdgcn_mfma_f32_32x32x16_bf16(b1, qr[d0], p1, 0, 0, 0); }
}
__device__ __forceinline__ int v_st(int k, int c) { const int kk = (k & ~0xC) | ((k & 4) << 1) | ((k & 8) >> 1); return ((kk >> 3) * 4 + (c >> 5)) * 512 + ((kk & 7) * 32 + (c & 31)) * 2; }
__device__ __forceinline__ int v_rd_base(int lane) { return ((lane & 3) << 3) | (((lane >> 2) & 3) << 6) | (((lane >> 4) & 1) << 5) | (((lane >> 5) & 1) << 8); }
constexpr int v_rd_off(int d0, int ks, int half) { return d0 * 512 + ks * 4096 + half * 2048; }
template <int OFF> __device__ __forceinline__ s16x4 tr_read(int vb) {
  s16x4 r; asm volatile("ds_read_b64_tr_b16 %0, %1 offset:%2" : "=&v"(r) : "v"(vb), "i"(OFF) : "memory"); return r;
}
#define PKLH(L, H) (bf16x8){L[0], L[1], L[2], L[3], H[0], H[1], H[2], H[3]}
template <int D0> __device__ __forceinline__ void pv_one(f32x16& od, int vb, bf16x8 pa0, bf16x8 pa1, bf16x8 pa2, bf16x8 pa3) {
  const s16x4 l0 = tr_read<v_rd_off(D0, 0, 0)>(vb), h0 = tr_read<v_rd_off(D0, 0, 1)>(vb), l1 = tr_read<v_rd_off(D0, 1, 0)>(vb), h1 = tr_read<v_rd_off(D0, 1, 1)>(vb);
  const s16x4 l2 = tr_read<v_rd_off(D0, 2, 0)>(vb), h2 = tr_read<v_rd_off(D0, 2, 1)>(vb), l3 = tr_read<v_rd_off(D0, 3, 0)>(vb), h3 = tr_read<v_rd_off(D0, 3, 1)>(vb);
  asm volatile("s_waitcnt lgkmcnt(0)" ::: "memory"); SBAR();
  od = __builtin_amdgcn_mfma_f32_32x32x16_bf16(pa0, PKLH(l0, h0), od, 0, 0, 0);
  od = __builtin_amdgcn_mfma_f32_32x32x16_bf16(pa1, PKLH(l1, h1), od, 0, 0, 0);
  od = __builtin_amdgcn_mfma_f32_32x32x16_bf16(pa2, PKLH(l2, h2), od, 0, 0, 0);
  od = __builtin_amdgcn_mfma_f32_32x32x16_bf16(pa3, PKLH(l3, h3), od, 0, 0, 0);
}
__device__ __forceinline__ void pv_d0(f32x16* o, int vb, bf16x8 pa0, bf16x8 pa1, bf16x8 pa2, bf16x8 pa3) {
  pv_one<0>(o[0], vb, pa0, pa1, pa2, pa3); pv_one<1>(o[1], vb, pa0, pa1, pa2, pa3); pv_one<2>(o[2], vb, pa0, pa1, pa2, pa3); pv_one<3>(o[3], vb, pa0, pa1, pa2, pa3);
}
__device__ __forceinline__ void attn_dense_body(bf16_t* __restrict__ Qb, const bf16_t* __restrict__ Kh, const bf16_t* __restrict__ Vh, int seq, char* lds) {
  int tid_l = threadIdx.x; asm volatile("" : "+v"(tid_l)); const int tid = tid_l, wid = tid >> 6, lane = tid & 63, r32 = lane & 31, hi = lane >> 5;
  char* V_lds = lds; char* K_lds = lds + 2 * SHM_V;
  float* wsf = (float*)(lds + 2 * SHM_V + 2 * SHM_K) + wid * 64; float* li_l = wsf; float* al_l = wsf + 32;
  float m_reg = -1e30f, l_reg = 0; f32x16 o[4] = {}; bf16x8 qr[8];
  const bf16_t* Qw = Qb + (long)(wid * QBLK + r32) * LDQ + hi * 8;
#pragma unroll
  for (int d0 = 0; d0 < 8; ++d0) qr[d0] = *reinterpret_cast<const bf16x8*>(Qw + d0 * 16);
  const int sr = tid >> 4, sc = (tid & 15) * 8, vst0 = v_st(sr, sc), vst1 = v_st(32 + sr, sc);
  const int vb0 = (int)(uintptr_t)V_lds + v_rd_base(lane);
  struct { bf16x8 vs0, vs1, ks0, ks1; } sr_[1];
#define SLOAD(i, k0) do { sr_[i].vs0 = *reinterpret_cast<const bf16x8*>(&Vh[(long)((k0) + sr) * LDK + sc]); sr_[i].vs1 = *reinterpret_cast<const bf16x8*>(&Vh[(long)((k0) + 32 + sr) * LDK + sc]); \
    sr_[i].ks0 = *reinterpret_cast<const bf16x8*>(&Kh[(long)((k0) + sr) * LDK + sc]); sr_[i].ks1 = *reinterpret_cast<const bf16x8*>(&Kh[(long)((k0) + 32 + sr) * LDK + sc]); } while (0)
#define SWRITE(b, i) do { *(bf16x8*)(V_lds + (b) * SHM_V + vst0) = sr_[i].vs0;          \
    *(bf16x8*)(V_lds + (b) * SHM_V + vst1) = sr_[i].vs1; int kc = sc * 2;               \
    *(bf16x8*)(K_lds + (b) * SHM_K + KSWZ(sr, kc)) = sr_[i].ks0;                       \
    *(bf16x8*)(K_lds + (b) * SHM_K + KSWZ(32 + sr, kc)) = sr_[i].ks1; } while (0)
#define SWAIT() asm volatile("s_waitcnt vmcnt(0)" ::: "memory")
#define RESC(a) do { if (__any((a) < 1.f)) { if (hi == 0) al_l[r32] = (a); asm volatile("s_waitcnt lgkmcnt(0)" ::: "memory"); \
    for (int d = 0; d < 4; ++d) for (int r = 0; r < 16; ++r) o[d][r] *= al_l[crow(r, hi)]; } } while (0)
  f32x16 pA0, pA1, pB0, pB1; float mnA, mnB, alA, alB; bf16x8 pa0, pa1, pa2, pa3; const int NT = seq / KVBLK;
  constexpr int SE = 0, SO = 0;
  SLOAD(SE, 0); asm volatile("s_waitcnt vmcnt(0)" ::: "memory"); SWRITE(0, SE); __syncthreads();
  qkt(pA0, pA1, K_lds, qr, r32, hi); partialSM(pA0, pA1, m_reg, mnA, alA);
  SLOAD(SO, KVBLK);
  SWAIT(); SWRITE(1, SO); __syncthreads();
  for (int j = 1; j + 1 < NT; j += 2) {
    SBAR(); qkt(pB0, pB1, K_lds + SHM_K, qr, r32, hi);
    finishSM(pA0, pA1, alA, l_reg, pa0, pa1, pa2, pa3); SBAR();
    SLOAD(SO, (j + 1) * KVBLK); SBAR();
    pv_d0(o, vb0, pa0, pa1, pa2, pa3); partialSM(pB0, pB1, m_reg, mnB, alB);
    __syncthreads(); SWAIT(); SWRITE(0, SE);
    RESC(alB); __syncthreads();
    SBAR(); qkt(pA0, pA1, K_lds, qr, r32, hi);
    finishSM(pB0, pB1, alB, l_reg, pa0, pa1, pa2, pa3); SBAR();
    SLOAD(SE, (j + 2) * KVBLK); SBAR();
    pv_d0(o, vb0 + (int)SHM_V, pa0, pa1, pa2, pa3); partialSM(pA0, pA1, m_reg, mnA, alA);
    __syncthreads(); SWAIT(); SWRITE(1, SO);
    RESC(alA); __syncthreads();
  }
  SBAR(); qkt(pB0, pB1, K_lds + SHM_K, qr, r32, hi);
  finishSM(pA0, pA1, alA, l_reg, pa0, pa1, pa2, pa3); SBAR();
  pv_d0(o, vb0, pa0, pa1, pa2, pa3); partialSM(pB0, pB1, m_reg, mnB, alB);
  __syncthreads(); RESC(alB);
  finishSM(pB0, pB1, alB, l_reg, pa0, pa1, pa2, pa3); SBAR();
  pv_d0(o, vb0 + (int)SHM_V, pa0, pa1, pa2, pa3);
  if (hi == 0) li_l[r32] = l_reg; asm volatile("s_waitcnt lgkmcnt(0)" ::: "memory");
  float rli[16];
#pragma unroll
  for (int r = 0; r < 16; ++r) rli[r] = __builtin_amdgcn_rcpf(li_l[crow(r, hi)]);
  bf16_t* qo = Qb + (long)(wid * QBLK + 4 * hi) * LDQ + r32; const bf16_t* zo = qo + (long)((OFF_ZB - OFF_QB) / 2);
#pragma unroll
  for (int r = 0; r < 16; ++r) { const int ro = ((r & 3) + 8 * (r >> 2)) * LDQ;
    const float z0 = bf2f(zo[ro]), z1 = bf2f(zo[ro + 32]), z2 = bf2f(zo[ro + 64]), z3 = bf2f(zo[ro + 96]);
    const float v0 = o[0][r] * rli[r] * z0, v1 = o[1][r] * rli[r] * z1, v2 = o[2][r] * rli[r] * z2, v3 = o[3][r] * rli[r] * z3;
    qo[ro] = (bf16_t)(cvtpk(v0, v0) & 0xffffu); qo[ro + 32] = (bf16_t)(cvtpk(v1, v1) & 0xffffu); qo[ro + 64] = (bf16_t)(cvtpk(v2, v2) & 0xffffu); qo[ro + 96] = (bf16_t)(cvtpk(v3, v3) & 0xffffu);
    asm volatile("" ::: "memory"); }
#undef SLOAD
#undef SWRITE
#undef SWAIT
#undef RESC
}
}

namespace ml {
using att::crow; using att::cvtpk; using att::v_st; using att::v_rd_base; using att::v_rd_off; using att::tr_read;
constexpr int O_QS = 0, O_KS = 17408, O_C0 = 34816, O_KTR = 52224, O_VTR = 68608, O_SP = 84992, O_F = 94208;
constexpr int NCH = 132;
template <int KS> __device__ __forceinline__ bf16x8 trfrag(int vb) {
  const s16x4 l = tr_read<v_rd_off(0, KS, 0)>(vb), h = tr_read<v_rd_off(0, KS, 1)>(vb);
  asm volatile("s_waitcnt lgkmcnt(0)" ::: "memory"); SBAR();
  return PKLH(l, h);
}
__device__ __forceinline__ bf16x8 scale_frag(bf16x8 v, const float* we) {
  const u32x4 w = *reinterpret_cast<const u32x4*>(&v); float f[8]; unpack8(w, f);
  const float4 s0 = *(const float4*)we, s1 = *(const float4*)(we + 4);
  f[0] *= s0.x; f[1] *= s0.y; f[2] *= s0.z; f[3] *= s0.w; f[4] *= s1.x; f[5] *= s1.y; f[6] *= s1.z; f[7] *= s1.w;
  const u32x4 o = pack8(f); return *reinterpret_cast<const bf16x8*>(&o);
}
__device__ __forceinline__ int chunk_row0(int c, int b, bool rev) {
  if (!rev) return c < 4 ? M_TOK + b * CTXL + 64 * c : b * SEQ + 64 * (c - 4);
  return c < 4 ? M_TOK + b * CTXL + 64 * (3 - c) : b * SEQ + 64 * (131 - c);
}
__device__ __forceinline__ void gate_scan(float gi, float gf, float bi, float bfb, float& m0, float* S, int lane, int jn) {
  const float li = gi + bi, xf = gf + bfb; const float lf = fminf(xf, 0.f) - log1pf(__expf(-fabsf(xf)));
  float bb = lf;
#pragma unroll
  for (int o = 1; o < 64; o <<= 1) { const float t = __shfl_up(bb, o); if (lane >= o) bb += t; }
  const float g = li - bb; float cm = g;
#pragma unroll
  for (int o = 1; o < 64; o <<= 1) { const float t = __shfl_up(cm, o); if (lane >= o) cm = fmaxf(cm, t); }
  const float Mx = fmaxf(m0, cm), m = bb + Mx, a = __expf(m0 - Mx), em = __expf(-m);
  const float bL = __shfl(bb, 63), ML = __shfl(Mx, 63), aend = __shfl(a, 63);
  S[jn] = g; S[64 + jn] = Mx; S[128 + jn] = a; S[192 + jn] = em; S[256 + jn] = __expf(g - ML); if (lane == 0) S[320] = aend;
  m0 = bL + ML;
}
__device__ void mlstm_scan(const Params& p, char* lds, int item) {
  int tid_l = threadIdx.x; asm volatile("" : "+v"(tid_l)); const int tid = tid_l, wid = __builtin_amdgcn_readfirstlane(tid >> 6), lane = tid & 63, r32 = lane & 31, hi = lane >> 5;
  const int dir = item & 1, vs = (item >> 1) & 3, bh = item >> 3, b = bh >> 3, h = bh & 7;
  const bool rev = dir != 0, flip = !rev;
  const bf16_t* QK = (const bf16_t*)(p.ws + OFF_QAKA); const bf16_t* VA = (const bf16_t*)(p.ws + OFF_VA); const float* GT = (const float*)(p.ws + OFF_GATES);
  bf16_t* H = (bf16_t*)(p.ws + (rev ? OFF_HB : OFF_HF));
  float* F = (float*)(lds + O_F); float *NQ = F + 768, *RS = F + 832, *N0 = F + 960;
  for (int i = tid; i < 64 * 272 / 4; i += 512) ((unsigned*)(lds + O_C0))[i] = 0u;
  if (tid < 128) N0[tid] = 0.f;
  f32x16 cacc = {}; f32x16 acc1 = {}; float nreg = 0.f, m0 = -1e30f;
  const float bi = p.in[7][dir * 16 + h], bfb = p.in[7][dir * 16 + 8 + h];
  const int qrow0 = tid >> 4, qc = (tid & 15) * 8, vrow = tid >> 3, vc = (tid & 7) * 8;
  const int jnat = 63 - lane, jg = flip ? lane : jnat;
  bf16x8 q0, q1, k0, k1, v0; float gi1 = 0.f, gf1 = 0.f, gi2 = 0.f, gf2 = 0.f;
  u32x2 hw0 = {0u, 0u}, hw1 = {0u, 0u}, hw2 = {0u, 0u}, hw3 = {0u, 0u}; bf16_t* hpend = nullptr;
  { const int R0 = chunk_row0(0, b, rev); const bf16_t* qp = QK + (size_t)(R0 + qrow0) * 2048 + h * 128 + qc;
    q0 = *(const bf16x8*)qp; q1 = *(const bf16x8*)(qp + 32 * 2048); k0 = *(const bf16x8*)(qp + 1024); k1 = *(const bf16x8*)(qp + 1024 + 32 * 2048);
    v0 = *(const bf16x8*)(VA + (size_t)(R0 + vrow) * 2048 + h * 256 + vs * 64 + vc);
    if (wid == 0) { const float g0i = GT[(size_t)(R0 + jg) * 32 + dir * 16 + h], g0f = GT[(size_t)(R0 + jg) * 32 + dir * 16 + 8 + h];
      const int R1 = chunk_row0(1, b, rev); gi1 = GT[(size_t)(R1 + jg) * 32 + dir * 16 + h]; gf1 = GT[(size_t)(R1 + jg) * 32 + dir * 16 + 8 + h];
      gate_scan(g0i, g0f, bi, bfb, m0, F, lane, jnat); } }
  const int w4 = wid & 3, t_hi = w4 >> 1, t_lo = w4 & 1;
  for (int c = 0; c < NCH; ++c) {
    const int R0 = chunk_row0(c, b, rev); const bool isctx = c < 4;
    float* S = F + (c & 1) * 384; float *G = S, *MX = S + 64, *A = S + 128, *EM = S + 192, *WE = S + 256;
    __syncthreads();
    { const int ra = flip ? 63 - qrow0 : qrow0, rb = flip ? 31 - qrow0 : qrow0 + 32, rv = flip ? 63 - vrow : vrow;
    *(bf16x8*)(lds + O_QS + ra * 272 + qc * 2) = q0; *(bf16x8*)(lds + O_QS + rb * 272 + qc * 2) = q1;
    *(bf16x8*)(lds + O_KS + ra * 272 + qc * 2) = k0; *(bf16x8*)(lds + O_KS + rb * 272 + qc * 2) = k1;
    *(bf16x8*)(lds + O_KTR + v_st(ra, qc)) = k0; *(bf16x8*)(lds + O_KTR + v_st(rb, qc)) = k1;
    *(bf16x8*)(lds + O_VTR + v_st(rv, vc)) = v0; }
    if (hpend) { *(u32x2*)(hpend) = hw0; *(u32x2*)(hpend + 8) = hw1; *(u32x2*)(hpend + 16) = hw2; *(u32x2*)(hpend + 24) = hw3; hpend = nullptr; }
    if (c + 1 < NCH) { const int R1 = chunk_row0(c + 1, b, rev); const bf16_t* qp = QK + (size_t)(R1 + qrow0) * 2048 + h * 128 + qc;
      q0 = *(const bf16x8*)qp; q1 = *(const bf16x8*)(qp + 32 * 2048); k0 = *(const bf16x8*)(qp + 1024); k1 = *(const bf16x8*)(qp + 1024 + 32 * 2048);
      v0 = *(const bf16x8*)(VA + (size_t)(R1 + vrow) * 2048 + h * 256 + vs * 64 + vc); }
    if (wid == 0 && c + 2 < NCH) { const int R2 = chunk_row0(c + 2, b, rev); gi2 = GT[(size_t)(R2 + jg) * 32 + dir * 16 + h]; gf2 = GT[(size_t)(R2 + jg) * 32 + dir * 16 + 8 + h]; }
    __syncthreads();
    if (wid < 4) {
      f32x16 pS = {};
      const char* ka = lds + O_KS + (32 * t_hi + r32) * 272 + hi * 16; const char* qb = lds + O_QS + (32 * t_lo + r32) * 272 + hi * 16;
#pragma unroll
      for (int d0 = 0; d0 < 8; ++d0) pS = __builtin_amdgcn_mfma_f32_32x32x16_bf16(*(const bf16x8*)(ka + d0 * 32), *(const bf16x8*)(qb + d0 * 32), pS, 0, 0, 0);
      const int j = 32 * t_lo + r32; const float mxj = MX[j]; float ps = 0.f;
#pragma unroll
      for (int r = 0; r < 16; ++r) { const int s = 32 * t_hi + crow(r, hi); const bool ok = (s >= j);
        const float arg = ok ? (G[s] - mxj) : -1e30f; const float wv = __builtin_amdgcn_exp2f(arg * 1.4426950408889634f); pS[r] *= wv; ps += pS[r]; }
      ps += __shfl_xor(ps, 32); if (hi == 0) RS[t_hi * 64 + j] = ps;
#pragma unroll
      for (int g4 = 0; g4 < 4; ++g4) { u32x2 w; w.x = cvtpk(pS[4 * g4], pS[4 * g4 + 1]); w.y = cvtpk(pS[4 * g4 + 2], pS[4 * g4 + 3]);
        *(u32x2*)(lds + O_SP + j * 144 + (32 * t_hi + 8 * g4 + 4 * hi) * 2) = w; }
    } else {
      acc1 = f32x16{};
      const char* ca = lds + O_C0 + (32 * t_hi + r32) * 272 + hi * 16; const char* qb = lds + O_QS + (32 * t_lo + r32) * 272 + hi * 16;
#pragma unroll
      for (int d0 = 0; d0 < 8; ++d0) acc1 = __builtin_amdgcn_mfma_f32_32x32x16_bf16(*(const bf16x8*)(ca + d0 * 32), *(const bf16x8*)(qb + d0 * 32), acc1, 0, 0, 0);
      const int t4 = tid - 256, jq = t4 >> 2, part = t4 & 3; float sum = 0.f;
      const char* qrow = lds + O_QS + jq * 272 + part * 64;
#pragma unroll
      for (int i = 0; i < 4; ++i) { float f[8]; unpack8(*(const u32x4*)(qrow + 16 * i), f);
#pragma unroll
        for (int e = 0; e < 8; ++e) sum += f[e] * N0[part * 32 + 8 * i + e]; }
      sum += __shfl_xor(sum, 1); sum += __shfl_xor(sum, 2); if (part == 0) NQ[jq] = sum;
    }
    __syncthreads();
    const float aend = S[320];
    if (wid == 0 && c + 1 < NCH) { gate_scan(gi1, gf1, bi, bfb, m0, F + ((c + 1) & 1) * 384, lane, jnat); gi1 = gi2; gf1 = gf2; }
    if (wid >= 4) {
      f32x16 acc2 = {};
      const int vbv = (int)(uintptr_t)(lds + O_VTR) + v_rd_base(lane) + t_hi * 512;
      const char* sb = lds + O_SP + (32 * t_lo + r32) * 144 + hi * 16;
      const s16x4 l0 = tr_read<v_rd_off(0, 0, 0)>(vbv), h0 = tr_read<v_rd_off(0, 0, 1)>(vbv), l1 = tr_read<v_rd_off(0, 1, 0)>(vbv), h1 = tr_read<v_rd_off(0, 1, 1)>(vbv);
      const s16x4 l2 = tr_read<v_rd_off(0, 2, 0)>(vbv), h2 = tr_read<v_rd_off(0, 2, 1)>(vbv), l3 = tr_read<v_rd_off(0, 3, 0)>(vbv), h3 = tr_read<v_rd_off(0, 3, 1)>(vbv);
      const bf16x8 s0 = *(const bf16x8*)(sb), s1 = *(const bf16x8*)(sb + 32), s2 = *(const bf16x8*)(sb + 64), s3 = *(const bf16x8*)(sb + 96);
      asm volatile("s_waitcnt lgkmcnt(0)" ::: "memory"); SBAR();
      acc2 = __builtin_amdgcn_mfma_f32_32x32x16_bf16(PKLH(l0, h0), s0, acc2, 0, 0, 0);
      acc2 = __builtin_amdgcn_mfma_f32_32x32x16_bf16(PKLH(l1, h1), s1, acc2, 0, 0, 0);
      acc2 = __builtin_amdgcn_mfma_f32_32x32x16_bf16(PKLH(l2, h2), s2, acc2, 0, 0, 0);
      acc2 = __builtin_amdgcn_mfma_f32_32x32x16_bf16(PKLH(l3, h3), s3, acc2, 0, 0, 0);
      const int j = 32 * t_lo + r32; const float aj = A[j]; const float den = aj * NQ[j] + RS[j] + RS[64 + j];
      const float inv = 1.0f / fmaxf(fabsf(den), EM[j]);
      if (!isctx) { hpend = H + (size_t)(R0 + (flip ? 63 - j : j)) * 2048 + h * 256 + vs * 64 + 32 * t_hi + 4 * hi;
#define HPK(g4) (u32x2){cvtpk((aj * acc1[4 * g4] + acc2[4 * g4]) * inv, (aj * acc1[4 * g4 + 1] + acc2[4 * g4 + 1]) * inv), cvtpk((aj * acc1[4 * g4 + 2] + acc2[4 * g4 + 2]) * inv, (aj * acc1[4 * g4 + 3] + acc2[4 * g4 + 3]) * inv)}
        hw0 = HPK(0); hw1 = HPK(1); hw2 = HPK(2); hw3 = HPK(3);
#undef HPK
      }
    }
    if (wid == 2 || wid == 3) { const int d = tid - 128; float s = 0.f;
#pragma unroll 8
      for (int si = 0; si < 64; ++si) s += WE[si] * bf2f(*(const bf16_t*)(lds + O_KS + si * 272 + d * 2));
      nreg = aend * nreg + s; N0[d] = nreg; }
    { const int dt = wid & 3, vt2 = wid >> 2;
      const int kb = (int)(uintptr_t)(lds + O_KTR) + v_rd_base(lane) + dt * 512;
      const int vb2 = (int)(uintptr_t)(lds + O_VTR) + v_rd_base(lane) + vt2 * 512;
      const s16x4 kl0 = tr_read<v_rd_off(0, 0, 0)>(kb), kh0 = tr_read<v_rd_off(0, 0, 1)>(kb), kl1 = tr_read<v_rd_off(0, 1, 0)>(kb), kh1 = tr_read<v_rd_off(0, 1, 1)>(kb);
      const s16x4 kl2 = tr_read<v_rd_off(0, 2, 0)>(kb), kh2 = tr_read<v_rd_off(0, 2, 1)>(kb), kl3 = tr_read<v_rd_off(0, 3, 0)>(kb), kh3 = tr_read<v_rd_off(0, 3, 1)>(kb);
      const s16x4 vl0 = tr_read<v_rd_off(0, 0, 0)>(vb2), vh0 = tr_read<v_rd_off(0, 0, 1)>(vb2), vl1 = tr_read<v_rd_off(0, 1, 0)>(vb2), vh1 = tr_read<v_rd_off(0, 1, 1)>(vb2);
      const s16x4 vl2 = tr_read<v_rd_off(0, 2, 0)>(vb2), vh2 = tr_read<v_rd_off(0, 2, 1)>(vb2), vl3 = tr_read<v_rd_off(0, 3, 0)>(vb2), vh3 = tr_read<v_rd_off(0, 3, 1)>(vb2);
      asm volatile("s_waitcnt lgkmcnt(0)" ::: "memory"); SBAR();
#pragma unroll
      for (int r = 0; r < 16; ++r) cacc[r] *= aend;
      cacc = __builtin_amdgcn_mfma_f32_32x32x16_bf16(PKLH(kl0, kh0), scale_frag(PKLH(vl0, vh0), WE + 0 + 8 * hi), cacc, 0, 0, 0);
      cacc = __builtin_amdgcn_mfma_f32_32x32x16_bf16(PKLH(kl1, kh1), scale_frag(PKLH(vl1, vh1), WE + 16 + 8 * hi), cacc, 0, 0, 0);
      cacc = __builtin_amdgcn_mfma_f32_32x32x16_bf16(PKLH(kl2, kh2), scale_frag(PKLH(vl2, vh2), WE + 32 + 8 * hi), cacc, 0, 0, 0);
      cacc = __builtin_amdgcn_mfma_f32_32x32x16_bf16(PKLH(kl3, kh3), scale_frag(PKLH(vl3, vh3), WE + 48 + 8 * hi), cacc, 0, 0, 0);
#pragma unroll
      for (int g4 = 0; g4 < 4; ++g4) { u32x2 w; w.x = cvtpk(cacc[4 * g4], cacc[4 * g4 + 1]); w.y = cvtpk(cacc[4 * g4 + 2], cacc[4 * g4 + 3]);
        *(u32x2*)(lds + O_C0 + (32 * vt2 + r32) * 272 + (32 * dt + 8 * g4 + 4 * hi) * 2) = w; }
    }
  }
  if (hpend) { *(u32x2*)(hpend) = hw0; *(u32x2*)(hpend + 8) = hw1; *(u32x2*)(hpend + 16) = hw2; *(u32x2*)(hpend + 24) = hw3; }
  __syncthreads();
}
}

__device__ void phase4_mixers(const Params& p, char* lds) {
  for (int item = blockIdx.x; item < 256; item += gridDim.x) ml::mlstm_scan(p, lds, item);
  bf16_t* QB = (bf16_t*)(p.ws + OFF_QB);
  const bf16_t* KA = (const bf16_t*)(p.ws + OFF_KALL); const bf16_t* VAl = (const bf16_t*)(p.ws + OFF_VALL);
  for (int i = blockIdx.x; i < 2048; i += gridDim.x) {
    const int g = i >> 7, b = g >> 2, kvh = g & 3, hq = kvh * 4 + ((i >> 5) & 3), qb = i & 31;
    const size_t qoff = (size_t)(b * SEQ + qb * 256) * 2048 + hq * 128, koff = (size_t)b * SKV * 512 + kvh * 128;
    att::attn_dense_body(QB + qoff, KA + koff, VAl + koff, SKV, lds);
    __syncthreads();
  }
}

#define GRID_SYNC() do { asm volatile("s_waitcnt vmcnt(0) lgkmcnt(0)" ::: "memory"); grid.sync(); } while (0)
__global__ void __launch_bounds__(512, 2) fwd_megakernel(Params p) {
  extern __shared__ __attribute__((aligned(16))) unsigned char lds[];
  cg::grid_group grid = cg::this_grid();
  unsigned char* ws = p.ws;
  PG8_LAS unsigned char* lds3 = (PG8_LAS unsigned char*)lds;
  phase0_prep(p, lds);
  GRID_SYNC();
  phase1_ln_mod(p);
  GRID_SYNC();
  { pg8::Gemm g{(const bf16_t*)(ws + OFF_U), (const bf16_t*)(ws + OFF_WT_IN), M_ALL, N1P, 2048}; InProjOrder S; S.init((int)gridDim.x, (int)blockIdx.x);
    Epi1 E{ws, (unsigned char*)p.out}; pg8::gemm_phase<Epi1, InProjOrder>(lds3, g, S, E); }
  GRID_SYNC();
  phase3_elem(p);
  GRID_SYNC();
  phase4_mixers(p, (char*)lds);
  GRID_SYNC();
  phase5_gate(p);
  GRID_SYNC();
  { pg8::Gemm g{(const bf16_t*)(ws + OFF_OZ), (const bf16_t*)(ws + OFF_WT_BA), M_TOK, 2048, 2048}; pg8::StaticOrder S; S.init(M_TOK, 2048, (int)gridDim.x, (int)blockIdx.x);
    Epi2a E{(bf16_t*)(ws + OFF_TMP), (const bf16_t*)p.out}; pg8::gemm_phase<Epi2a, pg8::StaticOrder>(lds3, g, S, E); }
  __syncthreads();
  { pg8::Gemm g{(const bf16_t*)(ws + OFF_QB), (const bf16_t*)(ws + OFF_WT_BB), M_TOK, 2048, 2048}; pg8::StaticOrder S; S.init(M_TOK, 2048, (int)gridDim.x, (int)blockIdx.x);
    Epi2b E{(const bf16_t*)(ws + OFF_TMP), (const bf16_t*)p.out + (size_t)M_TOK * 2048, (bf16_t*)(ws + OFF_MERGED)}; pg8::gemm_phase<Epi2b, pg8::StaticOrder>(lds3, g, S, E); }
  GRID_SYNC();
  { pg8::Gemm g{(const bf16_t*)(ws + OFF_MERGED), (const bf16_t*)(ws + OFF_WT_OUT), M_TOK, 2048, 2048}; pg8::StaticOrder S; S.init(M_TOK, 2048, (int)gridDim.x, (int)blockIdx.x);
    Epi3 E{p.in[0], (const float*)(ws + OFF_MOD), p.out}; pg8::gemm_phase<Epi3, pg8::StaticOrder>(lds3, g, S, E); }
  GRID_SYNC();
  phase8_final_ln(p);
}

extern "C" void kernel_launch(void* const* d_in, const int* in_sizes, int n_in, void* d_out, int out_size, void* d_ws, size_t ws_size, hipStream_t stream) {
  static int grid_blocks = 0;
  if (!grid_blocks) {
    if (n_in != 18 || out_size != M_TOK * DM || ws_size < WS_END) { fprintf(stderr, "kernel_launch: unexpected shapes (n_in %d out %d ws %zu need %zu)\n", n_in, out_size, ws_size, (size_t)WS_END); grid_blocks = -1; return; }
    int dev = 0, cus = 0, per_cu = 0;
    (void)hipGetDevice(&dev);
    (void)hipDeviceGetAttribute(&cus, hipDeviceAttributeMultiprocessorCount, dev);
    (void)hipFuncSetAttribute((const void*)fwd_megakernel, hipFuncAttributeMaxDynamicSharedMemorySize, LDS_BYTES);
    (void)hipOccupancyMaxActiveBlocksPerMultiprocessor(&per_cu, fwd_megakernel, 512, LDS_BYTES);
    if (per_cu < 1) per_cu = 1;
    grid_blocks = cus * per_cu;
  }
  if (grid_blocks < 0) return;
  Params p{};
  for (int i = 0; i < 18; ++i) p.in[i] = (const float*)d_in[i];
  p.out = (float*)d_out; p.ws = (unsigned char*)d_ws;
  void* args[] = {&p};
  hipError_t e = hipLaunchCooperativeKernel((void*)fwd_megakernel, dim3(grid_blocks), dim3(512), args, LDS_BYTES, stream);
  if (e != hipSuccess) fprintf(stderr, "cooperative launch failed: %s (grid %d)\n", hipGetErrorString(e), grid_blocks);
}
```

```cpp
#include <hip/hip_runtime.h>
#include <hip/hip_cooperative_groups.h>
#include <cstdio>
#include <cstdint>
namespace cg = cooperative_groups;

constexpr int DM = 2048, NB = 4, SEQ = 8192, CTXL = 256;
constexpr int M_TOK = NB * SEQ, M_CTX = NB * CTXL, M_ALL = M_TOK + M_CTX;
constexpr int SKV = CTXL + SEQ;
constexpr int N_IN = 17440, N1P = 17664;
constexpr float LN_EPS = 1e-6f;
constexpr float ALPHA_DN = 1.189207115002721f;
constexpr int LDS_BYTES = 132 * 1024;

constexpr size_t SZ_W2 = (size_t)2048 * 2048 * 2;
constexpr size_t SZ_ALL = (size_t)M_ALL * 2048 * 2;
constexpr size_t SZ_TOK = (size_t)M_TOK * 2048 * 2;
constexpr size_t SZ_KV = (size_t)NB * SKV * 512 * 2;
constexpr size_t OFF_WT_BA = 0, OFF_WT_BB = SZ_W2, OFF_WT_OUT = 2 * SZ_W2;
constexpr size_t OFF_MOD = 3 * SZ_W2;
constexpr size_t OFF_ROPE = OFF_MOD + 131072;
constexpr size_t OFF_U = OFF_ROPE + 32768;
constexpr size_t OFF_QAKA = OFF_U;
constexpr size_t OFF_QKPRE = OFF_U + SZ_ALL;
constexpr size_t OFF_HF = OFF_QKPRE, OFF_MERGED = OFF_QKPRE;
constexpr size_t OFF_OZ = OFF_QKPRE + SZ_ALL;
constexpr size_t OFF_QB = OFF_OZ + SZ_TOK;
constexpr size_t OFF_ZB = OFF_QB + SZ_TOK;
constexpr size_t OFF_TMP = OFF_ZB;
constexpr size_t OFF_VA = OFF_ZB + SZ_TOK;
constexpr size_t OFF_VALL = OFF_VA + SZ_ALL;
constexpr size_t OFF_KALL = OFF_VALL + SZ_KV;
constexpr size_t OFF_GATES = OFF_KALL + SZ_KV;
constexpr size_t OFF_KBRAW = OFF_GATES + (size_t)M_ALL * 32 * 4;
constexpr size_t OFF_HB = OFF_KBRAW;
constexpr size_t OFF_WT_IN = OFF_KBRAW + SZ_KV;
constexpr size_t WS_END = OFF_HB + SZ_TOK;
static_assert(OFF_WT_IN + (size_t)N1P * 2048 * 2 <= WS_END, "ws map");
static_assert(OFF_TMP + (size_t)M_TOK * 2048 * 4 <= OFF_VALL, "tmp map");
static_assert(OFF_U % 256 == 0 && OFF_GATES % 256 == 0 && OFF_KBRAW % 256 == 0, "align");

typedef unsigned short bf16_t;
using f32x16 = __attribute__((ext_vector_type(16))) float;
using s16x4 = __attribute__((ext_vector_type(4))) short;
using u32x2 = __attribute__((ext_vector_type(2))) unsigned;

struct Params { const float* in[18]; float* out; unsigned char* ws; };

__device__ __forceinline__ float wave_sum(float v) {
#pragma unroll
  for (int o = 32; o >= 1; o >>= 1) v += __shfl_xor(v, o);
  return v;
}
__device__ __forceinline__ float bf2f(unsigned short b) { return __uint_as_float(((unsigned)b) << 16); }
__device__ __forceinline__ float bflo(unsigned w) { return __uint_as_float(w << 16); }
__device__ __forceinline__ float bfhi(unsigned w) { return __uint_as_float(w & 0xffff0000u); }
__device__ __forceinline__ float sigmoidf_(float x) { return __builtin_amdgcn_rcpf(1.0f + __expf(-x)); }
__device__ __forceinline__ float siluf_(float x) { return x * __builtin_amdgcn_rcpf(1.0f + __expf(-x)); }
namespace pg8 {
#define PG8_LAS __attribute__((address_space(3)))
typedef unsigned short bf16_t;
typedef short bf16x8 __attribute__((ext_vector_type(8)));
typedef float f32x4 __attribute__((ext_vector_type(4)));
typedef unsigned u32x4 __attribute__((ext_vector_type(4)));
constexpr int BM = 256, BK = 64, HALF = 128, HTB = HALF * BK * 2  , STAGE_BYTES = 8 * HTB, NXCD = 8, WGM = 8;

__host__ __device__ __forceinline__ int lds_byte(int r, int c) { const int st = (r >> 4) * 2 + (c >> 5), rr = r & 15, cc = c & 31, ob = rr * 64 + cc * 2; return st * 1024 + (ob ^ (((ob >> 9) & 1) << 5)); }
__host__ __device__ __forceinline__ void stage_rc(int b, int& R, int& C) { const int st = b / 1024, sb = b % 1024, swz = sb ^ (((sb >> 9) & 1) << 5); R = (st >> 1) * 16 + swz / 64; C = (st & 1) * 32 + (swz % 64) / 2; }
__host__ __device__ __forceinline__ int perm32(int rho) { const int n = rho >> 4, i = rho & 15; return 8 * (i >> 2) + 4 * n + (i & 3); }

struct Unit { int pm, pn; };
struct Gemm { const bf16_t* A; const bf16_t* Bt; int M, N, K; };

struct StaticOrder {
    int nM, nN, nwg, G, c;
    __host__ __device__ void init(int M, int N, int G_, int c_) { nM = M / BM; nN = N / BM; nwg = nM * nN; G = G_; c = c_; }
    __host__ __device__ bool next(int i, Unit& u) const {
        const long L = (long)i * G + c; if (L >= nwg) return false;
        int wgid = (int)L; { const int q = nwg / NXCD, r = nwg % NXCD, xcd = wgid % NXCD, off = wgid / NXCD; wgid = (xcd < r ? xcd * (q + 1) : r * (q + 1) + (xcd - r) * q) + off; }
        const int nig = WGM * nN, gid = wgid / nig, fm = gid * WGM, gsz = (nM - fm) < WGM ? (nM - fm) : WGM;
        u.pm = fm + ((wgid % nig) % gsz); u.pn = (wgid % nig) / gsz; return true;
    }
    __device__ __forceinline__ void a_ready(const Unit&) const {}
    __device__ __forceinline__ void done(const Unit&) const {}
};
__device__ __forceinline__ unsigned cvt_pk_bf16(float lo, float hi) { unsigned r; asm volatile("v_cvt_pk_bf16_f32 %0, %1, %2" : "=v"(r) : "v"(lo), "v"(hi)); return r; }
template <class Epi, class Sched>
__device__ __forceinline__ void gemm_phase(PG8_LAS unsigned char* lds, const Gemm g, const Sched& S, const Epi& E) {
    int tid_l = threadIdx.x; asm volatile("" : "+v"(tid_l)); const int tid = tid_l, wid = __builtin_amdgcn_readfirstlane(tid >> 6), lane = tid & 63, wr = wid >> 2, wc = wid & 3, fr = lane & 15, fq = lane >> 4;
    const int K = g.K, nt = K / BK;
    unsigned voffA[2], voffB[2];
#pragma unroll
    for (int i = 0; i < 2; ++i) { int R, C; stage_rc(tid * 16 + i * 8192, R, C); const int Rb = Epi::PERM ? ((R & ~31) + perm32(R & 31)) : R;
        voffA[i] = (unsigned)(R * K + C) * 2u; voffB[i] = (unsigned)(Rb * K + C) * 2u; }
    const size_t kstep = (size_t)(BK * 2);
    const size_t hstep = (size_t)HALF * K * 2;
    const size_t tstep = 2 * hstep;
    const unsigned ldsw = (unsigned)wid * 1024u;
    const int aoff = lds_byte(wr * 64 + fr, fq * 8), boff = lds_byte(wc * 32 + fr, fq * 8);
#define PG8_SA(b, h) (((b) * 2 + (h)) * HTB)
#define PG8_SB(b, h) ((4 + (b) * 2 + (h)) * HTB)
#define PG8_STAGE(bufoff, gbase, voff) do { _Pragma("unroll") for (int _i = 0; _i < 2; ++_i) \
        __builtin_amdgcn_global_load_lds((const unsigned*)((const char*)(gbase) + (voff)[_i]), (PG8_LAS unsigned*)(lds + (bufoff) + ldsw + _i * 8192), 16, 0, 0); } while (0)
#define PG8_LDA(dst, b, h) do { _Pragma("unroll") for (int m = 0; m < 4; ++m) _Pragma("unroll") for (int k = 0; k < 2; ++k) dst[m][k] = *(const PG8_LAS bf16x8*)(lds + PG8_SA(b, h) + aoff + m * 2048 + k * 1024); } while (0)
#define PG8_LDB(dst, b, h) do { _Pragma("unroll") for (int n = 0; n < 2; ++n) _Pragma("unroll") for (int k = 0; k < 2; ++k) dst[n][k] = *(const PG8_LAS bf16x8*)(lds + PG8_SB(b, h) + boff + n * 2048 + k * 1024); } while (0)
#define PG8_MMA(ai, bj, At, Bt) do { __builtin_amdgcn_s_setprio(1); _Pragma("unroll") for (int m = 0; m < 4; ++m) _Pragma("unroll") for (int n = 0; n < 2; ++n) _Pragma("unroll") for (int k = 0; k < 2; ++k) \
        acc[ai][bj][m][n] = __builtin_amdgcn_mfma_f32_16x16x32_bf16(Bt[n][k], At[m][k], acc[ai][bj][m][n], 0, 0, 0); __builtin_amdgcn_s_setprio(0); } while (0)
#define PG8_WAIT_V(n) asm volatile("s_waitcnt vmcnt(" #n ")" ::: "memory")
#define PG8_WAIT_L(n) asm volatile("s_waitcnt lgkmcnt(" #n ")" ::: "memory")
#define PG8_BAR __builtin_amdgcn_s_barrier()
#define PG8_SCHED __builtin_amdgcn_sched_barrier(0)
    Unit cur, nxt; int ui = 0;
    if (!S.next(0, cur)) return;
    f32x4 acc[2][2][4][2];
#pragma unroll
    for (int a = 0; a < 2; ++a)
#pragma unroll
        for (int b = 0; b < 2; ++b)
#pragma unroll
            for (int m = 0; m < 4; ++m)
#pragma unroll
                for (int n = 0; n < 2; ++n) acc[a][b][m][n] = (f32x4){0.f, 0.f, 0.f, 0.f};
    bf16x8 At[4][2], B0[2][2], B1[2][2];
    const char* cA = (const char*)g.A + (size_t)cur.pm * tstep; const char* cB = (const char*)g.Bt + (size_t)cur.pn * tstep;
    S.a_ready(cur);
    PG8_STAGE(PG8_SB(0, 0), cB, voffB); PG8_STAGE(PG8_SA(0, 0), cA, voffA); PG8_STAGE(PG8_SB(0, 1), cB + hstep, voffB); PG8_STAGE(PG8_SA(0, 1), cA + hstep, voffA);
    if (wr == 1) PG8_BAR;
    PG8_WAIT_V(4); PG8_BAR;
    PG8_STAGE(PG8_SB(1, 0), cB + kstep, voffB); PG8_STAGE(PG8_SA(1, 0), cA + kstep, voffA); PG8_STAGE(PG8_SB(1, 1), cB + hstep + kstep, voffB);
    PG8_WAIT_V(6); PG8_BAR;
    for (;;) {
        const bool has_next = S.next(ui + 1, nxt);
        const char* nA = has_next ? (const char*)g.A + (size_t)nxt.pm * tstep : cA; const char* nB = has_next ? (const char*)g.Bt + (size_t)nxt.pn * tstep : cB;
        for (int t = 0; t < nt; t += 2) {
            const bool last = (t == nt - 2);
            const char* a1 = cA + (size_t)(t + 1) * kstep;
            const char* a2 = last ? nA : cA + (size_t)(t + 2) * kstep; const char* b2 = last ? nB : cB + (size_t)(t + 2) * kstep;
            const char* a3 = a2 + kstep; const char* b3 = b2 + kstep;
            if (last && has_next) S.a_ready(nxt);
            PG8_LDB(B0, 0, 0); PG8_SCHED; PG8_LDA(At, 0, 0); PG8_STAGE(PG8_SA(1, 1), a1 + hstep, voffA);
            PG8_WAIT_L(8); PG8_BAR; PG8_WAIT_L(0); PG8_MMA(0, 0, At, B0); PG8_BAR; PG8_SCHED;
            PG8_LDB(B1, 0, 1); PG8_STAGE(PG8_SB(0, 0), b2, voffB);
            PG8_BAR; PG8_WAIT_L(0); PG8_MMA(0, 1, At, B1); PG8_BAR;
            PG8_LDA(At, 0, 1); PG8_STAGE(PG8_SA(0, 0), a2, voffA);
            PG8_BAR; PG8_WAIT_L(0); PG8_MMA(1, 0, At, B0); PG8_BAR; PG8_SCHED;
            PG8_STAGE(PG8_SB(0, 1), b2 + hstep, voffB);
            PG8_WAIT_V(6); PG8_BAR; PG8_MMA(1, 1, At, B1); PG8_BAR;
            PG8_LDB(B0, 1, 0); PG8_SCHED; PG8_LDA(At, 1, 0); PG8_STAGE(PG8_SA(0, 1), a2 + hstep, voffA);
            PG8_WAIT_L(8); PG8_BAR; PG8_WAIT_L(0); PG8_MMA(0, 0, At, B0); PG8_BAR; PG8_SCHED;
            PG8_LDB(B1, 1, 1); PG8_STAGE(PG8_SB(1, 0), b3, voffB);
            PG8_BAR; PG8_WAIT_L(0); PG8_MMA(0, 1, At, B1); PG8_BAR;
            PG8_LDA(At, 1, 1); PG8_STAGE(PG8_SA(1, 0), a3, voffA);
            PG8_BAR; PG8_WAIT_L(0); PG8_MMA(1, 0, At, B0); PG8_BAR; PG8_SCHED;
            PG8_STAGE(PG8_SB(1, 1), b3 + hstep, voffB);
            PG8_WAIT_V(6); PG8_BAR; PG8_MMA(1, 1, At, B1); PG8_BAR;
        }
        if constexpr (!Epi::AFTER_DRAIN) { E(acc, cur, wr, wc, fr, fq); S.done(cur); }
        if (!has_next) break;
#pragma unroll
        for (int a = 0; a < 2; ++a)
#pragma unroll
            for (int b = 0; b < 2; ++b)
#pragma unroll
                for (int m = 0; m < 4; ++m)
#pragma unroll
                    for (int n = 0; n < 2; ++n) acc[a][b][m][n] = (f32x4){0.f, 0.f, 0.f, 0.f};
        cur = nxt; cA = nA; cB = nB; ++ui;
    }
    PG8_WAIT_V(0);
    if (wr == 0) PG8_BAR;
    PG8_BAR;
    if constexpr (Epi::AFTER_DRAIN) { E.fused(acc, cur, wr, wc, fr, fq, lds, wid, lane); S.done(cur); }
#undef PG8_SA
#undef PG8_SB
#undef PG8_STAGE
#undef PG8_LDA
#undef PG8_LDB
#undef PG8_MMA
#undef PG8_WAIT_V
#undef PG8_WAIT_L
#undef PG8_BAR
#undef PG8_SCHED
}
}


using pg8::f32x4; using pg8::u32x4; using pg8::bf16x8; using pg8::cvt_pk_bf16;

struct Epi1 {
  static constexpr bool PERM = true, AFTER_DRAIN = false;
  unsigned char* ws; unsigned char* dout;
  __device__ __forceinline__ void operator()(const f32x4 (&acc)[2][2][4][2], const pg8::Unit& u, int wr, int wc, int fr, int fq) const {
    const int pn = u.pn, pm = u.pm; const bool lat = pm < 128;
    const int rl = wr * 64 + fr, cl = wc * 32 + 8 * fq;
    if (pn == 20) {
      if (wc == 0) { float* G = (float*)(ws + OFF_GATES);
#pragma unroll
        for (int ai = 0; ai < 2; ++ai)
#pragma unroll
          for (int m = 0; m < 4; ++m) { float* rp = G + (size_t)(pm * 256 + ai * 128 + rl + m * 16) * 32 + 8 * fq;
            *(f32x4*)rp = acc[ai][0][m][0]; *(f32x4*)(rp + 4) = acc[ai][0][m][1]; } }
      return;
    }
    if (pn >= 21 && pn < 37) {
      if (!lat) return;
      bf16_t* O = (bf16_t*)(ws + OFF_OZ) + (pn - 21) * 128 + cl;
#pragma unroll
      for (int ai = 0; ai < 2; ++ai)
#pragma unroll
        for (int m = 0; m < 4; ++m) { const size_t row = (size_t)pm * 256 + ai * 128 + rl + m * 16;
          float r[8];
#pragma unroll
          for (int n = 0; n < 2; ++n)
#pragma unroll
            for (int e = 0; e < 4; ++e) r[n * 4 + e] = sigmoidf_(acc[ai][0][m][n][e]) * siluf_(acc[ai][1][m][n][e]);
          u32x4 w; w.x = cvt_pk_bf16(r[0], r[1]); w.y = cvt_pk_bf16(r[2], r[3]); w.z = cvt_pk_bf16(r[4], r[5]); w.w = cvt_pk_bf16(r[6], r[7]);
          *(u32x4*)(O + row * 2048) = w; }
      return;
    }
    bf16_t* O; int ld = 2048, act = 0; size_t rowbase = (size_t)pm * 256;
    if (pn < 8) { O = (bf16_t*)(ws + OFF_QKPRE) + pn * 256; }
    else if (pn < 16) { O = (bf16_t*)(ws + OFF_VA) + (pn - 8) * 256; }
    else if (pn < 18) { O = (bf16_t*)(ws + OFF_KBRAW) + (pn - 16) * 256; ld = 512; }
    else if (pn < 20) { O = (bf16_t*)(ws + OFF_VALL) + (pn - 18) * 256; ld = 512;
      rowbase = lat ? (size_t)(pm >> 5) * SKV + CTXL + (size_t)(pm & 31) * 256 : (size_t)(pm - 128) * SKV; }
    else { if (!lat) return;
      if (pn < 45) { O = (bf16_t*)(ws + OFF_QB) + (pn - 37) * 256; }
      else if (pn < 53) { O = (bf16_t*)(ws + OFF_ZB) + (pn - 45) * 256; act = 1; }
      else if (pn < 61) { O = (bf16_t*)dout + (pn - 53) * 256; act = 2; }
      else { O = (bf16_t*)dout + (size_t)M_TOK * 2048 + (pn - 61) * 256; act = 2; } }
#pragma unroll
    for (int ai = 0; ai < 2; ++ai)
#pragma unroll
      for (int m = 0; m < 4; ++m) { bf16_t* rowp = O + (rowbase + ai * 128 + rl + m * 16) * ld + cl;
#pragma unroll
        for (int bj = 0; bj < 2; ++bj) { f32x4 v0 = acc[ai][bj][m][0], v1 = acc[ai][bj][m][1];
          if (act == 1) {
#pragma unroll
            for (int e = 0; e < 4; ++e) { v0[e] = siluf_(v0[e]); v1[e] = siluf_(v1[e]); } }
          else if (act == 2) {
#pragma unroll
            for (int e = 0; e < 4; ++e) { v0[e] = sigmoidf_(v0[e]); v1[e] = sigmoidf_(v1[e]); } }
          u32x4 w; w.x = cvt_pk_bf16(v0[0], v0[1]); w.y = cvt_pk_bf16(v0[2], v0[3]); w.z = cvt_pk_bf16(v1[0], v1[1]); w.w = cvt_pk_bf16(v1[2], v1[3]);
          *(u32x4*)(rowp + bj * 128) = w; } }
  }
};
struct Epi2a {
  static constexpr bool PERM = true, AFTER_DRAIN = false;
  bf16_t* tmp; const bf16_t* sg;
  __device__ __forceinline__ void operator()(const f32x4 (&acc)[2][2][4][2], const pg8::Unit& u, int wr, int wc, int fr, int fq) const {
    const int col0 = u.pn * 256 + wc * 32 + 8 * fq;
#pragma unroll
    for (int ai = 0; ai < 2; ++ai)
#pragma unroll
      for (int m = 0; m < 4; ++m) { const size_t off = (size_t)(u.pm * 256 + ai * 128 + wr * 64 + fr + m * 16) * 2048 + col0;
#pragma unroll
        for (int bj = 0; bj < 2; ++bj) { const u32x4 s = *(const u32x4*)(sg + off + bj * 128);
          f32x4 a = acc[ai][bj][m][0], b = acc[ai][bj][m][1];
          a[0] *= bflo(s.x); a[1] *= bfhi(s.x); a[2] *= bflo(s.y); a[3] *= bfhi(s.y);
          b[0] *= bflo(s.z); b[1] *= bfhi(s.z); b[2] *= bflo(s.w); b[3] *= bfhi(s.w);
          u32x4 w; w.x = cvt_pk_bf16(a[0], a[1]); w.y = cvt_pk_bf16(a[2], a[3]); w.z = cvt_pk_bf16(b[0], b[1]); w.w = cvt_pk_bf16(b[2], b[3]);
          *(u32x4*)(tmp + off + bj * 128) = w; } }
  }
};
struct Epi2b {
  static constexpr bool PERM = true, AFTER_DRAIN = false;
  const bf16_t* tmp; const bf16_t* sg; bf16_t* merged;
  __device__ __forceinline__ void operator()(const f32x4 (&acc)[2][2][4][2], const pg8::Unit& u, int wr, int wc, int fr, int fq) const {
    const int col0 = u.pn * 256 + wc * 32 + 8 * fq;
#pragma unroll
    for (int ai = 0; ai < 2; ++ai)
#pragma unroll
      for (int m = 0; m < 4; ++m) { const size_t off = (size_t)(u.pm * 256 + ai * 128 + wr * 64 + fr + m * 16) * 2048 + col0;
#pragma unroll
        for (int bj = 0; bj < 2; ++bj) { const u32x4 s = *(const u32x4*)(sg + off + bj * 128);
          const u32x4 tw = *(const u32x4*)(tmp + off + bj * 128); const f32x4 t0 = {bflo(tw.x), bfhi(tw.x), bflo(tw.y), bfhi(tw.y)}, t1 = {bflo(tw.z), bfhi(tw.z), bflo(tw.w), bfhi(tw.w)};
          f32x4 a = acc[ai][bj][m][0], b = acc[ai][bj][m][1];
          a[0] = t0[0] + a[0] * bflo(s.x); a[1] = t0[1] + a[1] * bfhi(s.x); a[2] = t0[2] + a[2] * bflo(s.y); a[3] = t0[3] + a[3] * bfhi(s.y);
          b[0] = t1[0] + b[0] * bflo(s.z); b[1] = t1[1] + b[1] * bfhi(s.z); b[2] = t1[2] + b[2] * bflo(s.w); b[3] = t1[3] + b[3] * bfhi(s.w);
          u32x4 w; w.x = cvt_pk_bf16(a[0], a[1]); w.y = cvt_pk_bf16(a[2], a[3]); w.z = cvt_pk_bf16(b[0], b[1]); w.w = cvt_pk_bf16(b[2], b[3]);
          *(u32x4*)(merged + off + bj * 128) = w; } }
  }
};
struct Epi3 {
  static constexpr bool PERM = false, AFTER_DRAIN = false;
  const float* x; const float* mod; float* y;
  __device__ __forceinline__ void operator()(const f32x4 (&acc)[2][2][4][2], const pg8::Unit& u, int wr, int wc, int fr, int fq) const {
    const int col0 = u.pn * 256 + wc * 32 + 4 * fq;
    const float* gate = mod + (size_t)(u.pm >> 5) * 6144 + 4096 + col0;
    f32x4 gv[2][2];
#pragma unroll
    for (int bj = 0; bj < 2; ++bj)
#pragma unroll
      for (int n = 0; n < 2; ++n) gv[bj][n] = *(const f32x4*)(gate + bj * 128 + n * 16);
#pragma unroll
    for (int ai = 0; ai < 2; ++ai)
#pragma unroll
      for (int m = 0; m < 4; ++m) { const size_t off = (size_t)(u.pm * 256 + ai * 128 + wr * 64 + fr + m * 16) * 2048 + col0;
#pragma unroll
        for (int bj = 0; bj < 2; ++bj)
#pragma unroll
          for (int n = 0; n < 2; ++n) { const f32x4 xv = *(const f32x4*)(x + off + bj * 128 + n * 16);
            *(f32x4*)(y + off + bj * 128 + n * 16) = xv * ALPHA_DN + gv[bj][n] * acc[ai][bj][m][n]; } }
  }
};

struct InProjOrder {
  pg8::StaticOrder base; int G, c;
  __device__ void init(int G_, int c_) { base.init(M_TOK, N1P, G_, c_); G = G_; c = c_; }
  __device__ bool next(int i, pg8::Unit& u) const {
    const long L = (long)i * G + c; if (L < base.nwg) return base.next(i, u);
    const int r = (int)(L - base.nwg); if (r >= 4 * 21) return false;
    u.pm = 128 + (r & 3); u.pn = r >> 2; return true; }
  __device__ __forceinline__ void a_ready(const pg8::Unit&) const {}
  __device__ __forceinline__ void done(const pg8::Unit&) const {}
};

__device__ __forceinline__ int orig_col(int n) {
  if (n < 4096) return n;
  if (n < 4608) return 4128 + (n - 4096);
  if (n < 5120) return 4640 + (n - 4608);
  if (n < 5152) return 4096 + (n - 5120);
  if (n < 5376) return -1;
  if (n < 9472) { const int t = n - 5376, j = t >> 8, r = t & 255; return r < 128 ? 5152 + 128 * j + r : 7200 + 128 * j + (r - 128); }
  if (n < 11520) return 9248 + (n - 9472);
  if (n < 13568) return 11296 + (n - 11520);
  return 13344 + (n - 13568);
}
__device__ void phase0_prep(const Params& p, unsigned char* lds) {
  int tid_l = threadIdx.x; asm volatile("" : "+v"(tid_l)); const int tid = tid_l, wid = tid >> 6, lane = tid & 63;
  unsigned char* ws = p.ws;
  for (int idx = blockIdx.x * 512 + tid; idx < 4096; idx += gridDim.x * 512) {
    const int pos = idx >> 5, i = idx & 31; const float inv = powf(10000.0f, -(float)(2 * i) / 64.0f); const float ang = (float)pos * inv;
    float2 cs; cs.x = cosf(ang); cs.y = sinf(ang); ((float2*)(ws + OFF_ROPE))[idx] = cs; }
  float* sl = (float*)lds; float* red = sl + 5 * 2048; bool did = false;
  for (int it = blockIdx.x; it < 192; it += gridDim.x) {
    if (!did) { for (int i = tid; i < 5 * 2048; i += 512) { const int r = i >> 11, k = i & 2047; const float c = (r < 4) ? p.in[1][r * 2048 + k] : p.in[3][k]; sl[i] = c / (1.0f + expf(-c)); }
      __syncthreads(); did = true; }
    const int col = lane & 31, kh = lane >> 5, n = it * 32 + col;
    float a0 = 0.f, a1 = 0.f, a2 = 0.f, a3 = 0.f, a4 = 0.f;
    const float* wp = p.in[4] + (size_t)(wid * 256 + kh) * 6144 + n;
#pragma unroll 8
    for (int i = 0; i < 128; ++i) { const int k = wid * 256 + 2 * i + kh; const float w = wp[(size_t)(2 * i) * 6144];
      a0 += sl[k] * w; a1 += sl[2048 + k] * w; a2 += sl[4096 + k] * w; a3 += sl[6144 + k] * w; a4 += sl[8192 + k] * w; }
    a0 += __shfl_xor(a0, 32); a1 += __shfl_xor(a1, 32); a2 += __shfl_xor(a2, 32); a3 += __shfl_xor(a3, 32); a4 += __shfl_xor(a4, 32);
    if (kh == 0) { red[(wid * 5 + 0) * 32 + col] = a0; red[(wid * 5 + 1) * 32 + col] = a1; red[(wid * 5 + 2) * 32 + col] = a2; red[(wid * 5 + 3) * 32 + col] = a3; red[(wid * 5 + 4) * 32 + col] = a4; }
    __syncthreads();
    if (tid < 160) { const int r = tid >> 5, c = tid & 31; float s = 0.f;
#pragma unroll
      for (int w = 0; w < 8; ++w) s += red[(w * 5 + r) * 32 + c];
      ((float*)(ws + OFF_MOD))[r * 6144 + it * 32 + c] = s + p.in[5][it * 32 + c]; }
    __syncthreads();
  }
  __syncthreads();
  float* tile = (float*)lds;
  constexpr int NT_IN = (N1P / 64) * 32, NT = NT_IN + 3 * 1024;
  for (int t = blockIdx.x; t < NT; t += gridDim.x) {
    const float* src; bf16_t* dst; int ldsrc, n0, k0; bool perm;
    if (t < NT_IN) { src = p.in[6]; dst = (bf16_t*)(ws + OFF_WT_IN); ldsrc = N_IN; n0 = (t >> 5) * 64; k0 = (t & 31) * 64; perm = true; }
    else { int q = t - NT_IN; const int w = q >> 10; q &= 1023; src = p.in[13 + w]; dst = (bf16_t*)(ws + OFF_WT_BA + (size_t)w * SZ_W2); ldsrc = 2048; n0 = (q >> 5) * 64; k0 = (q & 31) * 64; perm = false; }
#pragma unroll
    for (int i = 0; i < 2; ++i) { const int kk = (tid >> 4) + 32 * i, nq = (tid & 15) * 4; const int oc = perm ? orig_col(n0 + nq) : n0 + nq;
      float4 v = make_float4(0.f, 0.f, 0.f, 0.f); if (oc >= 0) v = *(const float4*)(src + (size_t)(k0 + kk) * ldsrc + oc);
      float* tp = tile + kk * 65 + nq; tp[0] = v.x; tp[1] = v.y; tp[2] = v.z; tp[3] = v.w; }
    __syncthreads();
    { const int nn = tid >> 3, kq = (tid & 7) * 8; float r[8];
#pragma unroll
      for (int e = 0; e < 8; ++e) r[e] = tile[(kq + e) * 65 + nn];
      u32x4 w; w.x = cvt_pk_bf16(r[0], r[1]); w.y = cvt_pk_bf16(r[2], r[3]); w.z = cvt_pk_bf16(r[4], r[5]); w.w = cvt_pk_bf16(r[6], r[7]);
      *(u32x4*)(dst + (size_t)(n0 + nn) * 2048 + k0 + kq) = w; }
    __syncthreads();
  }
}

__device__ void phase1_ln_mod(const Params& p) {
  int tid_l = threadIdx.x; asm volatile("" : "+v"(tid_l)); const int tid = tid_l, wid = tid >> 6, lane = tid & 63;
  const float* MOD = (const float*)(p.ws + OFF_MOD); bf16_t* U = (bf16_t*)(p.ws + OFF_U);
  for (int row = blockIdx.x * 8 + wid; row < M_ALL; row += gridDim.x * 8) {
    const float* src = row < M_TOK ? p.in[0] + (size_t)row * 2048 : p.in[2] + (size_t)(row - M_TOK) * 2048;
    const float* md = MOD + (size_t)(row < M_TOK ? (row >> 13) : 4) * 6144;
    float4 v[4][2]; float s = 0.f;
#pragma unroll
    for (int g = 0; g < 4; ++g) { const float4* q = (const float4*)(src + g * 512 + lane * 8); v[g][0] = q[0]; v[g][1] = q[1];
      s += (v[g][0].x + v[g][0].y) + (v[g][0].z + v[g][0].w) + (v[g][1].x + v[g][1].y) + (v[g][1].z + v[g][1].w); }
    s = wave_sum(s); const float mu = s * (1.0f / 2048.0f); float q2 = 0.f;
#pragma unroll
    for (int g = 0; g < 4; ++g)
#pragma unroll
      for (int h = 0; h < 2; ++h) { const float a = v[g][h].x - mu, b = v[g][h].y - mu, c = v[g][h].z - mu, d = v[g][h].w - mu; q2 += (a * a + b * b) + (c * c + d * d); }
    q2 = wave_sum(q2); const float rs = rsqrtf(q2 * (1.0f / 2048.0f) + LN_EPS);
#pragma unroll
    for (int g = 0; g < 4; ++g) { const int c0 = g * 512 + lane * 8; float r[8];
#pragma unroll
      for (int h = 0; h < 2; ++h) { const float4 sh = *(const float4*)(md + c0 + 4 * h), sc = *(const float4*)(md + 2048 + c0 + 4 * h);
        r[4 * h + 0] = (v[g][h].x - mu) * rs * (1.0f + sc.x) + sh.x; r[4 * h + 1] = (v[g][h].y - mu) * rs * (1.0f + sc.y) + sh.y;
        r[4 * h + 2] = (v[g][h].z - mu) * rs * (1.0f + sc.z) + sh.z; r[4 * h + 3] = (v[g][h].w - mu) * rs * (1.0f + sc.w) + sh.w; }
      u32x4 w; w.x = cvt_pk_bf16(r[0], r[1]); w.y = cvt_pk_bf16(r[2], r[3]); w.z = cvt_pk_bf16(r[4], r[5]); w.w = cvt_pk_bf16(r[6], r[7]);
      *(u32x4*)(U + (size_t)row * 2048 + c0) = w; }
  }
}

__device__ __forceinline__ void unpack8(const u32x4 w, float* f) { f[0] = bflo(w.x); f[1] = bfhi(w.x); f[2] = bflo(w.y); f[3] = bfhi(w.y); f[4] = bflo(w.z); f[5] = bfhi(w.z); f[6] = bflo(w.w); f[7] = bfhi(w.w); }
__device__ __forceinline__ u32x4 pack8(const float* r) { u32x4 w; w.x = cvt_pk_bf16(r[0], r[1]); w.y = cvt_pk_bf16(r[2], r[3]); w.z = cvt_pk_bf16(r[4], r[5]); w.w = cvt_pk_bf16(r[6], r[7]); return w; }
__device__ __forceinline__ u32x4 norm_rope_head(const u32x4 raw, const float* nw, const float2* rope, int j, int pos_r, int pos_c) {
  float x[8]; unpack8(raw, x); float ss = 0.f;
#pragma unroll
  for (int e = 0; e < 8; ++e) ss += x[e] * x[e];
  ss += __shfl_xor(ss, 1); ss += __shfl_xor(ss, 2); ss += __shfl_xor(ss, 4); ss += __shfl_xor(ss, 8);
  const float rs = rsqrtf(ss * (1.0f / 128.0f) + LN_EPS);
  const float4 w0 = *(const float4*)(nw + 8 * j), w1 = *(const float4*)(nw + 8 * j + 4);
  x[0] *= rs * w0.x; x[1] *= rs * w0.y; x[2] *= rs * w0.z; x[3] *= rs * w0.w; x[4] *= rs * w1.x; x[5] *= rs * w1.y; x[6] *= rs * w1.z; x[7] *= rs * w1.w;
  float o[8];
  const bool is_x1 = ((j >> 2) & 1) == 0; const int pos = (j < 8) ? pos_r : pos_c; const int fi = 8 * (j & 3);
#pragma unroll
  for (int e = 0; e < 8; ++e) { const float pv = __shfl_xor(x[e], 4);
    if (pos_r >= 0) { const float2 cs = rope[pos * 32 + fi + e]; o[e] = is_x1 ? (x[e] * cs.x - pv * cs.y) : (pv * cs.y + x[e] * cs.x); }
    else o[e] = x[e]; }
  return pack8(o);
}
__device__ void phase3_elem(const Params& p) {
  int tid_l = threadIdx.x; asm volatile("" : "+v"(tid_l)); const int tid = tid_l, wid = tid >> 6, lane = tid & 63;
  unsigned char* ws = p.ws;
  { const bf16_t* X = (const bf16_t*)(ws + OFF_QKPRE); bf16_t* Y = (bf16_t*)(ws + OFF_QAKA); const float* cw = p.in[8]; const float* cb = p.in[9];
    for (size_t idx = (size_t)blockIdx.x * 512 + tid; idx < (size_t)M_ALL * 256; idx += (size_t)gridDim.x * 512) {
      const int row = (int)(idx >> 8), c8 = (int)(idx & 255) * 8;
      bool first, last; if (row < M_TOK) { const int s = row & (SEQ - 1); first = s == 0; last = s == SEQ - 1; } else { const int t = (row - M_TOK) & (CTXL - 1); first = t == 0; last = t == CTXL - 1; }
      const u32x4 z = {0u, 0u, 0u, 0u};
      const u32x4 cu = *(const u32x4*)(X + (size_t)row * 2048 + c8);
      const u32x4 pr = first ? z : *(const u32x4*)(X + (size_t)(row - 1) * 2048 + c8);
      const u32x4 nx = last ? z : *(const u32x4*)(X + (size_t)(row + 1) * 2048 + c8);
      float a[8], b[8], c[8], r[8]; unpack8(pr, a); unpack8(cu, b); unpack8(nx, c);
      const float sc = c8 >= 1024 ? 0.08838834764831845f : 1.0f;
#pragma unroll
      for (int e = 0; e < 8; ++e) { const float y = cb[c8 + e] + a[e] * cw[c8 + e] + b[e] * cw[2048 + c8 + e] + c[e] * cw[4096 + c8 + e]; r[e] = siluf_(y) * sc; }
      *(u32x4*)(Y + (size_t)row * 2048 + c8) = pack8(r); } }
  const float2* rope = (const float2*)(ws + OFF_ROPE);
  const int j = lane & 15, hl = lane >> 4;
  { const bf16_t* X = (const bf16_t*)(ws + OFF_KBRAW); bf16_t* Y = (bf16_t*)(ws + OFF_KALL);
    for (int row = blockIdx.x * 8 + wid; row < M_ALL; row += gridDim.x * 8) {
      size_t drow; int pr = -1, pc = -1;
      if (row < M_TOK) { const int b = row >> 13, s = row & (SEQ - 1); drow = (size_t)b * SKV + CTXL + s; pr = s >> 6; pc = s & 63; }
      else { const int b = (row - M_TOK) >> 8, t = (row - M_TOK) & (CTXL - 1); drow = (size_t)b * SKV + t; }
      const u32x4 raw = *(const u32x4*)(X + (size_t)row * 512 + hl * 128 + j * 8);
      *(u32x4*)(Y + drow * 512 + hl * 128 + j * 8) = norm_rope_head(raw, p.in[12], rope, j, pr, pc); } }
  { bf16_t* X = (bf16_t*)(ws + OFF_QB);
    for (int it = blockIdx.x * 8 + wid; it < M_TOK * 4; it += gridDim.x * 8) {
      const int row = it >> 2, hd = (it & 3) * 4 + hl, s = row & (SEQ - 1);
      bf16_t* q = X + (size_t)row * 2048 + hd * 128 + j * 8;
      const u32x4 raw = *(const u32x4*)q;
      *(u32x4*)q = norm_rope_head(raw, p.in[11], rope, j, s >> 6, s & 63); } }
}

__device__ void phase5_gate(const Params& p) {
  int tid_l = threadIdx.x; asm volatile("" : "+v"(tid_l)); const int tid = tid_l, wid = tid >> 6, lane = tid & 63;
  const bf16_t* HF = (const bf16_t*)(p.ws + OFF_HF); const bf16_t* HB = (const bf16_t*)(p.ws + OFF_HB); bf16_t* OZ = (bf16_t*)(p.ws + OFF_OZ);
  const float* nw = p.in[10];
  const int j = lane & 31, hl = lane >> 5;
  for (int it = blockIdx.x * 8 + wid; it < M_TOK * 4; it += gridDim.x * 8) {
    const size_t off = (size_t)(it >> 2) * 2048 + ((it & 3) * 2 + hl) * 256 + j * 8;
    float a[8], b[8], g[8], r[8]; unpack8(*(const u32x4*)(HF + off), a); unpack8(*(const u32x4*)(HB + off), b); unpack8(*(const u32x4*)(OZ + off), g);
    float ss = 0.f;
#pragma unroll
    for (int e = 0; e < 8; ++e) { a[e] += b[e]; ss += a[e] * a[e]; }
    ss += __shfl_xor(ss, 1); ss += __shfl_xor(ss, 2); ss += __shfl_xor(ss, 4); ss += __shfl_xor(ss, 8); ss += __shfl_xor(ss, 16);
    const float rs = rsqrtf(ss * (1.0f / 256.0f) + LN_EPS);
    const float* w = nw + ((it & 3) * 2 + hl) * 256 + j * 8;
#pragma unroll
    for (int e = 0; e < 8; ++e) r[e] = a[e] * rs * w[e] * g[e];
    *(u32x4*)(OZ + off) = pack8(r);
  }
}

__device__ void phase8_final_ln(const Params& p) {
  int tid_l = threadIdx.x; asm volatile("" : "+v"(tid_l)); const int tid = tid_l, wid = tid >> 6, lane = tid & 63;
  const float* lw = p.in[16]; const float* lb = p.in[17];
  for (int row = blockIdx.x * 8 + wid; row < M_TOK; row += gridDim.x * 8) {
    float4* r = (float4*)(p.out + (size_t)row * 2048);
    float4 v[8]; float s = 0.f;
#pragma unroll
    for (int i = 0; i < 8; ++i) { v[i] = r[lane + 64 * i]; s += (v[i].x + v[i].y) + (v[i].z + v[i].w); }
    s = wave_sum(s); const float mu = s * (1.f / 2048.f); float q = 0.f;
#pragma unroll
    for (int i = 0; i < 8; ++i) { const float a = v[i].x - mu, b = v[i].y - mu, c = v[i].z - mu, d = v[i].w - mu; q += (a * a + b * b) + (c * c + d * d); }
    q = wave_sum(q); const float rs = rsqrtf(q * (1.f / 2048.f) + LN_EPS);
#pragma unroll
    for (int i = 0; i < 8; ++i) { const float4 w = ((const float4*)lw)[lane + 64 * i], b = ((const float4*)lb)[lane + 64 * i];
      float4 y; y.x = (v[i].x - mu) * rs * w.x + b.x; y.y = (v[i].y - mu) * rs * w.y + b.y; y.z = (v[i].z - mu) * rs * w.z + b.z; y.w = (v[i].w - mu) * rs * w.w + b.w;
      r[lane + 64 * i] = y; }
  }
}

namespace att {
constexpr int D = 128, NW = 8, QBLK = 32, KVBLK = 64;
constexpr float SCALE = 0.088388347648318440f;
constexpr float THR = 8.f;
constexpr int LDQ = 2048, LDK = 512;
constexpr size_t SHM_V = KVBLK * D * 2, SHM_K = KVBLK * D * 2, SHM_ATTN = 2 * SHM_V + 2 * SHM_K + NW * 64 * 4;
#define KSWZ(row, colB) ((row) * 256 + ((colB) ^ (((row) & 7) << 4)))
#define SBAR() __builtin_amdgcn_sched_barrier(0)
__device__ __forceinline__ int crow(int r, int hi) { return (r & 3) + 8 * (r >> 2) + 4 * hi; }
__device__ __forceinline__ unsigned cvtpk(float lo, float hi) { unsigned r; asm volatile("v_cvt_pk_bf16_f32 %0, %1, %2" : "=v"(r) : "v"(lo), "v"(hi)); return r; }
__device__ __forceinline__ void partialSM(f32x16& p0, f32x16& p1, float& m_reg, float& mn, float& alpha) {
  constexpr float C = SCALE * 1.4426950408889634f;
  float pmax = p0[0]; for (int r = 1; r < 16; ++r) pmax = fmaxf(pmax, p0[r]); for (int r = 0; r < 16; ++r) pmax = fmaxf(pmax, p1[r]);
  { auto rr = __builtin_amdgcn_permlane32_swap(__float_as_uint(pmax), __float_as_uint(pmax), false, false);
    pmax = fmaxf(__uint_as_float(rr[0]), __uint_as_float(rr[1])); }
  if (__builtin_expect(__all(pmax - m_reg <= THR / SCALE), 1)) { mn = m_reg; alpha = 1.f; }
  else { mn = fmaxf(m_reg, pmax); alpha = __builtin_amdgcn_exp2f((m_reg - mn) * C); m_reg = mn; }
  float mnC = -mn * C;
  for (int r = 0; r < 16; ++r) p0[r] = fmaf(p0[r], C, mnC); for (int r = 0; r < 16; ++r) p1[r] = fmaf(p1[r], C, mnC);
  for (int r = 0; r < 16; ++r) p0[r] = __builtin_amdgcn_exp2f(p0[r]);
}
__device__ __forceinline__ void finishSM(f32x16& p0, f32x16& p1, float alpha, float& l_reg, bf16x8& pa0, bf16x8& pa1, bf16x8& pa2, bf16x8& pa3) {
  for (int r = 0; r < 16; ++r) p1[r] = __builtin_amdgcn_exp2f(p1[r]);
  float ps = 0; for (int r = 0; r < 16; ++r) ps += p0[r]; for (int r = 0; r < 16; ++r) ps += p1[r];
  { auto rr = __builtin_amdgcn_permlane32_swap(__float_as_uint(ps), __float_as_uint(ps), false, false);
    ps = __uint_as_float(rr[0]) + __uint_as_float(rr[1]); }
  l_reg = l_reg * alpha + ps;
#define PK4(P, BASE, OUT) do { unsigned a0 = cvtpk(P[BASE + 0], P[BASE + 1]), a1 = cvtpk(P[BASE + 2], P[BASE + 3]);   \
    unsigned b0 = cvtpk(P[BASE + 4], P[BASE + 5]), b1 = cvtpk(P[BASE + 6], P[BASE + 7]);                              \
    auto r0 = __builtin_amdgcn_permlane32_swap(a0, b0, false, false); auto r1 = __builtin_amdgcn_permlane32_swap(a1, b1, false, false); \
    u32x4 w = {r0[0], r1[0], r0[1], r1[1]}; OUT = *reinterpret_cast<bf16x8*>(&w); } while (0)
  PK4(p0, 0, pa0); PK4(p0, 8, pa1); PK4(p1, 0, pa2); PK4(p1, 8, pa3);
#undef PK4
}
__device__ __forceinline__ void qkt(f32x16& p0, f32x16& p1, const char* Ks, const bf16x8* qr, int r32, int hi) {
  p0 = f32x16{}; p1 = f32x16{};
  for (int d0 = 0; d0 < 8; ++d0) { int cb = (d0 * 16 + hi * 8) * 2;
    bf16x8 b0 = *reinterpret_cast<const bf16x8*>(Ks + KSWZ(r32, cb));
    bf16x8 b1 = *reinterpret_cast<const bf16x8*>(Ks + KSWZ(32 + r32, cb));
    p0 = __builtin_amdgcn_mfma_f32_32x32x16_bf16(b0, qr[d0], p0, 0, 0, 0);
    p1 = __builtin_amdgcn_mfma_f32_32x32x16_bf16(b1, qr[d0], p1, 0, 0, 0); }
}
__device__ __forceinline__ int v_st(int k, int c) { const int kk = (k & ~0xC) | ((k & 4) << 1) | ((k & 8) >> 1); return ((kk >> 3) * 4 + (c >> 5)) * 512 + ((kk & 7) * 32 + (c & 31)) * 2; }
__device__ __forceinline__ int v_rd_base(int lane) { return ((lane & 3) << 3) | (((lane >> 2) & 3) << 6) | (((lane >> 4) & 1) << 5) | (((lane >> 5) & 1) << 8); }
constexpr int v_rd_off(int d0, int ks, int half) { return d0 * 512 + ks * 4096 + half * 2048; }
template <int OFF> __device__ __forceinline__ s16x4 tr_read(int vb) {
  s16x4 r; asm volatile("ds_read_b64_tr_b16 %0, %1 offset:%2" : "=&v"(r) : "v"(vb), "i"(OFF) : "memory"); return r;
}
#define PKLH(L, H) (bf16x8){L[0], L[1], L[2], L[3], H[0], H[1], H[2], H[3]}
template <int D0> __device__ __forceinline__ void pv_one(f32x16& od, int vb, bf16x8 pa0, bf16x8 pa1, bf16x8 pa2, bf16x8 pa3) {
  const s16x4 l0 = tr_read<v_rd_off(D0, 0, 0)>(vb), h0 = tr_read<v_rd_off(D0, 0, 1)>(vb), l1 = tr_read<v_rd_off(D0, 1, 0)>(vb), h1 = tr_read<v_rd_off(D0, 1, 1)>(vb);
  const s16x4 l2 = tr_read<v_rd_off(D0, 2, 0)>(vb), h2 = tr_read<v_rd_off(D0, 2, 1)>(vb), l3 = tr_read<v_rd_off(D0, 3, 0)>(vb), h3 = tr_read<v_rd_off(D0, 3, 1)>(vb);
  asm volatile("s_waitcnt lgkmcnt(0)" ::: "memory"); SBAR();
  od = __builtin_amdgcn_mfma_f32_32x32x16_bf16(pa0, PKLH(l0, h0), od, 0, 0, 0);
  od = __builtin_amdgcn_mfma_f32_32x32x16_bf16(pa1, PKLH(l1, h1), od, 0, 0, 0);
  od = __builtin_amdgcn_mfma_f32_32x32x16_bf16(pa2, PKLH(l2, h2), od, 0, 0, 0);
  od = __builtin_amdgcn_mfma_f32_32x32x16_bf16(pa3, PKLH(l3, h3), od, 0, 0, 0);
}
__device__ __forceinline__ void pv_d0(f32x16* o, int vb, bf16x8 pa0, bf16x8 pa1, bf16x8 pa2, bf16x8 pa3) {
  pv_one<0>(o[0], vb, pa0, pa1, pa2, pa3); pv_one<1>(o[1], vb, pa0, pa1, pa2, pa3); pv_one<2>(o[2], vb, pa0, pa1, pa2, pa3); pv_one<3>(o[3], vb, pa0, pa1, pa2, pa3);
}
__device__ __forceinline__ void attn_dense_body(bf16_t* __restrict__ Qb, const bf16_t* __restrict__ Kh, const bf16_t* __restrict__ Vh, int seq, char* lds) {
  int tid_l = threadIdx.x; asm volatile("" : "+v"(tid_l)); const int tid = tid_l, wid = tid >> 6, lane = tid & 63, r32 = lane & 31, hi = lane >> 5;
  char* V_lds = lds; char* K_lds = lds + 2 * SHM_V;
  float* wsf = (float*)(lds + 2 * SHM_V + 2 * SHM_K) + wid * 64; float* li_l = wsf; float* al_l = wsf + 32;
  float m_reg = -1e30f, l_reg = 0; f32x16 o[4] = {}; bf16x8 qr[8];
  const bf16_t* Qw = Qb + (long)(wid * QBLK + r32) * LDQ + hi * 8;
#pragma unroll
  for (int d0 = 0; d0 < 8; ++d0) qr[d0] = *reinterpret_cast<const bf16x8*>(Qw + d0 * 16);
  const int sr = tid >> 4, sc = (tid & 15) * 8, vst0 = v_st(sr, sc), vst1 = v_st(32 + sr, sc);
  const int vb0 = (int)(uintptr_t)V_lds + v_rd_base(lane);
  struct { bf16x8 vs0, vs1, ks0, ks1; } sr_[1];
#define SLOAD(i, k0) do { sr_[i].vs0 = *reinterpret_cast<const bf16x8*>(&Vh[(long)((k0) + sr) * LDK + sc]); sr_[i].vs1 = *reinterpret_cast<const bf16x8*>(&Vh[(long)((k0) + 32 + sr) * LDK + sc]); \
    sr_[i].ks0 = *reinterpret_cast<const bf16x8*>(&Kh[(long)((k0) + sr) * LDK + sc]); sr_[i].ks1 = *reinterpret_cast<const bf16x8*>(&Kh[(long)((k0) + 32 + sr) * LDK + sc]); } while (0)
#define SWRITE(b, i) do { *(bf16x8*)(V_lds + (b) * SHM_V + vst0) = sr_[i].vs0;          \
    *(bf16x8*)(V_lds + (b) * SHM_V + vst1) = sr_[i].vs1; int kc = sc * 2;               \
    *(bf16x8*)(K_lds + (b) * SHM_K + KSWZ(sr, kc)) = sr_[i].ks0;                       \
    *(bf16x8*)(K_lds + (b) * SHM_K + KSWZ(32 + sr, kc)) = sr_[i].ks1; } while (0)
#define SWAIT() asm volatile("s_waitcnt vmcnt(0)" ::: "memory")
#define RESC(a) do { if (__any((a) < 1.f)) { if (hi == 0) al_l[r32] = (a); asm volatile("s_waitcnt lgkmcnt(0)" ::: "memory"); \
    for (int d = 0; d < 4; ++d) for (int r = 0; r < 16; ++r) o[d][r] *= al_l[crow(r, hi)]; } } while (0)
  f32x16 pA0, pA1, pB0, pB1; float mnA, mnB, alA, alB; bf16x8 pa0, pa1, pa2, pa3; const int NT = seq / KVBLK;
  constexpr int SE = 0, SO = 0;
  SLOAD(SE, 0); asm volatile("s_waitcnt vmcnt(0)" ::: "memory"); SWRITE(0, SE); __syncthreads();
  qkt(pA0, pA1, K_lds, qr, r32, hi); partialSM(pA0, pA1, m_reg, mnA, alA);
  SLOAD(SO, KVBLK);
  SWAIT(); SWRITE(1, SO); __syncthreads();
  for (int j = 1; j + 1 < NT; j += 2) {
    SBAR(); qkt(pB0, pB1, K_lds + SHM_K, qr, r32, hi);
    finishSM(pA0, pA1, alA, l_reg, pa0, pa1, pa2, pa3); SBAR();
    SLOAD(SO, (j + 1) * KVBLK); SBAR();
    pv_d0(o, vb0, pa0, pa1, pa2, pa3); partialSM(pB0, pB1, m_reg, mnB, alB);
    __syncthreads(); SWAIT(); SWRITE(0, SE);
    RESC(alB); __syncthreads();
    SBAR(); qkt(pA0, pA1, K_lds, qr, r32, hi);
    finishSM(pB0, pB1, alB, l_reg, pa0, pa1, pa2, pa3); SBAR();
    SLOAD(SE, (j + 2) * KVBLK); SBAR();
    pv_d0(o, vb0 + (int)SHM_V, pa0, pa1, pa2, pa3); partialSM(pA0, pA1, m_reg, mnA, alA);
    __syncthreads(); SWAIT(); SWRITE(1, SO);
    RESC(alA); __syncthreads();
  }
  SBAR(); qkt(pB0, pB1, K_lds + SHM_K, qr, r32, hi);
  finishSM(pA0, pA1, alA, l_reg, pa0, pa1, pa2, pa3); SBAR();
  pv_d0(o, vb0, pa0, pa1, pa2, pa3); partialSM(pB0, pB1, m_reg, mnB, alB);
  __syncthreads(); RESC(alB);
  finishSM(pB0, pB1, alB, l_reg, pa0, pa1, pa2, pa3); SBAR();
  pv_d0(o, vb0 + (int)SHM_V, pa0, pa1, pa2, pa3);
  if (hi == 0) li_l[r32] = l_reg; asm volatile("s_waitcnt lgkmcnt(0)" ::: "memory");
  float rli[16];
#pragma unroll
  for (int r = 0; r < 16; ++r) rli[r] = __builtin_amdgcn_rcpf(li_l[crow(r, hi)]);
  bf16_t* qo = Qb + (long)(wid * QBLK + 4 * hi) * LDQ + r32; const bf16_t* zo = qo + (long)((OFF_ZB - OFF_QB) / 2);
  unsigned short zz[64];
#pragma unroll
  for (int r = 0; r < 16; ++r) { const int ro = ((r & 3) + 8 * (r >> 2)) * LDQ;
    zz[4 * r] = zo[ro]; zz[4 * r + 1] = zo[ro + 32]; zz[4 * r + 2] = zo[ro + 64]; zz[4 * r + 3] = zo[ro + 96]; }
  asm volatile("" ::: "memory");
#pragma unroll
  for (int r = 0; r < 16; ++r) { const int ro = ((r & 3) + 8 * (r >> 2)) * LDQ;
    const float v0 = o[0][r] * rli[r] * bf2f(zz[4 * r]), v1 = o[1][r] * rli[r] * bf2f(zz[4 * r + 1]), v2 = o[2][r] * rli[r] * bf2f(zz[4 * r + 2]), v3 = o[3][r] * rli[r] * bf2f(zz[4 * r + 3]);
    qo[ro] = (bf16_t)(cvtpk(v0, v0) & 0xffffu); qo[ro + 32] = (bf16_t)(cvtpk(v1, v1) & 0xffffu); qo[ro + 64] = (bf16_t)(cvtpk(v2, v2) & 0xffffu); qo[ro + 96] = (bf16_t)(cvtpk(v3, v3) & 0xffffu); }
#undef SLOAD
#undef SWRITE
#undef SWAIT
#undef RESC
}
}

namespace ml {
using att::crow; using att::cvtpk; using att::v_st; using att::v_rd_base; using att::v_rd_off; using att::tr_read;
constexpr int O_QS = 0, O_KS = 17408, O_C0 = 34816, O_KTR = 69632, O_VTR = 86016, O_VW = 102400, O_SP = 118784, O_F = 128000;
constexpr int NCH = 132;
template <int KS> __device__ __forceinline__ bf16x8 trfrag(int vb) {
  const s16x4 l = tr_read<v_rd_off(0, KS, 0)>(vb), h = tr_read<v_rd_off(0, KS, 1)>(vb);
  asm volatile("s_waitcnt lgkmcnt(0)" ::: "memory"); SBAR();
  return PKLH(l, h);
}
__device__ __forceinline__ bf16x8 scale_frag(bf16x8 v, const float* we) {
  const u32x4 w = *reinterpret_cast<const u32x4*>(&v); float f[8]; unpack8(w, f);
  const float4 s0 = *(const float4*)we, s1 = *(const float4*)(we + 4);
  f[0] *= s0.x; f[1] *= s0.y; f[2] *= s0.z; f[3] *= s0.w; f[4] *= s1.x; f[5] *= s1.y; f[6] *= s1.z; f[7] *= s1.w;
  const u32x4 o = pack8(f); return *reinterpret_cast<const bf16x8*>(&o);
}
__device__ __forceinline__ int chunk_row0(int c, int b, bool rev) {
  if (!rev) return c < 4 ? M_TOK + b * CTXL + 64 * c : b * SEQ + 64 * (c - 4);
  return c < 4 ? M_TOK + b * CTXL + 64 * (3 - c) : b * SEQ + 64 * (131 - c);
}
__device__ __forceinline__ void gate_scan(float gi, float gf, float bi, float bfb, float& m0, float* S, int lane, int jn) {
  const float li = gi + bi, xf = gf + bfb; const float lf = fminf(xf, 0.f) - __logf(1.0f + __expf(-fabsf(xf)));
  float bb = lf;
#pragma unroll
  for (int o = 1; o < 64; o <<= 1) { const float t = __shfl_up(bb, o); if (lane >= o) bb += t; }
  const float g = li - bb; float cm = g;
#pragma unroll
  for (int o = 1; o < 64; o <<= 1) { const float t = __shfl_up(cm, o); if (lane >= o) cm = fmaxf(cm, t); }
  const float Mx = fmaxf(m0, cm), m = bb + Mx, a = __expf(m0 - Mx), em = __expf(-m);
  const float bL = __shfl(bb, 63), ML = __shfl(Mx, 63), aend = __shfl(a, 63);
  S[jn] = g; S[64 + jn] = Mx; S[128 + jn] = a; S[192 + jn] = em; S[256 + jn] = __expf(g - ML); if (lane == 0) S[320] = aend;
  m0 = bL + ML;
}
__device__ void mlstm_scan(const Params& p, char* lds, int item) {
  int tid_l = threadIdx.x; asm volatile("" : "+v"(tid_l)); const int tid = tid_l, wid = __builtin_amdgcn_readfirstlane(tid >> 6), lane = tid & 63, r32 = lane & 31, hi = lane >> 5;
  const int dir = item & 1, vs = (item >> 1) & 1, bh = item >> 2, b = bh >> 3, h = bh & 7;
  const bool rev = dir != 0, flip = !rev;
  const bf16_t* QK = (const bf16_t*)(p.ws + OFF_QAKA); const bf16_t* VA = (const bf16_t*)(p.ws + OFF_VA); const float* GT = (const float*)(p.ws + OFF_GATES);
  bf16_t* H = (bf16_t*)(p.ws + (rev ? OFF_HB : OFF_HF));
  float* F = (float*)(lds + O_F); float *NQ = F + 768, *RS = F + 832, *N0 = F + 960;
  for (int i = tid; i < 128 * 272 / 4; i += 512) ((unsigned*)(lds + O_C0))[i] = 0u;
  if (tid < 128) N0[tid] = 0.f;
  f32x16 cacc0 = {}, cacc1 = {}; f32x16 acc1 = {}; float nreg = 0.f, m0 = -1e30f;
  const float bi = p.in[7][dir * 16 + h], bfb = p.in[7][dir * 16 + 8 + h];
  const int qrow0 = tid >> 4, qc = (tid & 15) * 8;
  const int jnat = 63 - lane, jg = flip ? lane : jnat;
  bf16x8 q0, q1, k0, k1, v0, v1; float gi1 = 0.f, gf1 = 0.f;
  u32x2 hw0 = {0u, 0u}, hw1 = {0u, 0u}, hw2 = {0u, 0u}, hw3 = {0u, 0u}; bf16_t* hpend = nullptr;
  { const int R0 = chunk_row0(0, b, rev); const bf16_t* qp = QK + (size_t)(R0 + qrow0) * 2048 + h * 128 + qc; const bf16_t* vp = VA + (size_t)(R0 + qrow0) * 2048 + h * 256 + vs * 128 + qc;
    q0 = *(const bf16x8*)qp; q1 = *(const bf16x8*)(qp + 32 * 2048); k0 = *(const bf16x8*)(qp + 1024); k1 = *(const bf16x8*)(qp + 1024 + 32 * 2048);
    v0 = *(const bf16x8*)vp; v1 = *(const bf16x8*)(vp + 32 * 2048);
    if (wid == 0) { const float g0i = GT[(size_t)(R0 + jg) * 32 + dir * 16 + h], g0f = GT[(size_t)(R0 + jg) * 32 + dir * 16 + 8 + h];
      const int R1 = chunk_row0(1, b, rev); gi1 = GT[(size_t)(R1 + jg) * 32 + dir * 16 + h]; gf1 = GT[(size_t)(R1 + jg) * 32 + dir * 16 + 8 + h];
      gate_scan(g0i, g0f, bi, bfb, m0, F, lane, jnat); } }
  const int w4 = wid & 3, t_hi = w4 >> 1, t_lo = w4 & 1;
  const int vt = wid >> 1, jt = wid & 1;
  for (int c = 0; c < NCH; ++c) {
    const int R0 = chunk_row0(c, b, rev); const bool isctx = c < 4;
    float* S = F + (c & 1) * 384; float *G = S, *MX = S + 64, *A = S + 128, *EM = S + 192, *WE = S + 256;
    __syncthreads();
    { const int ra = flip ? 63 - qrow0 : qrow0, rb = flip ? 31 - qrow0 : qrow0 + 32;
    *(bf16x8*)(lds + O_QS + ra * 272 + qc * 2) = q0; *(bf16x8*)(lds + O_QS + rb * 272 + qc * 2) = q1;
    *(bf16x8*)(lds + O_KS + ra * 272 + qc * 2) = k0; *(bf16x8*)(lds + O_KS + rb * 272 + qc * 2) = k1;
    *(bf16x8*)(lds + O_KTR + v_st(ra, qc)) = k0; *(bf16x8*)(lds + O_KTR + v_st(rb, qc)) = k1;
    *(bf16x8*)(lds + O_VTR + v_st(ra, qc)) = v0; *(bf16x8*)(lds + O_VTR + v_st(rb, qc)) = v1;
    { const float wa = WE[ra], wb = WE[rb]; float f[8];
      unpack8(*reinterpret_cast<const u32x4*>(&v0), f);
#pragma unroll
      for (int e = 0; e < 8; ++e) f[e] *= wa;
      *(u32x4*)(lds + O_VW + v_st(ra, qc)) = pack8(f);
      unpack8(*reinterpret_cast<const u32x4*>(&v1), f);
#pragma unroll
      for (int e = 0; e < 8; ++e) f[e] *= wb;
      *(u32x4*)(lds + O_VW + v_st(rb, qc)) = pack8(f); } }
    if (hpend) { *(u32x2*)(hpend) = hw0; *(u32x2*)(hpend + 8) = hw1; *(u32x2*)(hpend + 16) = hw2; *(u32x2*)(hpend + 24) = hw3; hpend = nullptr; }
    if (c + 1 < NCH) { const int R1 = chunk_row0(c + 1, b, rev); const bf16_t* qp = QK + (size_t)(R1 + qrow0) * 2048 + h * 128 + qc; const bf16_t* vp = VA + (size_t)(R1 + qrow0) * 2048 + h * 256 + vs * 128 + qc;
      q0 = *(const bf16x8*)qp; q1 = *(const bf16x8*)(qp + 32 * 2048); k0 = *(const bf16x8*)(qp + 1024); k1 = *(const bf16x8*)(qp + 1024 + 32 * 2048);
      v0 = *(const bf16x8*)vp; v1 = *(const bf16x8*)(vp + 32 * 2048); }
    __syncthreads();
    if (wid < 4) {
      f32x16 pS = {};
      const char* ka = lds + O_KS + (32 * t_hi + r32) * 272 + hi * 16; const char* qb = lds + O_QS + (32 * t_lo + r32) * 272 + hi * 16;
#pragma unroll
      for (int d0 = 0; d0 < 8; ++d0) pS = __builtin_amdgcn_mfma_f32_32x32x16_bf16(*(const bf16x8*)(ka + d0 * 32), *(const bf16x8*)(qb + d0 * 32), pS, 0, 0, 0);
      const int j = 32 * t_lo + r32; const float mxj = MX[j]; float ps = 0.f;
#pragma unroll
      for (int r = 0; r < 16; ++r) { const int s = 32 * t_hi + crow(r, hi); const bool ok = (s >= j);
        const float arg = ok ? (G[s] - mxj) : -1e30f; const float wv = __builtin_amdgcn_exp2f(arg * 1.4426950408889634f); pS[r] *= wv; ps += pS[r]; }
      ps += __shfl_xor(ps, 32); if (hi == 0) RS[t_hi * 64 + j] = ps;
#pragma unroll
      for (int g4 = 0; g4 < 4; ++g4) { u32x2 w; w.x = cvtpk(pS[4 * g4], pS[4 * g4 + 1]); w.y = cvtpk(pS[4 * g4 + 2], pS[4 * g4 + 3]);
        *(u32x2*)(lds + O_SP + j * 144 + (32 * t_hi + 8 * g4 + 4 * hi) * 2) = w; }
    } else {
      const int t4 = tid - 256, jq = t4 >> 2, part = t4 & 3; float sum = 0.f;
      const char* qrow = lds + O_QS + jq * 272 + part * 64;
#pragma unroll
      for (int i = 0; i < 4; ++i) { float f[8]; unpack8(*(const u32x4*)(qrow + 16 * i), f);
#pragma unroll
        for (int e = 0; e < 8; ++e) sum += f[e] * N0[part * 32 + 8 * i + e]; }
      sum += __shfl_xor(sum, 1); sum += __shfl_xor(sum, 2); if (part == 0) NQ[jq] = sum;
    }
    { acc1 = f32x16{};
      const char* ca = lds + O_C0 + (32 * vt + r32) * 272 + hi * 16; const char* qb = lds + O_QS + (32 * jt + r32) * 272 + hi * 16;
#pragma unroll
      for (int d0 = 0; d0 < 8; ++d0) acc1 = __builtin_amdgcn_mfma_f32_32x32x16_bf16(*(const bf16x8*)(ca + d0 * 32), *(const bf16x8*)(qb + d0 * 32), acc1, 0, 0, 0); }
    __syncthreads();
    const float aend = S[320];
    if (wid == 0 && c + 1 < NCH) { gate_scan(gi1, gf1, bi, bfb, m0, F + ((c + 1) & 1) * 384, lane, jnat);
      if (c + 2 < NCH) { const int R2 = chunk_row0(c + 2, b, rev); gi1 = GT[(size_t)(R2 + jg) * 32 + dir * 16 + h]; gf1 = GT[(size_t)(R2 + jg) * 32 + dir * 16 + 8 + h]; } }
    {
      f32x16 acc2 = {};
      const int vbv = (int)(uintptr_t)(lds + O_VTR) + v_rd_base(lane) + vt * 512;
      const char* sb = lds + O_SP + (32 * jt + r32) * 144 + hi * 16;
      const s16x4 l0 = tr_read<v_rd_off(0, 0, 0)>(vbv), h0 = tr_read<v_rd_off(0, 0, 1)>(vbv), l1 = tr_read<v_rd_off(0, 1, 0)>(vbv), h1 = tr_read<v_rd_off(0, 1, 1)>(vbv);
      const s16x4 l2 = tr_read<v_rd_off(0, 2, 0)>(vbv), h2 = tr_read<v_rd_off(0, 2, 1)>(vbv), l3 = tr_read<v_rd_off(0, 3, 0)>(vbv), h3 = tr_read<v_rd_off(0, 3, 1)>(vbv);
      const bf16x8 s0 = *(const bf16x8*)(sb), s1 = *(const bf16x8*)(sb + 32), s2 = *(const bf16x8*)(sb + 64), s3 = *(const bf16x8*)(sb + 96);
      asm volatile("s_waitcnt lgkmcnt(0)" ::: "memory"); SBAR();
      acc2 = __builtin_amdgcn_mfma_f32_32x32x16_bf16(PKLH(l0, h0), s0, acc2, 0, 0, 0);
      acc2 = __builtin_amdgcn_mfma_f32_32x32x16_bf16(PKLH(l1, h1), s1, acc2, 0, 0, 0);
      acc2 = __builtin_amdgcn_mfma_f32_32x32x16_bf16(PKLH(l2, h2), s2, acc2, 0, 0, 0);
      acc2 = __builtin_amdgcn_mfma_f32_32x32x16_bf16(PKLH(l3, h3), s3, acc2, 0, 0, 0);
      const int j = 32 * jt + r32; const float aj = A[j]; const float den = aj * NQ[j] + RS[j] + RS[64 + j];
      const float inv = 1.0f / fmaxf(fabsf(den), EM[j]);
      if (!isctx) { hpend = H + (size_t)(R0 + (flip ? 63 - j : j)) * 2048 + h * 256 + vs * 128 + 32 * vt + 4 * hi;
#define HPK(g4) (u32x2){cvtpk((aj * acc1[4 * g4] + acc2[4 * g4]) * inv, (aj * acc1[4 * g4 + 1] + acc2[4 * g4 + 1]) * inv), cvtpk((aj * acc1[4 * g4 + 2] + acc2[4 * g4 + 2]) * inv, (aj * acc1[4 * g4 + 3] + acc2[4 * g4 + 3]) * inv)}
        hw0 = HPK(0); hw1 = HPK(1); hw2 = HPK(2); hw3 = HPK(3);
#undef HPK
      }
    }
    if (wid == 2 || wid == 3) { const int d = tid - 128; float s = 0.f;
#pragma unroll 8
      for (int si = 0; si < 64; ++si) s += WE[si] * bf2f(*(const bf16_t*)(lds + O_KS + si * 272 + d * 2));
      nreg = aend * nreg + s; N0[d] = nreg; }
    { const int dt = wid & 3, vp2 = (wid >> 2) * 2;
      const int kb = (int)(uintptr_t)(lds + O_KTR) + v_rd_base(lane) + dt * 512;
      const int vb2 = (int)(uintptr_t)(lds + O_VW) + v_rd_base(lane) + vp2 * 512;
      const s16x4 kl0 = tr_read<v_rd_off(0, 0, 0)>(kb), kh0 = tr_read<v_rd_off(0, 0, 1)>(kb), kl1 = tr_read<v_rd_off(0, 1, 0)>(kb), kh1 = tr_read<v_rd_off(0, 1, 1)>(kb);
      const s16x4 kl2 = tr_read<v_rd_off(0, 2, 0)>(kb), kh2 = tr_read<v_rd_off(0, 2, 1)>(kb), kl3 = tr_read<v_rd_off(0, 3, 0)>(kb), kh3 = tr_read<v_rd_off(0, 3, 1)>(kb);
      const s16x4 vl0 = tr_read<v_rd_off(0, 0, 0)>(vb2), vh0 = tr_read<v_rd_off(0, 0, 1)>(vb2), vl1 = tr_read<v_rd_off(0, 1, 0)>(vb2), vh1 = tr_read<v_rd_off(0, 1, 1)>(vb2);
      const s16x4 vl2 = tr_read<v_rd_off(0, 2, 0)>(vb2), vh2 = tr_read<v_rd_off(0, 2, 1)>(vb2), vl3 = tr_read<v_rd_off(0, 3, 0)>(vb2), vh3 = tr_read<v_rd_off(0, 3, 1)>(vb2);
      const s16x4 wl0 = tr_read<v_rd_off(1, 0, 0)>(vb2), wh0 = tr_read<v_rd_off(1, 0, 1)>(vb2), wl1 = tr_read<v_rd_off(1, 1, 0)>(vb2), wh1 = tr_read<v_rd_off(1, 1, 1)>(vb2);
      const s16x4 wl2 = tr_read<v_rd_off(1, 2, 0)>(vb2), wh2 = tr_read<v_rd_off(1, 2, 1)>(vb2), wl3 = tr_read<v_rd_off(1, 3, 0)>(vb2), wh3 = tr_read<v_rd_off(1, 3, 1)>(vb2);
      asm volatile("s_waitcnt lgkmcnt(0)" ::: "memory"); SBAR();
#pragma unroll
      for (int r = 0; r < 16; ++r) { cacc0[r] *= aend; cacc1[r] *= aend; }
      const bf16x8 ka0 = PKLH(kl0, kh0), ka1 = PKLH(kl1, kh1), ka2 = PKLH(kl2, kh2), ka3 = PKLH(kl3, kh3);
      cacc0 = __builtin_amdgcn_mfma_f32_32x32x16_bf16(ka0, PKLH(vl0, vh0), cacc0, 0, 0, 0);
      cacc1 = __builtin_amdgcn_mfma_f32_32x32x16_bf16(ka0, PKLH(wl0, wh0), cacc1, 0, 0, 0);
      cacc0 = __builtin_amdgcn_mfma_f32_32x32x16_bf16(ka1, PKLH(vl1, vh1), cacc0, 0, 0, 0);
      cacc1 = __builtin_amdgcn_mfma_f32_32x32x16_bf16(ka1, PKLH(wl1, wh1), cacc1, 0, 0, 0);
      cacc0 = __builtin_amdgcn_mfma_f32_32x32x16_bf16(ka2, PKLH(vl2, vh2), cacc0, 0, 0, 0);
      cacc1 = __builtin_amdgcn_mfma_f32_32x32x16_bf16(ka2, PKLH(wl2, wh2), cacc1, 0, 0, 0);
      cacc0 = __builtin_amdgcn_mfma_f32_32x32x16_bf16(ka3, PKLH(vl3, vh3), cacc0, 0, 0, 0);
      cacc1 = __builtin_amdgcn_mfma_f32_32x32x16_bf16(ka3, PKLH(wl3, wh3), cacc1, 0, 0, 0);
#pragma unroll
      for (int g4 = 0; g4 < 4; ++g4) { u32x2 w; w.x = cvtpk(cacc0[4 * g4], cacc0[4 * g4 + 1]); w.y = cvtpk(cacc0[4 * g4 + 2], cacc0[4 * g4 + 3]);
        *(u32x2*)(lds + O_C0 + (32 * vp2 + r32) * 272 + (32 * dt + 8 * g4 + 4 * hi) * 2) = w;
        u32x2 x; x.x = cvtpk(cacc1[4 * g4], cacc1[4 * g4 + 1]); x.y = cvtpk(cacc1[4 * g4 + 2], cacc1[4 * g4 + 3]);
        *(u32x2*)(lds + O_C0 + (32 * vp2 + 32 + r32) * 272 + (32 * dt + 8 * g4 + 4 * hi) * 2) = x; }
    }
  }
  if (hpend) { *(u32x2*)(hpend) = hw0; *(u32x2*)(hpend + 8) = hw1; *(u32x2*)(hpend + 16) = hw2; *(u32x2*)(hpend + 24) = hw3; }
  __syncthreads();
}
}

__device__ void phase4_mixers(const Params& p, char* lds) {
  bf16_t* QB = (bf16_t*)(p.ws + OFF_QB);
  const bf16_t* KA = (const bf16_t*)(p.ws + OFF_KALL); const bf16_t* VAl = (const bf16_t*)(p.ws + OFF_VALL);
  const bool sched = gridDim.x == 256; const int bx = blockIdx.x;
  for (int item = bx; item < 128; item += gridDim.x) ml::mlstm_scan(p, lds, item);
  const int nslots = sched ? 9 : (2048 + (int)gridDim.x - 1) / (int)gridDim.x;
  for (int sl = (sched && bx < 128) ? 2 : 0; sl < nslots; ++sl) {
    int i;
    if (sched) i = sl < 2 ? sl * 128 + (bx - 128) : 256 + (sl - 2) * 256 + (bx < 128 ? 128 + bx : bx - 128);
    else { i = sl * (int)gridDim.x + bx; if (i >= 2048) break; }
    const int g = i >> 7, b = g >> 2, kvh = g & 3, hq = kvh * 4 + ((i >> 5) & 3), qb = i & 31;
    const size_t qoff = (size_t)(b * SEQ + qb * 256) * 2048 + hq * 128, koff = (size_t)b * SKV * 512 + kvh * 128;
    att::attn_dense_body(QB + qoff, KA + koff, VAl + koff, SKV, lds);
    __syncthreads();
  }
}

#define GRID_SYNC() do { asm volatile("s_waitcnt vmcnt(0) lgkmcnt(0)" ::: "memory"); grid.sync(); } while (0)
__global__ void __launch_bounds__(512, 2) fwd_megakernel(Params p) {
  extern __shared__ __attribute__((aligned(16))) unsigned char lds[];
  cg::grid_group grid = cg::this_grid();
  unsigned char* ws = p.ws;
  PG8_LAS unsigned char* lds3 = (PG8_LAS unsigned char*)lds;
  phase0_prep(p, lds);
  GRID_SYNC();
  phase1_ln_mod(p);
  GRID_SYNC();
  { pg8::Gemm g{(const bf16_t*)(ws + OFF_U), (const bf16_t*)(ws + OFF_WT_IN), M_ALL, N1P, 2048}; InProjOrder S; S.init((int)gridDim.x, (int)blockIdx.x);
    Epi1 E{ws, (unsigned char*)p.out}; pg8::gemm_phase<Epi1, InProjOrder>(lds3, g, S, E); }
  GRID_SYNC();
  phase3_elem(p);
  GRID_SYNC();
  phase4_mixers(p, (char*)lds);
  GRID_SYNC();
  phase5_gate(p);
  GRID_SYNC();
  { pg8::Gemm g{(const bf16_t*)(ws + OFF_OZ), (const bf16_t*)(ws + OFF_WT_BA), M_TOK, 2048, 2048}; pg8::StaticOrder S; S.init(M_TOK, 2048, (int)gridDim.x, (int)blockIdx.x);
    Epi2a E{(bf16_t*)(ws + OFF_TMP), (const bf16_t*)p.out}; pg8::gemm_phase<Epi2a, pg8::StaticOrder>(lds3, g, S, E); }
  __syncthreads();
  { pg8::Gemm g{(const bf16_t*)(ws + OFF_QB), (const bf16_t*)(ws + OFF_WT_BB), M_TOK, 2048, 2048}; pg8::StaticOrder S; S.init(M_TOK, 2048, (int)gridDim.x, (int)blockIdx.x);
    Epi2b E{(const bf16_t*)(ws + OFF_TMP), (const bf16_t*)p.out + (size_t)M_TOK * 2048, (bf16_t*)(ws + OFF_MERGED)}; pg8::gemm_phase<Epi2b, pg8::StaticOrder>(lds3, g, S, E); }
  GRID_SYNC();
  { pg8::Gemm g{(const bf16_t*)(ws + OFF_MERGED), (const bf16_t*)(ws + OFF_WT_OUT), M_TOK, 2048, 2048}; pg8::StaticOrder S; S.init(M_TOK, 2048, (int)gridDim.x, (int)blockIdx.x);
    Epi3 E{p.in[0], (const float*)(ws + OFF_MOD), p.out}; pg8::gemm_phase<Epi3, pg8::StaticOrder>(lds3, g, S, E); }
  GRID_SYNC();
  phase8_final_ln(p);
}

extern "C" void kernel_launch(void* const* d_in, const int* in_sizes, int n_in, void* d_out, int out_size, void* d_ws, size_t ws_size, hipStream_t stream) {
  static int grid_blocks = 0;
  if (!grid_blocks) {
    if (n_in != 18 || out_size != M_TOK * DM || ws_size < WS_END) { fprintf(stderr, "kernel_launch: unexpected shapes (n_in %d out %d ws %zu need %zu)\n", n_in, out_size, ws_size, (size_t)WS_END); grid_blocks = -1; return; }
    int dev = 0, cus = 0, per_cu = 0;
    (void)hipGetDevice(&dev);
    (void)hipDeviceGetAttribute(&cus, hipDeviceAttributeMultiprocessorCount, dev);
    (void)hipFuncSetAttribute((const void*)fwd_megakernel, hipFuncAttributeMaxDynamicSharedMemorySize, LDS_BYTES);
    (void)hipOccupancyMaxActiveBlocksPerMultiprocessor(&per_cu, fwd_megakernel, 512, LDS_BYTES);
    if (per_cu < 1) per_cu = 1;
    grid_blocks = cus * per_cu;
  }
  if (grid_blocks < 0) return;
  Params p{};
  for (int i = 0; i < 18; ++i) p.in[i] = (const float*)d_in[i];
  p.out = (float*)d_out; p.ws = (unsigned char*)d_ws;
  void* args[] = {&p};
  hipError_t e = hipLaunchCooperativeKernel((void*)fwd_megakernel, dim3(grid_blocks), dim3(512), args, LDS_BYTES, stream);
  if (e != hipSuccess) fprintf(stderr, "cooperative launch failed: %s (grid %d)\n", hipGetErrorString(e), grid_blocks);
}
```

```cpp
#include <hip/hip_runtime.h>
#include <hip/hip_cooperative_groups.h>
#include <cstdio>
#include <cstdint>
namespace cg = cooperative_groups;

constexpr int DM = 2048, NB = 4, SEQ = 8192, CTXL = 256;
constexpr int M_TOK = NB * SEQ, M_CTX = NB * CTXL, M_ALL = M_TOK + M_CTX;
constexpr int SKV = CTXL + SEQ;
constexpr int N_IN = 17440, N1P = 17664;
constexpr float LN_EPS = 1e-6f;
constexpr float ALPHA_DN = 1.189207115002721f;
constexpr int LDS_BYTES = 132 * 1024;

constexpr size_t SZ_W2 = (size_t)2048 * 2048 * 2;
constexpr size_t SZ_ALL = (size_t)M_ALL * 2048 * 2;
constexpr size_t SZ_TOK = (size_t)M_TOK * 2048 * 2;
constexpr size_t SZ_KV = (size_t)NB * SKV * 512 * 2;
constexpr size_t OFF_WT_BA = 0, OFF_WT_BB = SZ_W2, OFF_WT_OUT = 2 * SZ_W2;
constexpr size_t OFF_MOD = 3 * SZ_W2;
constexpr size_t OFF_ROPE = OFF_MOD + 131072;
constexpr size_t OFF_U = OFF_ROPE + 32768;
constexpr size_t OFF_QAKA = OFF_U;
constexpr size_t OFF_QKPRE = OFF_U + SZ_ALL;
constexpr size_t OFF_HF = OFF_QKPRE, OFF_MERGED = OFF_QKPRE;
constexpr size_t OFF_OZ = OFF_QKPRE + SZ_ALL;
constexpr size_t OFF_QB = OFF_OZ + SZ_TOK;
constexpr size_t OFF_ZB = OFF_QB + SZ_TOK;
constexpr size_t OFF_TMP = OFF_ZB;
constexpr size_t OFF_VA = OFF_ZB + SZ_TOK;
constexpr size_t OFF_VALL = OFF_VA + SZ_ALL;
constexpr size_t OFF_KALL = OFF_VALL + SZ_KV;
constexpr size_t OFF_GATES = OFF_KALL + SZ_KV;
constexpr size_t OFF_KBRAW = OFF_GATES + (size_t)M_ALL * 32 * 4;
constexpr size_t OFF_HB = OFF_KBRAW;
constexpr size_t OFF_WT_IN = OFF_KBRAW + SZ_KV;
constexpr size_t WS_END = OFF_HB + SZ_TOK;
static_assert(OFF_WT_IN + (size_t)N1P * 2048 * 2 <= WS_END, "ws map");
static_assert(OFF_TMP + (size_t)M_TOK * 2048 * 4 <= OFF_VALL, "tmp map");
static_assert(OFF_U % 256 == 0 && OFF_GATES % 256 == 0 && OFF_KBRAW % 256 == 0, "align");

typedef unsigned short bf16_t;
using f32x16 = __attribute__((ext_vector_type(16))) float;
using s16x4 = __attribute__((ext_vector_type(4))) short;
using u32x2 = __attribute__((ext_vector_type(2))) unsigned;

struct Params { const float* in[18]; float* out; unsigned char* ws; };

__device__ __forceinline__ float wave_sum(float v) {
#pragma unroll
  for (int o = 32; o >= 1; o >>= 1) v += __shfl_xor(v, o);
  return v;
}
__device__ __forceinline__ float bf2f(unsigned short b) { return __uint_as_float(((unsigned)b) << 16); }
__device__ __forceinline__ float bflo(unsigned w) { return __uint_as_float(w << 16); }
__device__ __forceinline__ float bfhi(unsigned w) { return __uint_as_float(w & 0xffff0000u); }
__device__ __forceinline__ float sigmoidf_(float x) { return __builtin_amdgcn_rcpf(1.0f + __expf(-x)); }
__device__ __forceinline__ float siluf_(float x) { return x * __builtin_amdgcn_rcpf(1.0f + __expf(-x)); }
namespace pg8 {
#define PG8_LAS __attribute__((address_space(3)))
typedef unsigned short bf16_t;
typedef short bf16x8 __attribute__((ext_vector_type(8)));
typedef float f32x4 __attribute__((ext_vector_type(4)));
typedef unsigned u32x4 __attribute__((ext_vector_type(4)));
constexpr int BM = 256, BK = 64, HALF = 128, HTB = HALF * BK * 2  , STAGE_BYTES = 8 * HTB, NXCD = 8, WGM = 8;

__host__ __device__ __forceinline__ int lds_byte(int r, int c) { const int st = (r >> 4) * 2 + (c >> 5), rr = r & 15, cc = c & 31, ob = rr * 64 + cc * 2; return st * 1024 + (ob ^ (((ob >> 9) & 1) << 5)); }
__host__ __device__ __forceinline__ void stage_rc(int b, int& R, int& C) { const int st = b / 1024, sb = b % 1024, swz = sb ^ (((sb >> 9) & 1) << 5); R = (st >> 1) * 16 + swz / 64; C = (st & 1) * 32 + (swz % 64) / 2; }
__host__ __device__ __forceinline__ int perm32(int rho) { const int n = rho >> 4, i = rho & 15; return 8 * (i >> 2) + 4 * n + (i & 3); }

struct Unit { int pm, pn; };
struct Gemm { const bf16_t* A; const bf16_t* Bt; int M, N, K; };

struct StaticOrder {
    int nM, nN, nwg, G, c;
    __host__ __device__ void init(int M, int N, int G_, int c_) { nM = M / BM; nN = N / BM; nwg = nM * nN; G = G_; c = c_; }
    __host__ __device__ bool next(int i, Unit& u) const {
        const long L = (long)i * G + c; if (L >= nwg) return false;
        int wgid = (int)L; { const int q = nwg / NXCD, r = nwg % NXCD, xcd = wgid % NXCD, off = wgid / NXCD; wgid = (xcd < r ? xcd * (q + 1) : r * (q + 1) + (xcd - r) * q) + off; }
        const int nig = WGM * nN, gid = wgid / nig, fm = gid * WGM, gsz = (nM - fm) < WGM ? (nM - fm) : WGM;
        u.pm = fm + ((wgid % nig) % gsz); u.pn = (wgid % nig) / gsz; return true;
    }
    __device__ __forceinline__ void a_ready(const Unit&) const {}
    __device__ __forceinline__ void done(const Unit&) const {}
};
__device__ __forceinline__ unsigned cvt_pk_bf16(float lo, float hi) { unsigned r; asm volatile("v_cvt_pk_bf16_f32 %0, %1, %2" : "=v"(r) : "v"(lo), "v"(hi)); return r; }
template <class Epi, class Sched>
__device__ __forceinline__ void gemm_phase(PG8_LAS unsigned char* lds, const Gemm g, const Sched& S, const Epi& E) {
    int tid_l = threadIdx.x; asm volatile("" : "+v"(tid_l)); const int tid = tid_l, wid = __builtin_amdgcn_readfirstlane(tid >> 6), lane = tid & 63, wr = wid >> 2, wc = wid & 3, fr = lane & 15, fq = lane >> 4;
    const int K = g.K, nt = K / BK;
    unsigned voffA[2], voffB[2];
#pragma unroll
    for (int i = 0; i < 2; ++i) { int R, C; stage_rc(tid * 16 + i * 8192, R, C); const int Rb = Epi::PERM ? ((R & ~31) + perm32(R & 31)) : R;
        voffA[i] = (unsigned)(R * K + C) * 2u; voffB[i] = (unsigned)(Rb * K + C) * 2u; }
    const size_t kstep = (size_t)(BK * 2);
    const size_t hstep = (size_t)HALF * K * 2;
    const size_t tstep = 2 * hstep;
    const unsigned ldsw = (unsigned)wid * 1024u;
    const int aoff = lds_byte(wr * 64 + fr, fq * 8), boff = lds_byte(wc * 32 + fr, fq * 8);
#define PG8_SA(b, h) (((b) * 2 + (h)) * HTB)
#define PG8_SB(b, h) ((4 + (b) * 2 + (h)) * HTB)
#define PG8_STAGE(bufoff, gbase, voff) do { _Pragma("unroll") for (int _i = 0; _i < 2; ++_i) \
        __builtin_amdgcn_global_load_lds((const unsigned*)((const char*)(gbase) + (voff)[_i]), (PG8_LAS unsigned*)(lds + (bufoff) + ldsw + _i * 8192), 16, 0, 0); } while (0)
#define PG8_LDA(dst, b, h) do { _Pragma("unroll") for (int m = 0; m < 4; ++m) _Pragma("unroll") for (int k = 0; k < 2; ++k) dst[m][k] = *(const PG8_LAS bf16x8*)(lds + PG8_SA(b, h) + aoff + m * 2048 + k * 1024); } while (0)
#define PG8_LDB(dst, b, h) do { _Pragma("unroll") for (int n = 0; n < 2; ++n) _Pragma("unroll") for (int k = 0; k < 2; ++k) dst[n][k] = *(const PG8_LAS bf16x8*)(lds + PG8_SB(b, h) + boff + n * 2048 + k * 1024); } while (0)
#define PG8_MMA(ai, bj, At, Bt) do { __builtin_amdgcn_s_setprio(1); _Pragma("unroll") for (int m = 0; m < 4; ++m) _Pragma("unroll") for (int n = 0; n < 2; ++n) _Pragma("unroll") for (int k = 0; k < 2; ++k) \
        acc[ai][bj][m][n] = __builtin_amdgcn_mfma_f32_16x16x32_bf16(Bt[n][k], At[m][k], acc[ai][bj][m][n], 0, 0, 0); __builtin_amdgcn_s_setprio(0); } while (0)
#define PG8_WAIT_V(n) asm volatile("s_waitcnt vmcnt(" #n ")" ::: "memory")
#define PG8_WAIT_L(n) asm volatile("s_waitcnt lgkmcnt(" #n ")" ::: "memory")
#define PG8_BAR __builtin_amdgcn_s_barrier()
#define PG8_SCHED __builtin_amdgcn_sched_barrier(0)
    Unit cur, nxt; int ui = 0;
    if (!S.next(0, cur)) return;
    f32x4 acc[2][2][4][2];
#pragma unroll
    for (int a = 0; a < 2; ++a)
#pragma unroll
        for (int b = 0; b < 2; ++b)
#pragma unroll
            for (int m = 0; m < 4; ++m)
#pragma unroll
                for (int n = 0; n < 2; ++n) acc[a][b][m][n] = (f32x4){0.f, 0.f, 0.f, 0.f};
    bf16x8 At[4][2], B0[2][2], B1[2][2];
    const char* cA = (const char*)g.A + (size_t)cur.pm * tstep; const char* cB = (const char*)g.Bt + (size_t)cur.pn * tstep;
    S.a_ready(cur);
    PG8_STAGE(PG8_SB(0, 0), cB, voffB); PG8_STAGE(PG8_SA(0, 0), cA, voffA); PG8_STAGE(PG8_SB(0, 1), cB + hstep, voffB); PG8_STAGE(PG8_SA(0, 1), cA + hstep, voffA);
    if (wr == 1) PG8_BAR;
    PG8_WAIT_V(4); PG8_BAR;
    PG8_STAGE(PG8_SB(1, 0), cB + kstep, voffB); PG8_STAGE(PG8_SA(1, 0), cA + kstep, voffA); PG8_STAGE(PG8_SB(1, 1), cB + hstep + kstep, voffB);
    PG8_WAIT_V(6); PG8_BAR;
    for (;;) {
        const bool has_next = S.next(ui + 1, nxt);
        const char* nA = has_next ? (const char*)g.A + (size_t)nxt.pm * tstep : cA; const char* nB = has_next ? (const char*)g.Bt + (size_t)nxt.pn * tstep : cB;
        for (int t = 0; t < nt; t += 2) {
            const bool last = (t == nt - 2);
            const char* a1 = cA + (size_t)(t + 1) * kstep;
            const char* a2 = last ? nA : cA + (size_t)(t + 2) * kstep; const char* b2 = last ? nB : cB + (size_t)(t + 2) * kstep;
            const char* a3 = a2 + kstep; const char* b3 = b2 + kstep;
            if (last && has_next) S.a_ready(nxt);
            PG8_LDB(B0, 0, 0); PG8_SCHED; PG8_LDA(At, 0, 0); PG8_STAGE(PG8_SA(1, 1), a1 + hstep, voffA);
            PG8_WAIT_L(8); PG8_BAR; PG8_WAIT_L(0); PG8_MMA(0, 0, At, B0); PG8_BAR; PG8_SCHED;
            PG8_LDB(B1, 0, 1); PG8_STAGE(PG8_SB(0, 0), b2, voffB);
            PG8_BAR; PG8_WAIT_L(0); PG8_MMA(0, 1, At, B1); PG8_BAR;
            PG8_LDA(At, 0, 1); PG8_STAGE(PG8_SA(0, 0), a2, voffA);
            PG8_BAR; PG8_WAIT_L(0); PG8_MMA(1, 0, At, B0); PG8_BAR; PG8_SCHED;
            PG8_STAGE(PG8_SB(0, 1), b2 + hstep, voffB);
            PG8_WAIT_V(6); PG8_BAR; PG8_MMA(1, 1, At, B1); PG8_BAR;
            PG8_LDB(B0, 1, 0); PG8_SCHED; PG8_LDA(At, 1, 0); PG8_STAGE(PG8_SA(0, 1), a2 + hstep, voffA);
            PG8_WAIT_L(8); PG8_BAR; PG8_WAIT_L(0); PG8_MMA(0, 0, At, B0); PG8_BAR; PG8_SCHED;
            PG8_LDB(B1, 1, 1); PG8_STAGE(PG8_SB(1, 0), b3, voffB);
            PG8_BAR; PG8_WAIT_L(0); PG8_MMA(0, 1, At, B1); PG8_BAR;
            PG8_LDA(At, 1, 1); PG8_STAGE(PG8_SA(1, 0), a3, voffA);
            PG8_BAR; PG8_WAIT_L(0); PG8_MMA(1, 0, At, B0); PG8_BAR; PG8_SCHED;
            PG8_STAGE(PG8_SB(1, 1), b3 + hstep, voffB);
            PG8_WAIT_V(6); PG8_BAR; PG8_MMA(1, 1, At, B1); PG8_BAR;
        }
        if constexpr (!Epi::AFTER_DRAIN) { E(acc, cur, wr, wc, fr, fq); S.done(cur); }
        if (!has_next) break;
#pragma unroll
        for (int a = 0; a < 2; ++a)
#pragma unroll
            for (int b = 0; b < 2; ++b)
#pragma unroll
                for (int m = 0; m < 4; ++m)
#pragma unroll
                    for (int n = 0; n < 2; ++n) acc[a][b][m][n] = (f32x4){0.f, 0.f, 0.f, 0.f};
        cur = nxt; cA = nA; cB = nB; ++ui;
    }
    PG8_WAIT_V(0);
    if (wr == 0) PG8_BAR;
    PG8_BAR;
    if constexpr (Epi::AFTER_DRAIN) { E.fused(acc, cur, wr, wc, fr, fq, lds, wid, lane); S.done(cur); }
#undef PG8_SA
#undef PG8_SB
#undef PG8_STAGE
#undef PG8_LDA
#undef PG8_LDB
#undef PG8_MMA
#undef PG8_WAIT_V
#undef PG8_WAIT_L
#undef PG8_BAR
#undef PG8_SCHED
}
}


using pg8::f32x4; using pg8::u32x4; using pg8::bf16x8; using pg8::cvt_pk_bf16;

struct Epi1 {
  static constexpr bool PERM = true, AFTER_DRAIN = false;
  unsigned char* ws; unsigned char* dout;
  __device__ __forceinline__ void operator()(const f32x4 (&acc)[2][2][4][2], const pg8::Unit& u, int wr, int wc, int fr, int fq) const {
    const int pn = u.pn, pm = u.pm; const bool lat = pm < 128;
    const int rl = wr * 64 + fr, cl = wc * 32 + 8 * fq;
    if (pn == 20) {
      if (wc == 0) { float* G = (float*)(ws + OFF_GATES);
#pragma unroll
        for (int ai = 0; ai < 2; ++ai)
#pragma unroll
          for (int m = 0; m < 4; ++m) { float* rp = G + (size_t)(pm * 256 + ai * 128 + rl + m * 16) * 32 + 8 * fq;
            *(f32x4*)rp = acc[ai][0][m][0]; *(f32x4*)(rp + 4) = acc[ai][0][m][1]; } }
      return;
    }
    if (pn >= 21 && pn < 37) {
      if (!lat) return;
      bf16_t* O = (bf16_t*)(ws + OFF_OZ) + (pn - 21) * 128 + cl;
#pragma unroll
      for (int ai = 0; ai < 2; ++ai)
#pragma unroll
        for (int m = 0; m < 4; ++m) { const size_t row = (size_t)pm * 256 + ai * 128 + rl + m * 16;
          float r[8];
#pragma unroll
          for (int n = 0; n < 2; ++n)
#pragma unroll
            for (int e = 0; e < 4; ++e) r[n * 4 + e] = sigmoidf_(acc[ai][0][m][n][e]) * siluf_(acc[ai][1][m][n][e]);
          u32x4 w; w.x = cvt_pk_bf16(r[0], r[1]); w.y = cvt_pk_bf16(r[2], r[3]); w.z = cvt_pk_bf16(r[4], r[5]); w.w = cvt_pk_bf16(r[6], r[7]);
          *(u32x4*)(O + row * 2048) = w; }
      return;
    }
    bf16_t* O; int ld = 2048, act = 0; size_t rowbase = (size_t)pm * 256;
    if (pn < 8) { O = (bf16_t*)(ws + OFF_QKPRE) + pn * 256; }
    else if (pn < 16) { O = (bf16_t*)(ws + OFF_VA) + (pn - 8) * 256; }
    else if (pn < 18) { O = (bf16_t*)(ws + OFF_KBRAW) + (pn - 16) * 256; ld = 512; }
    else if (pn < 20) { O = (bf16_t*)(ws + OFF_VALL) + (pn - 18) * 256; ld = 512;
      rowbase = lat ? (size_t)(pm >> 5) * SKV + CTXL + (size_t)(pm & 31) * 256 : (size_t)(pm - 128) * SKV; }
    else { if (!lat) return;
      if (pn < 45) { O = (bf16_t*)(ws + OFF_QB) + (pn - 37) * 256; }
      else if (pn < 53) { O = (bf16_t*)(ws + OFF_ZB) + (pn - 45) * 256; act = 1; }
      else if (pn < 61) { O = (bf16_t*)dout + (pn - 53) * 256; act = 2; }
      else { O = (bf16_t*)dout + (size_t)M_TOK * 2048 + (pn - 61) * 256; act = 2; } }
#pragma unroll
    for (int ai = 0; ai < 2; ++ai)
#pragma unroll
      for (int m = 0; m < 4; ++m) { bf16_t* rowp = O + (rowbase + ai * 128 + rl + m * 16) * ld + cl;
#pragma unroll
        for (int bj = 0; bj < 2; ++bj) { f32x4 v0 = acc[ai][bj][m][0], v1 = acc[ai][bj][m][1];
          if (act == 1) {
#pragma unroll
            for (int e = 0; e < 4; ++e) { v0[e] = siluf_(v0[e]); v1[e] = siluf_(v1[e]); } }
          else if (act == 2) {
#pragma unroll
            for (int e = 0; e < 4; ++e) { v0[e] = sigmoidf_(v0[e]); v1[e] = sigmoidf_(v1[e]); } }
          u32x4 w; w.x = cvt_pk_bf16(v0[0], v0[1]); w.y = cvt_pk_bf16(v0[2], v0[3]); w.z = cvt_pk_bf16(v1[0], v1[1]); w.w = cvt_pk_bf16(v1[2], v1[3]);
          *(u32x4*)(rowp + bj * 128) = w; } }
  }
};
struct Epi2a {
  static constexpr bool PERM = true, AFTER_DRAIN = false;
  bf16_t* tmp; const bf16_t* sg;
  __device__ __forceinline__ void operator()(const f32x4 (&acc)[2][2][4][2], const pg8::Unit& u, int wr, int wc, int fr, int fq) const {
    const int col0 = u.pn * 256 + wc * 32 + 8 * fq;
#pragma unroll
    for (int ai = 0; ai < 2; ++ai)
#pragma unroll
      for (int m = 0; m < 4; ++m) { const size_t off = (size_t)(u.pm * 256 + ai * 128 + wr * 64 + fr + m * 16) * 2048 + col0;
#pragma unroll
        for (int bj = 0; bj < 2; ++bj) { const u32x4 s = *(const u32x4*)(sg + off + bj * 128);
          f32x4 a = acc[ai][bj][m][0], b = acc[ai][bj][m][1];
          a[0] *= bflo(s.x); a[1] *= bfhi(s.x); a[2] *= bflo(s.y); a[3] *= bfhi(s.y);
          b[0] *= bflo(s.z); b[1] *= bfhi(s.z); b[2] *= bflo(s.w); b[3] *= bfhi(s.w);
          u32x4 w; w.x = cvt_pk_bf16(a[0], a[1]); w.y = cvt_pk_bf16(a[2], a[3]); w.z = cvt_pk_bf16(b[0], b[1]); w.w = cvt_pk_bf16(b[2], b[3]);
          *(u32x4*)(tmp + off + bj * 128) = w; } }
  }
};
struct Epi2b {
  static constexpr bool PERM = true, AFTER_DRAIN = false;
  const bf16_t* tmp; const bf16_t* sg; bf16_t* merged;
  __device__ __forceinline__ void operator()(const f32x4 (&acc)[2][2][4][2], const pg8::Unit& u, int wr, int wc, int fr, int fq) const {
    const int col0 = u.pn * 256 + wc * 32 + 8 * fq;
#pragma unroll
    for (int ai = 0; ai < 2; ++ai)
#pragma unroll
      for (int m = 0; m < 4; ++m) { const size_t off = (size_t)(u.pm * 256 + ai * 128 + wr * 64 + fr + m * 16) * 2048 + col0;
#pragma unroll
        for (int bj = 0; bj < 2; ++bj) { const u32x4 s = *(const u32x4*)(sg + off + bj * 128);
          const u32x4 tw = *(const u32x4*)(tmp + off + bj * 128); const f32x4 t0 = {bflo(tw.x), bfhi(tw.x), bflo(tw.y), bfhi(tw.y)}, t1 = {bflo(tw.z), bfhi(tw.z), bflo(tw.w), bfhi(tw.w)};
          f32x4 a = acc[ai][bj][m][0], b = acc[ai][bj][m][1];
          a[0] = t0[0] + a[0] * bflo(s.x); a[1] = t0[1] + a[1] * bfhi(s.x); a[2] = t0[2] + a[2] * bflo(s.y); a[3] = t0[3] + a[3] * bfhi(s.y);
          b[0] = t1[0] + b[0] * bflo(s.z); b[1] = t1[1] + b[1] * bfhi(s.z); b[2] = t1[2] + b[2] * bflo(s.w); b[3] = t1[3] + b[3] * bfhi(s.w);
          u32x4 w; w.x = cvt_pk_bf16(a[0], a[1]); w.y = cvt_pk_bf16(a[2], a[3]); w.z = cvt_pk_bf16(b[0], b[1]); w.w = cvt_pk_bf16(b[2], b[3]);
          *(u32x4*)(merged + off + bj * 128) = w; } }
  }
};
struct Epi3 {
  static constexpr bool PERM = false, AFTER_DRAIN = false;
  const float* x; const float* mod; float* y;
  __device__ __forceinline__ void operator()(const f32x4 (&acc)[2][2][4][2], const pg8::Unit& u, int wr, int wc, int fr, int fq) const {
    const int col0 = u.pn * 256 + wc * 32 + 4 * fq;
    const float* gate = mod + (size_t)(u.pm >> 5) * 6144 + 4096 + col0;
    f32x4 gv[2][2];
#pragma unroll
    for (int bj = 0; bj < 2; ++bj)
#pragma unroll
      for (int n = 0; n < 2; ++n) gv[bj][n] = *(const f32x4*)(gate + bj * 128 + n * 16);
#pragma unroll
    for (int ai = 0; ai < 2; ++ai)
#pragma unroll
      for (int m = 0; m < 4; ++m) { const size_t off = (size_t)(u.pm * 256 + ai * 128 + wr * 64 + fr + m * 16) * 2048 + col0;
#pragma unroll
        for (int bj = 0; bj < 2; ++bj)
#pragma unroll
          for (int n = 0; n < 2; ++n) { const f32x4 xv = *(const f32x4*)(x + off + bj * 128 + n * 16);
            *(f32x4*)(y + off + bj * 128 + n * 16) = xv * ALPHA_DN + gv[bj][n] * acc[ai][bj][m][n]; } }
  }
};

struct InProjOrder {
  pg8::StaticOrder base; int G, c;
  __device__ void init(int G_, int c_) { base.init(M_TOK, N1P, G_, c_); G = G_; c = c_; }
  __device__ bool next(int i, pg8::Unit& u) const {
    const long L = (long)i * G + c; if (L < base.nwg) return base.next(i, u);
    const int r = (int)(L - base.nwg); if (r >= 4 * 21) return false;
    u.pm = 128 + (r & 3); u.pn = r >> 2; return true; }
  __device__ __forceinline__ void a_ready(const pg8::Unit&) const {}
  __device__ __forceinline__ void done(const pg8::Unit&) const {}
};

__device__ __forceinline__ int orig_col(int n) {
  if (n < 4096) return n;
  if (n < 4608) return 4128 + (n - 4096);
  if (n < 5120) return 4640 + (n - 4608);
  if (n < 5152) return 4096 + (n - 5120);
  if (n < 5376) return -1;
  if (n < 9472) { const int t = n - 5376, j = t >> 8, r = t & 255; return r < 128 ? 5152 + 128 * j + r : 7200 + 128 * j + (r - 128); }
  if (n < 11520) return 9248 + (n - 9472);
  if (n < 13568) return 11296 + (n - 11520);
  return 13344 + (n - 13568);
}
__device__ void phase0_prep(const Params& p, unsigned char* lds) {
  int tid_l = threadIdx.x; asm volatile("" : "+v"(tid_l)); const int tid = tid_l, wid = tid >> 6, lane = tid & 63;
  unsigned char* ws = p.ws;
  for (int idx = blockIdx.x * 512 + tid; idx < 4096; idx += gridDim.x * 512) {
    const int pos = idx >> 5, i = idx & 31; const float inv = powf(10000.0f, -(float)(2 * i) / 64.0f); const float ang = (float)pos * inv;
    float2 cs; cs.x = cosf(ang); cs.y = sinf(ang); ((float2*)(ws + OFF_ROPE))[idx] = cs; }
  float* sl = (float*)lds; float* red = sl + 5 * 2048; bool did = false;
  for (int it = blockIdx.x; it < 192; it += gridDim.x) {
    if (!did) { for (int i = tid; i < 5 * 2048; i += 512) { const int r = i >> 11, k = i & 2047; const float c = (r < 4) ? p.in[1][r * 2048 + k] : p.in[3][k]; sl[i] = c / (1.0f + expf(-c)); }
      __syncthreads(); did = true; }
    const int col = lane & 31, kh = lane >> 5, n = it * 32 + col;
    float a0 = 0.f, a1 = 0.f, a2 = 0.f, a3 = 0.f, a4 = 0.f;
    const float* wp = p.in[4] + (size_t)(wid * 256 + kh) * 6144 + n;
#pragma unroll 8
    for (int i = 0; i < 128; ++i) { const int k = wid * 256 + 2 * i + kh; const float w = wp[(size_t)(2 * i) * 6144];
      a0 += sl[k] * w; a1 += sl[2048 + k] * w; a2 += sl[4096 + k] * w; a3 += sl[6144 + k] * w; a4 += sl[8192 + k] * w; }
    a0 += __shfl_xor(a0, 32); a1 += __shfl_xor(a1, 32); a2 += __shfl_xor(a2, 32); a3 += __shfl_xor(a3, 32); a4 += __shfl_xor(a4, 32);
    if (kh == 0) { red[(wid * 5 + 0) * 32 + col] = a0; red[(wid * 5 + 1) * 32 + col] = a1; red[(wid * 5 + 2) * 32 + col] = a2; red[(wid * 5 + 3) * 32 + col] = a3; red[(wid * 5 + 4) * 32 + col] = a4; }
    __syncthreads();
    if (tid < 160) { const int r = tid >> 5, c = tid & 31; float s = 0.f;
#pragma unroll
      for (int w = 0; w < 8; ++w) s += red[(w * 5 + r) * 32 + c];
      ((float*)(ws + OFF_MOD))[r * 6144 + it * 32 + c] = s + p.in[5][it * 32 + c]; }
    __syncthreads();
  }
  __syncthreads();
  float* tile = (float*)lds;
  constexpr int NT_IN = (N1P / 64) * 32, NT = NT_IN + 3 * 1024;
  for (int t = blockIdx.x; t < NT; t += gridDim.x) {
    const float* src; bf16_t* dst; int ldsrc, n0, k0; bool perm;
    if (t < NT_IN) { src = p.in[6]; dst = (bf16_t*)(ws + OFF_WT_IN); ldsrc = N_IN; n0 = (t >> 5) * 64; k0 = (t & 31) * 64; perm = true; }
    else { int q = t - NT_IN; const int w = q >> 10; q &= 1023; src = p.in[13 + w]; dst = (bf16_t*)(ws + OFF_WT_BA + (size_t)w * SZ_W2); ldsrc = 2048; n0 = (q >> 5) * 64; k0 = (q & 31) * 64; perm = false; }
#pragma unroll
    for (int i = 0; i < 2; ++i) { const int kk = (tid >> 4) + 32 * i, nq = (tid & 15) * 4; const int oc = perm ? orig_col(n0 + nq) : n0 + nq;
      float4 v = make_float4(0.f, 0.f, 0.f, 0.f); if (oc >= 0) v = *(const float4*)(src + (size_t)(k0 + kk) * ldsrc + oc);
      float* tp = tile + kk * 65 + nq; tp[0] = v.x; tp[1] = v.y; tp[2] = v.z; tp[3] = v.w; }
    __syncthreads();
    { const int nn = tid >> 3, kq = (tid & 7) * 8; float r[8];
#pragma unroll
      for (int e = 0; e < 8; ++e) r[e] = tile[(kq + e) * 65 + nn];
      u32x4 w; w.x = cvt_pk_bf16(r[0], r[1]); w.y = cvt_pk_bf16(r[2], r[3]); w.z = cvt_pk_bf16(r[4], r[5]); w.w = cvt_pk_bf16(r[6], r[7]);
      *(u32x4*)(dst + (size_t)(n0 + nn) * 2048 + k0 + kq) = w; }
    __syncthreads();
  }
}

__device__ void phase1_ln_mod(const Params& p) {
  int tid_l = threadIdx.x; asm volatile("" : "+v"(tid_l)); const int tid = tid_l, wid = tid >> 6, lane = tid & 63;
  const float* MOD = (const float*)(p.ws + OFF_MOD); bf16_t* U = (bf16_t*)(p.ws + OFF_U);
  for (int row = blockIdx.x * 8 + wid; row < M_ALL; row += gridDim.x * 8) {
    const float* src = row < M_TOK ? p.in[0] + (size_t)row * 2048 : p.in[2] + (size_t)(row - M_TOK) * 2048;
    const float* md = MOD + (size_t)(row < M_TOK ? (row >> 13) : 4) * 6144;
    float4 v[4][2]; float s = 0.f;
#pragma unroll
    for (int g = 0; g < 4; ++g) { const float4* q = (const float4*)(src + g * 512 + lane * 8); v[g][0] = q[0]; v[g][1] = q[1];
      s += (v[g][0].x + v[g][0].y) + (v[g][0].z + v[g][0].w) + (v[g][1].x + v[g][1].y) + (v[g][1].z + v[g][1].w); }
    s = wave_sum(s); const float mu = s * (1.0f / 2048.0f); float q2 = 0.f;
#pragma unroll
    for (int g = 0; g < 4; ++g)
#pragma unroll
      for (int h = 0; h < 2; ++h) { const float a = v[g][h].x - mu, b = v[g][h].y - mu, c = v[g][h].z - mu, d = v[g][h].w - mu; q2 += (a * a + b * b) + (c * c + d * d); }
    q2 = wave_sum(q2); const float rs = rsqrtf(q2 * (1.0f / 2048.0f) + LN_EPS);
#pragma unroll
    for (int g = 0; g < 4; ++g) { const int c0 = g * 512 + lane * 8; float r[8];
#pragma unroll
      for (int h = 0; h < 2; ++h) { const float4 sh = *(const float4*)(md + c0 + 4 * h), sc = *(const float4*)(md + 2048 + c0 + 4 * h);
        r[4 * h + 0] = (v[g][h].x - mu) * rs * (1.0f + sc.x) + sh.x; r[4 * h + 1] = (v[g][h].y - mu) * rs * (1.0f + sc.y) + sh.y;
        r[4 * h + 2] = (v[g][h].z - mu) * rs * (1.0f + sc.z) + sh.z; r[4 * h + 3] = (v[g][h].w - mu) * rs * (1.0f + sc.w) + sh.w; }
      u32x4 w; w.x = cvt_pk_bf16(r[0], r[1]); w.y = cvt_pk_bf16(r[2], r[3]); w.z = cvt_pk_bf16(r[4], r[5]); w.w = cvt_pk_bf16(r[6], r[7]);
      *(u32x4*)(U + (size_t)row * 2048 + c0) = w; }
  }
}

__device__ __forceinline__ void unpack8(const u32x4 w, float* f) { f[0] = bflo(w.x); f[1] = bfhi(w.x); f[2] = bflo(w.y); f[3] = bfhi(w.y); f[4] = bflo(w.z); f[5] = bfhi(w.z); f[6] = bflo(w.w); f[7] = bfhi(w.w); }
__device__ __forceinline__ u32x4 pack8(const float* r) { u32x4 w; w.x = cvt_pk_bf16(r[0], r[1]); w.y = cvt_pk_bf16(r[2], r[3]); w.z = cvt_pk_bf16(r[4], r[5]); w.w = cvt_pk_bf16(r[6], r[7]); return w; }
__device__ __forceinline__ u32x4 norm_rope_head(const u32x4 raw, const float* nw, const float2* rope, int j, int pos_r, int pos_c) {
  float x[8]; unpack8(raw, x); float ss = 0.f;
#pragma unroll
  for (int e = 0; e < 8; ++e) ss += x[e] * x[e];
  ss += __shfl_xor(ss, 1); ss += __shfl_xor(ss, 2); ss += __shfl_xor(ss, 4); ss += __shfl_xor(ss, 8);
  const float rs = rsqrtf(ss * (1.0f / 128.0f) + LN_EPS);
  const float4 w0 = *(const float4*)(nw + 8 * j), w1 = *(const float4*)(nw + 8 * j + 4);
  x[0] *= rs * w0.x; x[1] *= rs * w0.y; x[2] *= rs * w0.z; x[3] *= rs * w0.w; x[4] *= rs * w1.x; x[5] *= rs * w1.y; x[6] *= rs * w1.z; x[7] *= rs * w1.w;
  float o[8];
  const bool is_x1 = ((j >> 2) & 1) == 0; const int pos = (j < 8) ? pos_r : pos_c; const int fi = 8 * (j & 3);
#pragma unroll
  for (int e = 0; e < 8; ++e) { const float pv = __shfl_xor(x[e], 4);
    if (pos_r >= 0) { const float2 cs = rope[pos * 32 + fi + e]; o[e] = is_x1 ? (x[e] * cs.x - pv * cs.y) : (pv * cs.y + x[e] * cs.x); }
    else o[e] = x[e]; }
  return pack8(o);
}
__device__ void phase3_elem(const Params& p) {
  int tid_l = threadIdx.x; asm volatile("" : "+v"(tid_l)); const int tid = tid_l, wid = tid >> 6, lane = tid & 63;
  unsigned char* ws = p.ws;
  { const bf16_t* X = (const bf16_t*)(ws + OFF_QKPRE); bf16_t* Y = (bf16_t*)(ws + OFF_QAKA); const float* cw = p.in[8]; const float* cb = p.in[9];
    for (size_t idx = (size_t)blockIdx.x * 512 + tid; idx < (size_t)M_ALL * 256; idx += (size_t)gridDim.x * 512) {
      const int row = (int)(idx >> 8), c8 = (int)(idx & 255) * 8;
      bool first, last; if (row < M_TOK) { const int s = row & (SEQ - 1); first = s == 0; last = s == SEQ - 1; } else { const int t = (row - M_TOK) & (CTXL - 1); first = t == 0; last = t == CTXL - 1; }
      const u32x4 z = {0u, 0u, 0u, 0u};
      const u32x4 cu = *(const u32x4*)(X + (size_t)row * 2048 + c8);
      const u32x4 pr = first ? z : *(const u32x4*)(X + (size_t)(row - 1) * 2048 + c8);
      const u32x4 nx = last ? z : *(const u32x4*)(X + (size_t)(row + 1) * 2048 + c8);
      float a[8], b[8], c[8], r[8]; unpack8(pr, a); unpack8(cu, b); unpack8(nx, c);
      const float sc = c8 >= 1024 ? 0.08838834764831845f : 1.0f;
#pragma unroll
      for (int e = 0; e < 8; ++e) { const float y = cb[c8 + e] + a[e] * cw[c8 + e] + b[e] * cw[2048 + c8 + e] + c[e] * cw[4096 + c8 + e]; r[e] = siluf_(y) * sc; }
      *(u32x4*)(Y + (size_t)row * 2048 + c8) = pack8(r); } }
  const float2* rope = (const float2*)(ws + OFF_ROPE);
  const int j = lane & 15, hl = lane >> 4;
  { const bf16_t* X = (const bf16_t*)(ws + OFF_KBRAW); bf16_t* Y = (bf16_t*)(ws + OFF_KALL);
    for (int row = blockIdx.x * 8 + wid; row < M_ALL; row += gridDim.x * 8) {
      size_t drow; int pr = -1, pc = -1;
      if (row < M_TOK) { const int b = row >> 13, s = row & (SEQ - 1); drow = (size_t)b * SKV + CTXL + s; pr = s >> 6; pc = s & 63; }
      else { const int b = (row - M_TOK) >> 8, t = (row - M_TOK) & (CTXL - 1); drow = (size_t)b * SKV + t; }
      const u32x4 raw = *(const u32x4*)(X + (size_t)row * 512 + hl * 128 + j * 8);
      *(u32x4*)(Y + drow * 512 + hl * 128 + j * 8) = norm_rope_head(raw, p.in[12], rope, j, pr, pc); } }
  { bf16_t* X = (bf16_t*)(ws + OFF_QB);
    for (int it = blockIdx.x * 8 + wid; it < M_TOK * 4; it += gridDim.x * 8) {
      const int row = it >> 2, hd = (it & 3) * 4 + hl, s = row & (SEQ - 1);
      bf16_t* q = X + (size_t)row * 2048 + hd * 128 + j * 8;
      const u32x4 raw = *(const u32x4*)q;
      *(u32x4*)q = norm_rope_head(raw, p.in[11], rope, j, s >> 6, s & 63); } }
}

__device__ void phase5_gate(const Params& p) {
  int tid_l = threadIdx.x; asm volatile("" : "+v"(tid_l)); const int tid = tid_l, wid = tid >> 6, lane = tid & 63;
  const bf16_t* HF = (const bf16_t*)(p.ws + OFF_HF); const bf16_t* HB = (const bf16_t*)(p.ws + OFF_HB); bf16_t* OZ = (bf16_t*)(p.ws + OFF_OZ);
  const float* nw = p.in[10];
  const int j = lane & 31, hl = lane >> 5;
  for (int it = blockIdx.x * 8 + wid; it < M_TOK * 4; it += gridDim.x * 8) {
    const size_t off = (size_t)(it >> 2) * 2048 + ((it & 3) * 2 + hl) * 256 + j * 8;
    float a[8], b[8], g[8], r[8]; unpack8(*(const u32x4*)(HF + off), a); unpack8(*(const u32x4*)(HB + off), b); unpack8(*(const u32x4*)(OZ + off), g);
    float ss = 0.f;
#pragma unroll
    for (int e = 0; e < 8; ++e) { a[e] += b[e]; ss += a[e] * a[e]; }
    ss += __shfl_xor(ss, 1); ss += __shfl_xor(ss, 2); ss += __shfl_xor(ss, 4); ss += __shfl_xor(ss, 8); ss += __shfl_xor(ss, 16);
    const float rs = rsqrtf(ss * (1.0f / 256.0f) + LN_EPS);
    const float* w = nw + ((it & 3) * 2 + hl) * 256 + j * 8;
#pragma unroll
    for (int e = 0; e < 8; ++e) r[e] = a[e] * rs * w[e] * g[e];
    *(u32x4*)(OZ + off) = pack8(r);
  }
}

__device__ void phase8_final_ln(const Params& p) {
  int tid_l = threadIdx.x; asm volatile("" : "+v"(tid_l)); const int tid = tid_l, wid = tid >> 6, lane = tid & 63;
  const float* lw = p.in[16]; const float* lb = p.in[17];
  for (int row = blockIdx.x * 8 + wid; row < M_TOK; row += gridDim.x * 8) {
    float4* r = (float4*)(p.out + (size_t)row * 2048);
    float4 v[8]; float s = 0.f;
#pragma unroll
    for (int i = 0; i < 8; ++i) { v[i] = r[lane + 64 * i]; s += (v[i].x + v[i].y) + (v[i].z + v[i].w); }
    s = wave_sum(s); const float mu = s * (1.f / 2048.f); float q = 0.f;
#pragma unroll
    for (int i = 0; i < 8; ++i) { const float a = v[i].x - mu, b = v[i].y - mu, c = v[i].z - mu, d = v[i].w - mu; q += (a * a + b * b) + (c * c + d * d); }
    q = wave_sum(q); const float rs = rsqrtf(q * (1.f / 2048.f) + LN_EPS);
#pragma unroll
    for (int i = 0; i < 8; ++i) { const float4 w = ((const float4*)lw)[lane + 64 * i], b = ((const float4*)lb)[lane + 64 * i];
      float4 y; y.x = (v[i].x - mu) * rs * w.x + b.x; y.y = (v[i].y - mu) * rs * w.y + b.y; y.z = (v[i].z - mu) * rs * w.z + b.z; y.w = (v[i].w - mu) * rs * w.w + b.w;
      r[lane + 64 * i] = y; }
  }
}

namespace att {
constexpr int D = 128, NW = 8, QBLK = 32, KVBLK = 64;
constexpr float SCALE = 0.088388347648318440f;
constexpr float THR = 8.f;
constexpr int LDQ = 2048, LDK = 512;
constexpr size_t SHM_V = KVBLK * D * 2, SHM_K = KVBLK * D * 2, SHM_ATTN = 2 * SHM_V + 2 * SHM_K + NW * 64 * 4;
#define KSWZ(row, colB) ((row) * 256 + ((colB) ^ (((row) & 7) << 4)))
#define SBAR() __builtin_amdgcn_sched_barrier(0)
__device__ __forceinline__ int crow(int r, int hi) { return (r & 3) + 8 * (r >> 2) + 4 * hi; }
__device__ __forceinline__ unsigned cvtpk(float lo, float hi) { unsigned r; asm volatile("v_cvt_pk_bf16_f32 %0, %1, %2" : "=v"(r) : "v"(lo), "v"(hi)); return r; }
__device__ __forceinline__ void partialSM(f32x16& p0, f32x16& p1, float& m_reg, float& mn, float& alpha) {
  constexpr float C = SCALE * 1.4426950408889634f;
  float pmax = p0[0]; for (int r = 1; r < 16; ++r) pmax = fmaxf(pmax, p0[r]); for (int r = 0; r < 16; ++r) pmax = fmaxf(pmax, p1[r]);
  { auto rr = __builtin_amdgcn_permlane32_swap(__float_as_uint(pmax), __float_as_uint(pmax), false, false);
    pmax = fmaxf(__uint_as_float(rr[0]), __uint_as_float(rr[1])); }
  if (__builtin_expect(__all(pmax - m_reg <= THR / SCALE), 1)) { mn = m_reg; alpha = 1.f; }
  else { mn = fmaxf(m_reg, pmax); alpha = __builtin_amdgcn_exp2f((m_reg - mn) * C); m_reg = mn; }
  float mnC = -mn * C;
  for (int r = 0; r < 16; ++r) p0[r] = fmaf(p0[r], C, mnC); for (int r = 0; r < 16; ++r) p1[r] = fmaf(p1[r], C, mnC);
  for (int r = 0; r < 16; ++r) p0[r] = __builtin_amdgcn_exp2f(p0[r]);
}
__device__ __forceinline__ void finishSM(f32x16& p0, f32x16& p1, float alpha, float& l_reg, bf16x8& pa0, bf16x8& pa1, bf16x8& pa2, bf16x8& pa3) {
  for (int r = 0; r < 16; ++r) p1[r] = __builtin_amdgcn_exp2f(p1[r]);
  float ps = 0; for (int r = 0; r < 16; ++r) ps += p0[r]; for (int r = 0; r < 16; ++r) ps += p1[r];
  { auto rr = __builtin_amdgcn_permlane32_swap(__float_as_uint(ps), __float_as_uint(ps), false, false);
    ps = __uint_as_float(rr[0]) + __uint_as_float(rr[1]); }
  l_reg = l_reg * alpha + ps;
#define PK4(P, BASE, OUT) do { unsigned a0 = cvtpk(P[BASE + 0], P[BASE + 1]), a1 = cvtpk(P[BASE + 2], P[BASE + 3]);   \
    unsigned b0 = cvtpk(P[BASE + 4], P[BASE + 5]), b1 = cvtpk(P[BASE + 6], P[BASE + 7]);                              \
    auto r0 = __builtin_amdgcn_permlane32_swap(a0, b0, false, false); auto r1 = __builtin_amdgcn_permlane32_swap(a1, b1, false, false); \
    u32x4 w = {r0[0], r1[0], r0[1], r1[1]}; OUT = *reinterpret_cast<bf16x8*>(&w); } while (0)
  PK4(p0, 0, pa0); PK4(p0, 8, pa1); PK4(p1, 0, pa2); PK4(p1, 8, pa3);
#undef PK4
}
__device__ __forceinline__ void qkt(f32x16& p0, f32x16& p1, const char* Ks, const bf16x8* qr, int r32, int hi) {
  p0 = f32x16{}; p1 = f32x16{};
  for (int d0 = 0; d0 < 8; ++d0) { int cb = (d0 * 16 + hi * 8) * 2;
    bf16x8 b0 = *reinterpret_cast<const bf16x8*>(Ks + KSWZ(r32, cb));
    bf16x8 b1 = *reinterpret_cast<const bf16x8*>(Ks + KSWZ(32 + r32, cb));
    p0 = __builtin_amdgcn_mfma_f32_32x32x16_bf16(b0, qr[d0], p0, 0, 0, 0);
    p1 = __builtin_amdgcn_mfma_f32_32x32x16_bf16(b1, qr[d0], p1, 0, 0, 0); }
}
__device__ __forceinline__ int v_st(int k, int c) { const int kk = (k & ~0xC) | ((k & 4) << 1) | ((k & 8) >> 1); return ((kk >> 3) * 4 + (c >> 5)) * 512 + ((kk & 7) * 32 + (c & 31)) * 2; }
__device__ __forceinline__ int v_rd_base(int lane) { return ((lane & 3) << 3) | (((lane >> 2) & 3) << 6) | (((lane >> 4) & 1) << 5) | (((lane >> 5) & 1) << 8); }
constexpr int v_rd_off(int d0, int ks, int half) { return d0 * 512 + ks * 4096 + half * 2048; }
template <int OFF> __device__ __forceinline__ s16x4 tr_read(int vb) {
  s16x4 r; asm volatile("ds_read_b64_tr_b16 %0, %1 offset:%2" : "=&v"(r) : "v"(vb), "i"(OFF) : "memory"); return r;
}
#define PKLH(L, H) (bf16x8){L[0], L[1], L[2], L[3], H[0], H[1], H[2], H[3]}
template <int D0> __device__ __forceinline__ void pv_one(f32x16& od, int vb, bf16x8 pa0, bf16x8 pa1, bf16x8 pa2, bf16x8 pa3) {
  const s16x4 l0 = tr_read<v_rd_off(D0, 0, 0)>(vb), h0 = tr_read<v_rd_off(D0, 0, 1)>(vb), l1 = tr_read<v_rd_off(D0, 1, 0)>(vb), h1 = tr_read<v_rd_off(D0, 1, 1)>(vb);
  const s16x4 l2 = tr_read<v_rd_off(D0, 2, 0)>(vb), h2 = tr_read<v_rd_off(D0, 2, 1)>(vb), l3 = tr_read<v_rd_off(D0, 3, 0)>(vb), h3 = tr_read<v_rd_off(D0, 3, 1)>(vb);
  asm volatile("s_waitcnt lgkmcnt(0)" ::: "memory"); SBAR();
  od = __builtin_amdgcn_mfma_f32_32x32x16_bf16(pa0, PKLH(l0, h0), od, 0, 0, 0);
  od = __builtin_amdgcn_mfma_f32_32x32x16_bf16(pa1, PKLH(l1, h1), od, 0, 0, 0);
  od = __builtin_amdgcn_mfma_f32_32x32x16_bf16(pa2, PKLH(l2, h2), od, 0, 0, 0);
  od = __builtin_amdgcn_mfma_f32_32x32x16_bf16(pa3, PKLH(l3, h3), od, 0, 0, 0);
}
__device__ __forceinline__ void pv_d0(f32x16* o, int vb, bf16x8 pa0, bf16x8 pa1, bf16x8 pa2, bf16x8 pa3) {
  pv_one<0>(o[0], vb, pa0, pa1, pa2, pa3); pv_one<1>(o[1], vb, pa0, pa1, pa2, pa3); pv_one<2>(o[2], vb, pa0, pa1, pa2, pa3); pv_one<3>(o[3], vb, pa0, pa1, pa2, pa3);
}
__device__ __forceinline__ void attn_dense_body(bf16_t* __restrict__ Qb, const bf16_t* __restrict__ Kh, const bf16_t* __restrict__ Vh, int seq, char* lds) {
  int tid_l = threadIdx.x; asm volatile("" : "+v"(tid_l)); const int tid = tid_l, wid = tid >> 6, lane = tid & 63, r32 = lane & 31, hi = lane >> 5;
  char* V_lds = lds; char* K_lds = lds + 2 * SHM_V;
  float* wsf = (float*)(lds + 2 * SHM_V + 2 * SHM_K) + wid * 64; float* li_l = wsf; float* al_l = wsf + 32;
  float m_reg = -1e30f, l_reg = 0; f32x16 o[4] = {}; bf16x8 qr[8];
  const bf16_t* Qw = Qb + (long)(wid * QBLK + r32) * LDQ + hi * 8;
#pragma unroll
  for (int d0 = 0; d0 < 8; ++d0) qr[d0] = *reinterpret_cast<const bf16x8*>(Qw + d0 * 16);
  const int sr = tid >> 4, sc = (tid & 15) * 8, vst0 = v_st(sr, sc), vst1 = v_st(32 + sr, sc);
  const int vb0 = (int)(uintptr_t)V_lds + v_rd_base(lane);
  struct { bf16x8 vs0, vs1, ks0, ks1; } sr_[1];
#define SLOAD(i, k0) do { sr_[i].vs0 = *reinterpret_cast<const bf16x8*>(&Vh[(long)((k0) + sr) * LDK + sc]); sr_[i].vs1 = *reinterpret_cast<const bf16x8*>(&Vh[(long)((k0) + 32 + sr) * LDK + sc]); \
    sr_[i].ks0 = *reinterpret_cast<const bf16x8*>(&Kh[(long)((k0) + sr) * LDK + sc]); sr_[i].ks1 = *reinterpret_cast<const bf16x8*>(&Kh[(long)((k0) + 32 + sr) * LDK + sc]); } while (0)
#define SWRITE(b, i) do { *(bf16x8*)(V_lds + (b) * SHM_V + vst0) = sr_[i].vs0;          \
    *(bf16x8*)(V_lds + (b) * SHM_V + vst1) = sr_[i].vs1; int kc = sc * 2;               \
    *(bf16x8*)(K_lds + (b) * SHM_K + KSWZ(sr, kc)) = sr_[i].ks0;                       \
    *(bf16x8*)(K_lds + (b) * SHM_K + KSWZ(32 + sr, kc)) = sr_[i].ks1; } while (0)
#define SWAIT() asm volatile("s_waitcnt vmcnt(0)" ::: "memory")
#define RESC(a) do { if (__any((a) < 1.f)) { if (hi == 0) al_l[r32] = (a); asm volatile("s_waitcnt lgkmcnt(0)" ::: "memory"); \
    for (int d = 0; d < 4; ++d) for (int r = 0; r < 16; ++r) o[d][r] *= al_l[crow(r, hi)]; } } while (0)
  f32x16 pA0, pA1, pB0, pB1; float mnA, mnB, alA, alB; bf16x8 pa0, pa1, pa2, pa3; const int NT = seq / KVBLK;
  constexpr int SE = 0, SO = 0;
  SLOAD(SE, 0); asm volatile("s_waitcnt vmcnt(0)" ::: "memory"); SWRITE(0, SE); __syncthreads();
  qkt(pA0, pA1, K_lds, qr, r32, hi); partialSM(pA0, pA1, m_reg, mnA, alA);
  SLOAD(SO, KVBLK);
  SWAIT(); SWRITE(1, SO); __syncthreads();
  for (int j = 1; j + 1 < NT; j += 2) {
    SBAR(); qkt(pB0, pB1, K_lds + SHM_K, qr, r32, hi);
    finishSM(pA0, pA1, alA, l_reg, pa0, pa1, pa2, pa3); SBAR();
    SLOAD(SO, (j + 1) * KVBLK); SBAR();
    pv_d0(o, vb0, pa0, pa1, pa2, pa3); partialSM(pB0, pB1, m_reg, mnB, alB);
    __syncthreads(); SWAIT(); SWRITE(0, SE);
    RESC(alB); __syncthreads();
    SBAR(); qkt(pA0, pA1, K_lds, qr, r32, hi);
    finishSM(pB0, pB1, alB, l_reg, pa0, pa1, pa2, pa3); SBAR();
    SLOAD(SE, (j + 2) * KVBLK); SBAR();
    pv_d0(o, vb0 + (int)SHM_V, pa0, pa1, pa2, pa3); partialSM(pA0, pA1, m_reg, mnA, alA);
    __syncthreads(); SWAIT(); SWRITE(1, SO);
    RESC(alA); __syncthreads();
  }
  SBAR(); qkt(pB0, pB1, K_lds + SHM_K, qr, r32, hi);
  finishSM(pA0, pA1, alA, l_reg, pa0, pa1, pa2, pa3); SBAR();
  pv_d0(o, vb0, pa0, pa1, pa2, pa3); partialSM(pB0, pB1, m_reg, mnB, alB);
  __syncthreads(); RESC(alB);
  finishSM(pB0, pB1, alB, l_reg, pa0, pa1, pa2, pa3); SBAR();
  pv_d0(o, vb0 + (int)SHM_V, pa0, pa1, pa2, pa3);
  if (hi == 0) li_l[r32] = l_reg; asm volatile("s_waitcnt lgkmcnt(0)" ::: "memory");
  float rli[16];
#pragma unroll
  for (int r = 0; r < 16; ++r) rli[r] = __builtin_amdgcn_rcpf(li_l[crow(r, hi)]);
  bf16_t* qo = Qb + (long)(wid * QBLK + 4 * hi) * LDQ + r32; const bf16_t* zo = qo + (long)((OFF_ZB - OFF_QB) / 2);
  unsigned short zz[64];
#pragma unroll
  for (int r = 0; r < 16; ++r) { const int ro = ((r & 3) + 8 * (r >> 2)) * LDQ;
    zz[4 * r] = zo[ro]; zz[4 * r + 1] = zo[ro + 32]; zz[4 * r + 2] = zo[ro + 64]; zz[4 * r + 3] = zo[ro + 96]; }
  asm volatile("" ::: "memory");
#pragma unroll
  for (int r = 0; r < 16; ++r) { const int ro = ((r & 3) + 8 * (r >> 2)) * LDQ;
    const float v0 = o[0][r] * rli[r] * bf2f(zz[4 * r]), v1 = o[1][r] * rli[r] * bf2f(zz[4 * r + 1]), v2 = o[2][r] * rli[r] * bf2f(zz[4 * r + 2]), v3 = o[3][r] * rli[r] * bf2f(zz[4 * r + 3]);
    qo[ro] = (bf16_t)(cvtpk(v0, v0) & 0xffffu); qo[ro + 32] = (bf16_t)(cvtpk(v1, v1) & 0xffffu); qo[ro + 64] = (bf16_t)(cvtpk(v2, v2) & 0xffffu); qo[ro + 96] = (bf16_t)(cvtpk(v3, v3) & 0xffffu); }
#undef SLOAD
#undef SWRITE
#undef SWAIT
#undef RESC
}
}

namespace ml {
using att::crow; using att::cvtpk; using att::v_st; using att::v_rd_base; using att::v_rd_off; using att::tr_read;
constexpr int O_QS = 0, O_KS = 17408, O_C0 = 34816, O_KTR = 69632, O_VTR = 86016, O_VW = 102400, O_SP = 118784, O_F = 128000;
constexpr int NCH = 132;
template <int KS> __device__ __forceinline__ bf16x8 trfrag(int vb) {
  const s16x4 l = tr_read<v_rd_off(0, KS, 0)>(vb), h = tr_read<v_rd_off(0, KS, 1)>(vb);
  asm volatile("s_waitcnt lgkmcnt(0)" ::: "memory"); SBAR();
  return PKLH(l, h);
}
__device__ __forceinline__ bf16x8 scale_frag(bf16x8 v, const float* we) {
  const u32x4 w = *reinterpret_cast<const u32x4*>(&v); float f[8]; unpack8(w, f);
  const float4 s0 = *(const float4*)we, s1 = *(const float4*)(we + 4);
  f[0] *= s0.x; f[1] *= s0.y; f[2] *= s0.z; f[3] *= s0.w; f[4] *= s1.x; f[5] *= s1.y; f[6] *= s1.z; f[7] *= s1.w;
  const u32x4 o = pack8(f); return *reinterpret_cast<const bf16x8*>(&o);
}
__device__ __forceinline__ int chunk_row0(int c, int b, bool rev) {
  if (!rev) return c < 4 ? M_TOK + b * CTXL + 64 * c : b * SEQ + 64 * (c - 4);
  return c < 4 ? M_TOK + b * CTXL + 64 * (3 - c) : b * SEQ + 64 * (131 - c);
}
__device__ __forceinline__ void gate_scan(float gi, float gf, float bi, float bfb, float& m0, float* S, int lane, int jn) {
  const float li = gi + bi, xf = gf + bfb; const float lf = fminf(xf, 0.f) - __logf(1.0f + __expf(-fabsf(xf)));
  float bb = lf;
#define DPP_F(x, old, ctrl, rmask, bc) __int_as_float(__builtin_amdgcn_update_dpp(__float_as_int(old), __float_as_int(x), ctrl, rmask, 0xf, bc))
  bb += DPP_F(bb, 0.f, 0x111, 0xf, true); bb += DPP_F(bb, 0.f, 0x112, 0xf, true); bb += DPP_F(bb, 0.f, 0x114, 0xf, true); bb += DPP_F(bb, 0.f, 0x118, 0xf, true);
  bb += DPP_F(bb, 0.f, 0x142, 0xa, true); bb += DPP_F(bb, 0.f, 0x143, 0xc, true);
  const float g = li - bb; float cm = g; const float NI = -3.0e38f;
  cm = fmaxf(cm, DPP_F(cm, NI, 0x111, 0xf, false)); cm = fmaxf(cm, DPP_F(cm, NI, 0x112, 0xf, false)); cm = fmaxf(cm, DPP_F(cm, NI, 0x114, 0xf, false)); cm = fmaxf(cm, DPP_F(cm, NI, 0x118, 0xf, false));
  cm = fmaxf(cm, DPP_F(cm, NI, 0x142, 0xa, false)); cm = fmaxf(cm, DPP_F(cm, NI, 0x143, 0xc, false));
#undef DPP_F
  const float Mx = fmaxf(m0, cm), m = bb + Mx, a = __expf(m0 - Mx), em = __expf(-m);
  const float bL = __int_as_float(__builtin_amdgcn_readlane(__float_as_int(bb), 63)), ML = __int_as_float(__builtin_amdgcn_readlane(__float_as_int(Mx), 63)), aend = __int_as_float(__builtin_amdgcn_readlane(__float_as_int(a), 63));
  S[jn] = g; S[64 + jn] = Mx; S[128 + jn] = a; S[192 + jn] = em; S[256 + jn] = __expf(g - ML); if (lane == 0) S[320] = aend;
  m0 = bL + ML;
}
__device__ void mlstm_scan(const Params& p, char* lds, int item) {
  int tid_l = threadIdx.x; asm volatile("" : "+v"(tid_l)); const int tid = tid_l, wid = __builtin_amdgcn_readfirstlane(tid >> 6), lane = tid & 63, r32 = lane & 31, hi = lane >> 5;
  const int dir = item & 1, vs = (item >> 1) & 1, bh = item >> 2, b = bh >> 3, h = bh & 7;
  const bool rev = dir != 0, flip = !rev;
  const bf16_t* QK = (const bf16_t*)(p.ws + OFF_QAKA); const bf16_t* VA = (const bf16_t*)(p.ws + OFF_VA); const float* GT = (const float*)(p.ws + OFF_GATES);
  bf16_t* H = (bf16_t*)(p.ws + (rev ? OFF_HB : OFF_HF));
  float* F = (float*)(lds + O_F); float *NQ = F + 768, *RS = F + 832, *N0 = F + 960, *GSL = F + 1088, *PN = F + 1216;
  for (int i = tid; i < 128 * 272 / 4; i += 512) ((unsigned*)(lds + O_C0))[i] = 0u;
  if (tid < 128) N0[tid] = 0.f;
  f32x16 cacc0 = {}, cacc1 = {}; f32x16 acc1 = {}; float nreg = 0.f, m0 = -1e30f, aend_prev = 0.f; bool npend = false;
  const float bi = p.in[7][dir * 16 + h], bfb = p.in[7][dir * 16 + 8 + h];
  const int qrow0 = tid >> 4, qc = (tid & 15) * 8;
  const int jnat = 63 - lane, jg = flip ? lane : jnat;
  bf16x8 q0, q1, k0, k1, v0, v1; float gi1 = 0.f, gf1 = 0.f;
  u32x2 hw0 = {0u, 0u}, hw1 = {0u, 0u}, hw2 = {0u, 0u}, hw3 = {0u, 0u}; bf16_t* hpend = nullptr;
  { const int R0 = chunk_row0(0, b, rev); const bf16_t* qp = QK + (size_t)(R0 + qrow0) * 2048 + h * 128 + qc; const bf16_t* vp = VA + (size_t)(R0 + qrow0) * 2048 + h * 256 + vs * 128 + qc;
    q0 = *(const bf16x8*)qp; q1 = *(const bf16x8*)(qp + 32 * 2048); k0 = *(const bf16x8*)(qp + 1024); k1 = *(const bf16x8*)(qp + 1024 + 32 * 2048);
    v0 = *(const bf16x8*)vp; v1 = *(const bf16x8*)(vp + 32 * 2048);
    if (wid == 0) { const float g0i = GT[(size_t)(R0 + jg) * 32 + dir * 16 + h], g0f = GT[(size_t)(R0 + jg) * 32 + dir * 16 + 8 + h];
      const int R1 = chunk_row0(1, b, rev); gi1 = GT[(size_t)(R1 + jg) * 32 + dir * 16 + h]; gf1 = GT[(size_t)(R1 + jg) * 32 + dir * 16 + 8 + h];
      gate_scan(g0i, g0f, bi, bfb, m0, F, lane, jnat); } }
  const int w4 = wid & 3, t_hi = w4 >> 1, t_lo = w4 & 1;
  const int vt = wid >> 1, jt = wid & 1;
  for (int c = 0; c < NCH; ++c) {
    const int R0 = chunk_row0(c, b, rev); const bool isctx = c < 4;
    float* S = F + (c & 1) * 384; float *G = S, *MX = S + 64, *A = S + 128, *EM = S + 192, *WE = S + 256;
    __syncthreads();
    { const int ra = flip ? 63 - qrow0 : qrow0, rb = flip ? 31 - qrow0 : qrow0 + 32;
    *(bf16x8*)(lds + O_QS + ra * 272 + qc * 2) = q0; *(bf16x8*)(lds + O_QS + rb * 272 + qc * 2) = q1;
    *(bf16x8*)(lds + O_KS + ra * 272 + qc * 2) = k0; *(bf16x8*)(lds + O_KS + rb * 272 + qc * 2) = k1;
    *(bf16x8*)(lds + O_KTR + v_st(ra, qc)) = k0; *(bf16x8*)(lds + O_KTR + v_st(rb, qc)) = k1;
    *(bf16x8*)(lds + O_VTR + v_st(ra, qc)) = v0; *(bf16x8*)(lds + O_VTR + v_st(rb, qc)) = v1;
    { const float wa = WE[ra], wb = WE[rb]; float f[8];
      unpack8(*reinterpret_cast<const u32x4*>(&v0), f);
#pragma unroll
      for (int e = 0; e < 8; ++e) f[e] *= wa;
      *(u32x4*)(lds + O_VW + v_st(ra, qc)) = pack8(f);
      unpack8(*reinterpret_cast<const u32x4*>(&v1), f);
#pragma unroll
      for (int e = 0; e < 8; ++e) f[e] *= wb;
      *(u32x4*)(lds + O_VW + v_st(rb, qc)) = pack8(f); } }
    if (hpend) { *(u32x2*)(hpend) = hw0; *(u32x2*)(hpend + 8) = hw1; *(u32x2*)(hpend + 16) = hw2; *(u32x2*)(hpend + 24) = hw3; hpend = nullptr; }
    if (npend && tid < 128) { nreg = aend_prev * nreg + ((PN[tid] + PN[128 + tid]) + (PN[256 + tid] + PN[384 + tid])); N0[tid] = nreg; }
    npend = true;
    if (wid == 0) { GSL[lane] = gi1; GSL[64 + lane] = gf1;
      if (c + 2 < NCH) { const int R2 = chunk_row0(c + 2, b, rev); gi1 = GT[(size_t)(R2 + jg) * 32 + dir * 16 + h]; gf1 = GT[(size_t)(R2 + jg) * 32 + dir * 16 + 8 + h]; } }
    if (c + 1 < NCH) { const int R1 = chunk_row0(c + 1, b, rev); const bf16_t* qp = QK + (size_t)(R1 + qrow0) * 2048 + h * 128 + qc; const bf16_t* vp = VA + (size_t)(R1 + qrow0) * 2048 + h * 256 + vs * 128 + qc;
      q0 = *(const bf16x8*)qp; q1 = *(const bf16x8*)(qp + 32 * 2048); k0 = *(const bf16x8*)(qp + 1024); k1 = *(const bf16x8*)(qp + 1024 + 32 * 2048);
      v0 = *(const bf16x8*)vp; v1 = *(const bf16x8*)(vp + 32 * 2048); }
    __syncthreads();
    if (wid < 4) {
      f32x16 pS = {};
      const char* ka = lds + O_KS + (32 * t_hi + r32) * 272 + hi * 16; const char* qb = lds + O_QS + (32 * t_lo + r32) * 272 + hi * 16;
#pragma unroll
      for (int d0 = 0; d0 < 8; ++d0) pS = __builtin_amdgcn_mfma_f32_32x32x16_bf16(*(const bf16x8*)(ka + d0 * 32), *(const bf16x8*)(qb + d0 * 32), pS, 0, 0, 0);
      const int j = 32 * t_lo + r32; const float mxj = MX[j]; float ps = 0.f;
#pragma unroll
      for (int r = 0; r < 16; ++r) { const int s = 32 * t_hi + crow(r, hi); const bool ok = (s >= j);
        const float arg = ok ? (G[s] - mxj) : -1e30f; const float wv = __builtin_amdgcn_exp2f(arg * 1.4426950408889634f); pS[r] *= wv; ps += pS[r]; }
      ps += __shfl_xor(ps, 32); if (hi == 0) RS[t_hi * 64 + j] = ps;
#pragma unroll
      for (int g4 = 0; g4 < 4; ++g4) { u32x2 w; w.x = cvtpk(pS[4 * g4], pS[4 * g4 + 1]); w.y = cvtpk(pS[4 * g4 + 2], pS[4 * g4 + 3]);
        *(u32x2*)(lds + O_SP + j * 144 + (32 * t_hi + 8 * g4 + 4 * hi) * 2) = w; }
    } else {
      const int t4 = tid - 256, jq = t4 >> 2, part = t4 & 3; float sum = 0.f;
      const char* qrow = lds + O_QS + jq * 272 + part * 64;
#pragma unroll
      for (int i = 0; i < 4; ++i) { float f[8]; unpack8(*(const u32x4*)(qrow + 16 * i), f);
#pragma unroll
        for (int e = 0; e < 8; ++e) sum += f[e] * N0[part * 32 + 8 * i + e]; }
      sum += __shfl_xor(sum, 1); sum += __shfl_xor(sum, 2); if (part == 0) NQ[jq] = sum;
    }
    { acc1 = f32x16{};
      const char* ca = lds + O_C0 + (32 * vt + r32) * 272 + hi * 16; const char* qb = lds + O_QS + (32 * jt + r32) * 272 + hi * 16;
#pragma unroll
      for (int d0 = 0; d0 < 8; ++d0) acc1 = __builtin_amdgcn_mfma_f32_32x32x16_bf16(*(const bf16x8*)(ca + d0 * 32), *(const bf16x8*)(qb + d0 * 32), acc1, 0, 0, 0); }
    __syncthreads();
    const float aend = S[320];
    if (wid == 0 && c + 1 < NCH) gate_scan(GSL[lane], GSL[64 + lane], bi, bfb, m0, F + ((c + 1) & 1) * 384, lane, jnat);
    {
      f32x16 acc2 = {};
      const int vbv = (int)(uintptr_t)(lds + O_VTR) + v_rd_base(lane) + vt * 512;
      const char* sb = lds + O_SP + (32 * jt + r32) * 144 + hi * 16;
      const s16x4 l0 = tr_read<v_rd_off(0, 0, 0)>(vbv), h0 = tr_read<v_rd_off(0, 0, 1)>(vbv), l1 = tr_read<v_rd_off(0, 1, 0)>(vbv), h1 = tr_read<v_rd_off(0, 1, 1)>(vbv);
      const s16x4 l2 = tr_read<v_rd_off(0, 2, 0)>(vbv), h2 = tr_read<v_rd_off(0, 2, 1)>(vbv), l3 = tr_read<v_rd_off(0, 3, 0)>(vbv), h3 = tr_read<v_rd_off(0, 3, 1)>(vbv);
      const bf16x8 s0 = *(const bf16x8*)(sb), s1 = *(const bf16x8*)(sb + 32), s2 = *(const bf16x8*)(sb + 64), s3 = *(const bf16x8*)(sb + 96);
      asm volatile("s_waitcnt lgkmcnt(0)" ::: "memory"); SBAR();
      acc2 = __builtin_amdgcn_mfma_f32_32x32x16_bf16(PKLH(l0, h0), s0, acc2, 0, 0, 0);
      acc2 = __builtin_amdgcn_mfma_f32_32x32x16_bf16(PKLH(l1, h1), s1, acc2, 0, 0, 0);
      acc2 = __builtin_amdgcn_mfma_f32_32x32x16_bf16(PKLH(l2, h2), s2, acc2, 0, 0, 0);
      acc2 = __builtin_amdgcn_mfma_f32_32x32x16_bf16(PKLH(l3, h3), s3, acc2, 0, 0, 0);
      const int j = 32 * jt + r32; const float aj = A[j]; const float den = aj * NQ[j] + RS[j] + RS[64 + j];
      const float inv = 1.0f / fmaxf(fabsf(den), EM[j]);
      if (!isctx) { hpend = H + (size_t)(R0 + (flip ? 63 - j : j)) * 2048 + h * 256 + vs * 128 + 32 * vt + 4 * hi;
#define HPK(g4) (u32x2){cvtpk((aj * acc1[4 * g4] + acc2[4 * g4]) * inv, (aj * acc1[4 * g4 + 1] + acc2[4 * g4 + 1]) * inv), cvtpk((aj * acc1[4 * g4 + 2] + acc2[4 * g4 + 2]) * inv, (aj * acc1[4 * g4 + 3] + acc2[4 * g4 + 3]) * inv)}
        hw0 = HPK(0); hw1 = HPK(1); hw2 = HPK(2); hw3 = HPK(3);
#undef HPK
      }
    }
    { const int d = tid & 127, q4 = tid >> 7; float s = 0.f;
#pragma unroll
      for (int si = 0; si < 16; ++si) s += WE[16 * q4 + si] * bf2f(*(const bf16_t*)(lds + O_KS + (16 * q4 + si) * 272 + d * 2));
      PN[q4 * 128 + d] = s; }
    aend_prev = aend;
    { const int dt = wid & 3, vp2 = (wid >> 2) * 2;
      const int kb = (int)(uintptr_t)(lds + O_KTR) + v_rd_base(lane) + dt * 512;
      const int vb2 = (int)(uintptr_t)(lds + O_VW) + v_rd_base(lane) + vp2 * 512;
      const s16x4 kl0 = tr_read<v_rd_off(0, 0, 0)>(kb), kh0 = tr_read<v_rd_off(0, 0, 1)>(kb), kl1 = tr_read<v_rd_off(0, 1, 0)>(kb), kh1 = tr_read<v_rd_off(0, 1, 1)>(kb);
      const s16x4 kl2 = tr_read<v_rd_off(0, 2, 0)>(kb), kh2 = tr_read<v_rd_off(0, 2, 1)>(kb), kl3 = tr_read<v_rd_off(0, 3, 0)>(kb), kh3 = tr_read<v_rd_off(0, 3, 1)>(kb);
      const s16x4 vl0 = tr_read<v_rd_off(0, 0, 0)>(vb2), vh0 = tr_read<v_rd_off(0, 0, 1)>(vb2), vl1 = tr_read<v_rd_off(0, 1, 0)>(vb2), vh1 = tr_read<v_rd_off(0, 1, 1)>(vb2);
      const s16x4 vl2 = tr_read<v_rd_off(0, 2, 0)>(vb2), vh2 = tr_read<v_rd_off(0, 2, 1)>(vb2), vl3 = tr_read<v_rd_off(0, 3, 0)>(vb2), vh3 = tr_read<v_rd_off(0, 3, 1)>(vb2);
      const s16x4 wl0 = tr_read<v_rd_off(1, 0, 0)>(vb2), wh0 = tr_read<v_rd_off(1, 0, 1)>(vb2), wl1 = tr_read<v_rd_off(1, 1, 0)>(vb2), wh1 = tr_read<v_rd_off(1, 1, 1)>(vb2);
      const s16x4 wl2 = tr_read<v_rd_off(1, 2, 0)>(vb2), wh2 = tr_read<v_rd_off(1, 2, 1)>(vb2), wl3 = tr_read<v_rd_off(1, 3, 0)>(vb2), wh3 = tr_read<v_rd_off(1, 3, 1)>(vb2);
      asm volatile("s_waitcnt lgkmcnt(0)" ::: "memory"); SBAR();
#pragma unroll
      for (int r = 0; r < 16; ++r) { cacc0[r] *= aend; cacc1[r] *= aend; }
      const bf16x8 ka0 = PKLH(kl0, kh0), ka1 = PKLH(kl1, kh1), ka2 = PKLH(kl2, kh2), ka3 = PKLH(kl3, kh3);
      cacc0 = __builtin_amdgcn_mfma_f32_32x32x16_bf16(ka0, PKLH(vl0, vh0), cacc0, 0, 0, 0);
      cacc1 = __builtin_amdgcn_mfma_f32_32x32x16_bf16(ka0, PKLH(wl0, wh0), cacc1, 0, 0, 0);
      cacc0 = __builtin_amdgcn_mfma_f32_32x32x16_bf16(ka1, PKLH(vl1, vh1), cacc0, 0, 0, 0);
      cacc1 = __builtin_amdgcn_mfma_f32_32x32x16_bf16(ka1, PKLH(wl1, wh1), cacc1, 0, 0, 0);
      cacc0 = __builtin_amdgcn_mfma_f32_32x32x16_bf16(ka2, PKLH(vl2, vh2), cacc0, 0, 0, 0);
      cacc1 = __builtin_amdgcn_mfma_f32_32x32x16_bf16(ka2, PKLH(wl2, wh2), cacc1, 0, 0, 0);
      cacc0 = __builtin_amdgcn_mfma_f32_32x32x16_bf16(ka3, PKLH(vl3, vh3), cacc0, 0, 0, 0);
      cacc1 = __builtin_amdgcn_mfma_f32_32x32x16_bf16(ka3, PKLH(wl3, wh3), cacc1, 0, 0, 0);
#pragma unroll
      for (int g4 = 0; g4 < 4; ++g4) { u32x2 w; w.x = cvtpk(cacc0[4 * g4], cacc0[4 * g4 + 1]); w.y = cvtpk(cacc0[4 * g4 + 2], cacc0[4 * g4 + 3]);
        *(u32x2*)(lds + O_C0 + (32 * vp2 + r32) * 272 + (32 * dt + 8 * g4 + 4 * hi) * 2) = w;
        u32x2 x; x.x = cvtpk(cacc1[4 * g4], cacc1[4 * g4 + 1]); x.y = cvtpk(cacc1[4 * g4 + 2], cacc1[4 * g4 + 3]);
        *(u32x2*)(lds + O_C0 + (32 * vp2 + 32 + r32) * 272 + (32 * dt + 8 * g4 + 4 * hi) * 2) = x; }
    }
  }
  if (hpend) { *(u32x2*)(hpend) = hw0; *(u32x2*)(hpend + 8) = hw1; *(u32x2*)(hpend + 16) = hw2; *(u32x2*)(hpend + 24) = hw3; }
  __syncthreads();
}
}

__device__ void phase4_mixers(const Params& p, char* lds) {
  bf16_t* QB = (bf16_t*)(p.ws + OFF_QB);
  const bf16_t* KA = (const bf16_t*)(p.ws + OFF_KALL); const bf16_t* VAl = (const bf16_t*)(p.ws + OFF_VALL);
  const bool sched = gridDim.x == 256; const int bx = blockIdx.x;
  for (int item = bx; item < 128; item += gridDim.x) ml::mlstm_scan(p, lds, item);
  const int nslots = sched ? 9 : (2048 + (int)gridDim.x - 1) / (int)gridDim.x;
  for (int sl = (sched && bx < 128) ? 2 : 0; sl < nslots; ++sl) {
    int i;
    if (sched) i = sl < 2 ? sl * 128 + (bx - 128) : 256 + (sl - 2) * 256 + (bx < 128 ? 128 + bx : bx - 128);
    else { i = sl * (int)gridDim.x + bx; if (i >= 2048) break; }
    const int g = i >> 7, b = g >> 2, kvh = g & 3, hq = kvh * 4 + ((i >> 5) & 3), qb = i & 31;
    const size_t qoff = (size_t)(b * SEQ + qb * 256) * 2048 + hq * 128, koff = (size_t)b * SKV * 512 + kvh * 128;
    att::attn_dense_body(QB + qoff, KA + koff, VAl + koff, SKV, lds);
    __syncthreads();
  }
}

#define GRID_SYNC() do { asm volatile("s_waitcnt vmcnt(0) lgkmcnt(0)" ::: "memory"); grid.sync(); } while (0)
__global__ void __launch_bounds__(512, 2) fwd_megakernel(Params p) {
  extern __shared__ __attribute__((aligned(16))) unsigned char lds[];
  cg::grid_group grid = cg::this_grid();
  unsigned char* ws = p.ws;
  PG8_LAS unsigned char* lds3 = (PG8_LAS unsigned char*)lds;
  phase0_prep(p, lds);
  GRID_SYNC();
  phase1_ln_mod(p);
  GRID_SYNC();
  { pg8::Gemm g{(const bf16_t*)(ws + OFF_U), (const bf16_t*)(ws + OFF_WT_IN), M_ALL, N1P, 2048}; InProjOrder S; S.init((int)gridDim.x, (int)blockIdx.x);
    Epi1 E{ws, (unsigned char*)p.out}; pg8::gemm_phase<Epi1, InProjOrder>(lds3, g, S, E); }
  GRID_SYNC();
  phase3_elem(p);
  GRID_SYNC();
  phase4_mixers(p, (char*)lds);
  GRID_SYNC();
  phase5_gate(p);
  GRID_SYNC();
  { pg8::Gemm g{(const bf16_t*)(ws + OFF_OZ), (const bf16_t*)(ws + OFF_WT_BA), M_TOK, 2048, 2048}; pg8::StaticOrder S; S.init(M_TOK, 2048, (int)gridDim.x, (int)blockIdx.x);
    Epi2a E{(bf16_t*)(ws + OFF_TMP), (const bf16_t*)p.out}; pg8::gemm_phase<Epi2a, pg8::StaticOrder>(lds3, g, S, E); }
  __syncthreads();
  { pg8::Gemm g{(const bf16_t*)(ws + OFF_QB), (const bf16_t*)(ws + OFF_WT_BB), M_TOK, 2048, 2048}; pg8::StaticOrder S; S.init(M_TOK, 2048, (int)gridDim.x, (int)blockIdx.x);
    Epi2b E{(const bf16_t*)(ws + OFF_TMP), (const bf16_t*)p.out + (size_t)M_TOK * 2048, (bf16_t*)(ws + OFF_MERGED)}; pg8::gemm_phase<Epi2b, pg8::StaticOrder>(lds3, g, S, E); }
  GRID_SYNC();
  { pg8::Gemm g{(const bf16_t*)(ws + OFF_MERGED), (const bf16_t*)(ws + OFF_WT_OUT), M_TOK, 2048, 2048}; pg8::StaticOrder S; S.init(M_TOK, 2048, (int)gridDim.x, (int)blockIdx.x);
    Epi3 E{p.in[0], (const float*)(ws + OFF_MOD), p.out}; pg8::gemm_phase<Epi3, pg8::StaticOrder>(lds3, g, S, E); }
  GRID_SYNC();
  phase8_final_ln(p);
}

extern "C" void kernel_launch(void* const* d_in, const int* in_sizes, int n_in, void* d_out, int out_size, void* d_ws, size_t ws_size, hipStream_t stream) {
  static int grid_blocks = 0;
  if (!grid_blocks) {
    if (n_in != 18 || out_size != M_TOK * DM || ws_size < WS_END) { fprintf(stderr, "kernel_launch: unexpected shapes (n_in %d out %d ws %zu need %zu)\n", n_in, out_size, ws_size, (size_t)WS_END); grid_blocks = -1; return; }
    int dev = 0, cus = 0, per_cu = 0;
    (void)hipGetDevice(&dev);
    (void)hipDeviceGetAttribute(&cus, hipDeviceAttributeMultiprocessorCount, dev);
    (void)hipFuncSetAttribute((const void*)fwd_megakernel, hipFuncAttributeMaxDynamicSharedMemorySize, LDS_BYTES);
    (void)hipOccupancyMaxActiveBlocksPerMultiprocessor(&per_cu, fwd_megakernel, 512, LDS_BYTES);
    if (per_cu < 1) per_cu = 1;
    grid_blocks = cus * per_cu;
  }
  if (grid_blocks < 0) return;
  Params p{};
  for (int i = 0; i < 18; ++i) p.in[i] = (const float*)d_in[i];
  p.out = (float*)d_out; p.ws = (unsigned char*)d_ws;
  void* args[] = {&p};
  hipError_t e = hipLaunchCooperativeKernel((void*)fwd_megakernel, dim3(grid_blocks), dim3(512), args, LDS_BYTES, stream);
  if (e != hipSuccess) fprintf(stderr, "cooperative launch failed: %s (grid %d)\n", hipGetErrorString(e), grid_blocks);
}
```

```cpp
#include <hip/hip_runtime.h>
#include <hip/hip_cooperative_groups.h>
#include <cstdio>
#include <cstdint>
namespace cg = cooperative_groups;

constexpr int DM = 2048, NB = 4, SEQ = 8192, CTXL = 256;
constexpr int M_TOK = NB * SEQ, M_CTX = NB * CTXL, M_ALL = M_TOK + M_CTX;
constexpr int SKV = CTXL + SEQ;
constexpr int N_IN = 17440, N1P = 17664;
constexpr float LN_EPS = 1e-6f;
constexpr float ALPHA_DN = 1.189207115002721f;
constexpr int LDS_BYTES = 132 * 1024;

constexpr size_t SZ_W2 = (size_t)2048 * 2048 * 2;
constexpr size_t SZ_ALL = (size_t)M_ALL * 2048 * 2;
constexpr size_t SZ_TOK = (size_t)M_TOK * 2048 * 2;
constexpr size_t SZ_KV = (size_t)NB * SKV * 512 * 2;
constexpr size_t OFF_WT_BA = 0, OFF_WT_BB = SZ_W2, OFF_WT_OUT = 2 * SZ_W2;
constexpr size_t OFF_MOD = 3 * SZ_W2;
constexpr size_t OFF_ROPE = OFF_MOD + 131072;
constexpr size_t OFF_U = OFF_ROPE + 32768;
constexpr size_t OFF_QAKA = OFF_U;
constexpr size_t OFF_QKPRE = OFF_U + SZ_ALL;
constexpr size_t OFF_HF = OFF_QKPRE, OFF_MERGED = OFF_QKPRE;
constexpr size_t OFF_OZ = OFF_QKPRE + SZ_ALL;
constexpr size_t OFF_QB = OFF_OZ + SZ_TOK;
constexpr size_t OFF_ZB = OFF_QB + SZ_TOK;
constexpr size_t OFF_TMP = OFF_ZB;
constexpr size_t OFF_VA = OFF_ZB + SZ_TOK;
constexpr size_t OFF_VALL = OFF_VA + SZ_ALL;
constexpr size_t OFF_KALL = OFF_VALL + SZ_KV;
constexpr size_t OFF_GATES = OFF_KALL + SZ_KV;
constexpr size_t OFF_KBRAW = OFF_GATES + (size_t)M_ALL * 32 * 4;
constexpr size_t OFF_HB = OFF_KBRAW;
constexpr size_t OFF_WT_IN = OFF_KBRAW + SZ_KV;
constexpr size_t WS_END = OFF_HB + SZ_TOK;
static_assert(OFF_WT_IN + (size_t)N1P * 2048 * 2 <= WS_END, "ws map");
static_assert(OFF_TMP + (size_t)M_TOK * 2048 * 4 <= OFF_VALL, "tmp map");
static_assert(OFF_U % 256 == 0 && OFF_GATES % 256 == 0 && OFF_KBRAW % 256 == 0, "align");

typedef unsigned short bf16_t;
using f32x16 = __attribute__((ext_vector_type(16))) float;
using s16x4 = __attribute__((ext_vector_type(4))) short;
using u32x2 = __attribute__((ext_vector_type(2))) unsigned;

struct Params { const float* in[18]; float* out; unsigned char* ws; };

__device__ __forceinline__ float wave_sum(float v) {
#pragma unroll
  for (int o = 32; o >= 1; o >>= 1) v += __shfl_xor(v, o);
  return v;
}
__device__ __forceinline__ float bf2f(unsigned short b) { return __uint_as_float(((unsigned)b) << 16); }
__device__ __forceinline__ float bflo(unsigned w) { return __uint_as_float(w << 16); }
__device__ __forceinline__ float bfhi(unsigned w) { return __uint_as_float(w & 0xffff0000u); }
__device__ __forceinline__ float sigmoidf_(float x) { return __builtin_amdgcn_rcpf(1.0f + __expf(-x)); }
__device__ __forceinline__ float siluf_(float x) { return x * __builtin_amdgcn_rcpf(1.0f + __expf(-x)); }
namespace pg8 {
#define PG8_LAS __attribute__((address_space(3)))
typedef unsigned short bf16_t;
typedef short bf16x8 __attribute__((ext_vector_type(8)));
typedef float f32x4 __attribute__((ext_vector_type(4)));
typedef unsigned u32x4 __attribute__((ext_vector_type(4)));
constexpr int BM = 256, BK = 64, HALF = 128, HTB = HALF * BK * 2  , STAGE_BYTES = 8 * HTB, NXCD = 8, WGM = 8;

__host__ __device__ __forceinline__ int lds_byte(int r, int c) { const int st = (r >> 4) * 2 + (c >> 5), rr = r & 15, cc = c & 31, ob = rr * 64 + cc * 2; return st * 1024 + (ob ^ (((ob >> 9) & 1) << 5)); }
__host__ __device__ __forceinline__ void stage_rc(int b, int& R, int& C) { const int st = b / 1024, sb = b % 1024, swz = sb ^ (((sb >> 9) & 1) << 5); R = (st >> 1) * 16 + swz / 64; C = (st & 1) * 32 + (swz % 64) / 2; }
__host__ __device__ __forceinline__ int perm32(int rho) { const int n = rho >> 4, i = rho & 15; return 8 * (i >> 2) + 4 * n + (i & 3); }

struct Unit { int pm, pn; };
struct Gemm { const bf16_t* A; const bf16_t* Bt; int M, N, K; };

struct StaticOrder {
    int nM, nN, nwg, G, c;
    __host__ __device__ void init(int M, int N, int G_, int c_) { nM = M / BM; nN = N / BM; nwg = nM * nN; G = G_; c = c_; }
    __host__ __device__ bool next(int i, Unit& u) const {
        const long L = (long)i * G + c; if (L >= nwg) return false;
        int wgid = (int)L; { const int q = nwg / NXCD, r = nwg % NXCD, xcd = wgid % NXCD, off = wgid / NXCD; wgid = (xcd < r ? xcd * (q + 1) : r * (q + 1) + (xcd - r) * q) + off; }
        const int nig = WGM * nN, gid = wgid / nig, fm = gid * WGM, gsz = (nM - fm) < WGM ? (nM - fm) : WGM;
        u.pm = fm + ((wgid % nig) % gsz); u.pn = (wgid % nig) / gsz; return true;
    }
    __device__ __forceinline__ void a_ready(const Unit&) const {}
    __device__ __forceinline__ void done(const Unit&) const {}
};
__device__ __forceinline__ unsigned cvt_pk_bf16(float lo, float hi) { unsigned r; asm volatile("v_cvt_pk_bf16_f32 %0, %1, %2" : "=v"(r) : "v"(lo), "v"(hi)); return r; }
template <class Epi, class Sched>
__device__ __forceinline__ void gemm_phase(PG8_LAS unsigned char* lds, const Gemm g, const Sched& S, const Epi& E) {
    int tid_l = threadIdx.x; asm volatile("" : "+v"(tid_l)); const int tid = tid_l, wid = __builtin_amdgcn_readfirstlane(tid >> 6), lane = tid & 63, wr = wid >> 2, wc = wid & 3, fr = lane & 15, fq = lane >> 4;
    const int K = g.K, nt = K / BK;
    unsigned voffA[2], voffB[2];
#pragma unroll
    for (int i = 0; i < 2; ++i) { int R, C; stage_rc(tid * 16 + i * 8192, R, C); const int Rb = Epi::PERM ? ((R & ~31) + perm32(R & 31)) : R;
        voffA[i] = (unsigned)(R * K + C) * 2u; voffB[i] = (unsigned)(Rb * K + C) * 2u; }
    const size_t kstep = (size_t)(BK * 2);
    const size_t hstep = (size_t)HALF * K * 2;
    const size_t tstep = 2 * hstep;
    const unsigned ldsw = (unsigned)wid * 1024u;
    const int aoff = lds_byte(wr * 64 + fr, fq * 8), boff = lds_byte(wc * 32 + fr, fq * 8);
#define PG8_SA(b, h) (((b) * 2 + (h)) * HTB)
#define PG8_SB(b, h) ((4 + (b) * 2 + (h)) * HTB)
#define PG8_STAGE(bufoff, gbase, voff) do { _Pragma("unroll") for (int _i = 0; _i < 2; ++_i) \
        __builtin_amdgcn_global_load_lds((const unsigned*)((const char*)(gbase) + (voff)[_i]), (PG8_LAS unsigned*)(lds + (bufoff) + ldsw + _i * 8192), 16, 0, 0); } while (0)
#define PG8_LDA(dst, b, h) do { _Pragma("unroll") for (int m = 0; m < 4; ++m) _Pragma("unroll") for (int k = 0; k < 2; ++k) dst[m][k] = *(const PG8_LAS bf16x8*)(lds + PG8_SA(b, h) + aoff + m * 2048 + k * 1024); } while (0)
#define PG8_LDB(dst, b, h) do { _Pragma("unroll") for (int n = 0; n < 2; ++n) _Pragma("unroll") for (int k = 0; k < 2; ++k) dst[n][k] = *(const PG8_LAS bf16x8*)(lds + PG8_SB(b, h) + boff + n * 2048 + k * 1024); } while (0)
#define PG8_MMA(ai, bj, At, Bt) do { __builtin_amdgcn_s_setprio(1); _Pragma("unroll") for (int m = 0; m < 4; ++m) _Pragma("unroll") for (int n = 0; n < 2; ++n) _Pragma("unroll") for (int k = 0; k < 2; ++k) \
        acc[ai][bj][m][n] = __builtin_amdgcn_mfma_f32_16x16x32_bf16(Bt[n][k], At[m][k], acc[ai][bj][m][n], 0, 0, 0); __builtin_amdgcn_s_setprio(0); } while (0)
#define PG8_WAIT_V(n) asm volatile("s_waitcnt vmcnt(" #n ")" ::: "memory")
#define PG8_WAIT_L(n) asm volatile("s_waitcnt lgkmcnt(" #n ")" ::: "memory")
#define PG8_BAR __builtin_amdgcn_s_barrier()
#define PG8_SCHED __builtin_amdgcn_sched_barrier(0)
    Unit cur, nxt; int ui = 0;
    if (!S.next(0, cur)) return;
    f32x4 acc[2][2][4][2];
#pragma unroll
    for (int a = 0; a < 2; ++a)
#pragma unroll
        for (int b = 0; b < 2; ++b)
#pragma unroll
            for (int m = 0; m < 4; ++m)
#pragma unroll
                for (int n = 0; n < 2; ++n) acc[a][b][m][n] = (f32x4){0.f, 0.f, 0.f, 0.f};
    bf16x8 At[4][2], B0[2][2], B1[2][2];
    const char* cA = (const char*)g.A + (size_t)cur.pm * tstep; const char* cB = (const char*)g.Bt + (size_t)cur.pn * tstep;
    S.a_ready(cur);
    PG8_STAGE(PG8_SB(0, 0), cB, voffB); PG8_STAGE(PG8_SA(0, 0), cA, voffA); PG8_STAGE(PG8_SB(0, 1), cB + hstep, voffB); PG8_STAGE(PG8_SA(0, 1), cA + hstep, voffA);
    if (wr == 1) PG8_BAR;
    PG8_WAIT_V(4); PG8_BAR;
    PG8_STAGE(PG8_SB(1, 0), cB + kstep, voffB); PG8_STAGE(PG8_SA(1, 0), cA + kstep, voffA); PG8_STAGE(PG8_SB(1, 1), cB + hstep + kstep, voffB);
    PG8_WAIT_V(6); PG8_BAR;
    for (;;) {
        const bool has_next = S.next(ui + 1, nxt);
        const char* nA = has_next ? (const char*)g.A + (size_t)nxt.pm * tstep : cA; const char* nB = has_next ? (const char*)g.Bt + (size_t)nxt.pn * tstep : cB;
        for (int t = 0; t < nt; t += 2) {
            const bool last = (t == nt - 2);
            const char* a1 = cA + (size_t)(t + 1) * kstep;
            const char* a2 = last ? nA : cA + (size_t)(t + 2) * kstep; const char* b2 = last ? nB : cB + (size_t)(t + 2) * kstep;
            const char* a3 = a2 + kstep; const char* b3 = b2 + kstep;
            if (last && has_next) S.a_ready(nxt);
            PG8_LDB(B0, 0, 0); PG8_SCHED; PG8_LDA(At, 0, 0); PG8_STAGE(PG8_SA(1, 1), a1 + hstep, voffA);
            PG8_WAIT_L(8); PG8_BAR; PG8_WAIT_L(0); PG8_MMA(0, 0, At, B0); PG8_BAR; PG8_SCHED;
            PG8_LDB(B1, 0, 1); PG8_STAGE(PG8_SB(0, 0), b2, voffB);
            PG8_BAR; PG8_WAIT_L(0); PG8_MMA(0, 1, At, B1); PG8_BAR;
            PG8_LDA(At, 0, 1); PG8_STAGE(PG8_SA(0, 0), a2, voffA);
            PG8_BAR; PG8_WAIT_L(0); PG8_MMA(1, 0, At, B0); PG8_BAR; PG8_SCHED;
            PG8_STAGE(PG8_SB(0, 1), b2 + hstep, voffB);
            PG8_WAIT_V(6); PG8_BAR; PG8_MMA(1, 1, At, B1); PG8_BAR;
            PG8_LDB(B0, 1, 0); PG8_SCHED; PG8_LDA(At, 1, 0); PG8_STAGE(PG8_SA(0, 1), a2 + hstep, voffA);
            PG8_WAIT_L(8); PG8_BAR; PG8_WAIT_L(0); PG8_MMA(0, 0, At, B0); PG8_BAR; PG8_SCHED;
            PG8_LDB(B1, 1, 1); PG8_STAGE(PG8_SB(1, 0), b3, voffB);
            PG8_BAR; PG8_WAIT_L(0); PG8_MMA(0, 1, At, B1); PG8_BAR;
            PG8_LDA(At, 1, 1); PG8_STAGE(PG8_SA(1, 0), a3, voffA);
            PG8_BAR; PG8_WAIT_L(0); PG8_MMA(1, 0, At, B0); PG8_BAR; PG8_SCHED;
            PG8_STAGE(PG8_SB(1, 1), b3 + hstep, voffB);
            PG8_WAIT_V(6); PG8_BAR; PG8_MMA(1, 1, At, B1); PG8_BAR;
        }
        if (wr == 0) PG8_BAR;
        if constexpr (!Epi::AFTER_DRAIN) { E(acc, cur, wr, wc, fr, fq); S.done(cur); }
        if (!has_next) break;
#pragma unroll
        for (int a = 0; a < 2; ++a)
#pragma unroll
            for (int b = 0; b < 2; ++b)
#pragma unroll
                for (int m = 0; m < 4; ++m)
#pragma unroll
                    for (int n = 0; n < 2; ++n) acc[a][b][m][n] = (f32x4){0.f, 0.f, 0.f, 0.f};
        cur = nxt; cA = nA; cB = nB; ++ui;
        if (wr == 1) PG8_BAR;
    }
    PG8_WAIT_V(0);
    PG8_BAR;
    if constexpr (Epi::AFTER_DRAIN) { E.fused(acc, cur, wr, wc, fr, fq, lds, wid, lane); S.done(cur); }
#undef PG8_SA
#undef PG8_SB
#undef PG8_STAGE
#undef PG8_LDA
#undef PG8_LDB
#undef PG8_MMA
#undef PG8_WAIT_V
#undef PG8_WAIT_L
#undef PG8_BAR
#undef PG8_SCHED
}
}


using pg8::f32x4; using pg8::u32x4; using pg8::bf16x8; using pg8::cvt_pk_bf16;

struct Epi1 {
  static constexpr bool PERM = true, AFTER_DRAIN = false;
  unsigned char* ws; unsigned char* dout;
  __device__ __forceinline__ void operator()(const f32x4 (&acc)[2][2][4][2], const pg8::Unit& u, int wr, int wc, int fr, int fq) const {
    const int pn = u.pn, pm = u.pm; const bool lat = pm < 128;
    const int rl = wr * 64 + fr, cl = wc * 32 + 8 * fq;
    if (pn == 20) {
      if (wc == 0) { float* G = (float*)(ws + OFF_GATES);
#pragma unroll
        for (int ai = 0; ai < 2; ++ai)
#pragma unroll
          for (int m = 0; m < 4; ++m) { float* rp = G + (size_t)(pm * 256 + ai * 128 + rl + m * 16) * 32 + 8 * fq;
            *(f32x4*)rp = acc[ai][0][m][0]; *(f32x4*)(rp + 4) = acc[ai][0][m][1]; } }
      return;
    }
    if (pn >= 21 && pn < 37) {
      if (!lat) return;
      bf16_t* O = (bf16_t*)(ws + OFF_OZ) + (pn - 21) * 128 + cl;
#pragma unroll
      for (int ai = 0; ai < 2; ++ai)
#pragma unroll
        for (int m = 0; m < 4; ++m) { const size_t row = (size_t)pm * 256 + ai * 128 + rl + m * 16;
          float r[8];
#pragma unroll
          for (int n = 0; n < 2; ++n)
#pragma unroll
            for (int e = 0; e < 4; ++e) r[n * 4 + e] = sigmoidf_(acc[ai][0][m][n][e]) * siluf_(acc[ai][1][m][n][e]);
          u32x4 w; w.x = cvt_pk_bf16(r[0], r[1]); w.y = cvt_pk_bf16(r[2], r[3]); w.z = cvt_pk_bf16(r[4], r[5]); w.w = cvt_pk_bf16(r[6], r[7]);
          *(u32x4*)(O + row * 2048) = w; }
      return;
    }
    bf16_t* O; int ld = 2048, act = 0; size_t rowbase = (size_t)pm * 256;
    if (pn < 8) { O = (bf16_t*)(ws + OFF_QKPRE) + pn * 256; }
    else if (pn < 16) { O = (bf16_t*)(ws + OFF_VA) + (pn - 8) * 256; }
    else if (pn < 18) { O = (bf16_t*)(ws + OFF_KBRAW) + (pn - 16) * 256; ld = 512; }
    else if (pn < 20) { O = (bf16_t*)(ws + OFF_VALL) + (pn - 18) * 256; ld = 512;
      rowbase = lat ? (size_t)(pm >> 5) * SKV + CTXL + (size_t)(pm & 31) * 256 : (size_t)(pm - 128) * SKV; }
    else { if (!lat) return;
      if (pn < 45) { O = (bf16_t*)(ws + OFF_QB) + (pn - 37) * 256; }
      else if (pn < 53) { O = (bf16_t*)(ws + OFF_ZB) + (pn - 45) * 256; act = 1; }
      else if (pn < 61) { O = (bf16_t*)dout + (pn - 53) * 256; act = 2; }
      else { O = (bf16_t*)dout + (size_t)M_TOK * 2048 + (pn - 61) * 256; act = 2; } }
#pragma unroll
    for (int ai = 0; ai < 2; ++ai)
#pragma unroll
      for (int m = 0; m < 4; ++m) { bf16_t* rowp = O + (rowbase + ai * 128 + rl + m * 16) * ld + cl;
#pragma unroll
        for (int bj = 0; bj < 2; ++bj) { f32x4 v0 = acc[ai][bj][m][0], v1 = acc[ai][bj][m][1];
          if (act == 1) {
#pragma unroll
            for (int e = 0; e < 4; ++e) { v0[e] = siluf_(v0[e]); v1[e] = siluf_(v1[e]); } }
          else if (act == 2) {
#pragma unroll
            for (int e = 0; e < 4; ++e) { v0[e] = sigmoidf_(v0[e]); v1[e] = sigmoidf_(v1[e]); } }
          u32x4 w; w.x = cvt_pk_bf16(v0[0], v0[1]); w.y = cvt_pk_bf16(v0[2], v0[3]); w.z = cvt_pk_bf16(v1[0], v1[1]); w.w = cvt_pk_bf16(v1[2], v1[3]);
          *(u32x4*)(rowp + bj * 128) = w; } }
  }
};
struct Epi2a {
  static constexpr bool PERM = true, AFTER_DRAIN = false;
  bf16_t* tmp; const bf16_t* sg;
  __device__ __forceinline__ void operator()(const f32x4 (&acc)[2][2][4][2], const pg8::Unit& u, int wr, int wc, int fr, int fq) const {
    const int col0 = u.pn * 256 + wc * 32 + 8 * fq;
#pragma unroll
    for (int ai = 0; ai < 2; ++ai)
#pragma unroll
      for (int m = 0; m < 4; ++m) { const size_t off = (size_t)(u.pm * 256 + ai * 128 + wr * 64 + fr + m * 16) * 2048 + col0;
#pragma unroll
        for (int bj = 0; bj < 2; ++bj) { const u32x4 s = *(const u32x4*)(sg + off + bj * 128);
          f32x4 a = acc[ai][bj][m][0], b = acc[ai][bj][m][1];
          a[0] *= bflo(s.x); a[1] *= bfhi(s.x); a[2] *= bflo(s.y); a[3] *= bfhi(s.y);
          b[0] *= bflo(s.z); b[1] *= bfhi(s.z); b[2] *= bflo(s.w); b[3] *= bfhi(s.w);
          u32x4 w; w.x = cvt_pk_bf16(a[0], a[1]); w.y = cvt_pk_bf16(a[2], a[3]); w.z = cvt_pk_bf16(b[0], b[1]); w.w = cvt_pk_bf16(b[2], b[3]);
          *(u32x4*)(tmp + off + bj * 128) = w; } }
  }
};
struct Epi2b {
  static constexpr bool PERM = true, AFTER_DRAIN = false;
  const bf16_t* tmp; const bf16_t* sg; bf16_t* merged;
  __device__ __forceinline__ void operator()(const f32x4 (&acc)[2][2][4][2], const pg8::Unit& u, int wr, int wc, int fr, int fq) const {
    const int col0 = u.pn * 256 + wc * 32 + 8 * fq;
#pragma unroll
    for (int ai = 0; ai < 2; ++ai)
#pragma unroll
      for (int m = 0; m < 4; ++m) { const size_t off = (size_t)(u.pm * 256 + ai * 128 + wr * 64 + fr + m * 16) * 2048 + col0;
#pragma unroll
        for (int bj = 0; bj < 2; ++bj) { const u32x4 s = *(const u32x4*)(sg + off + bj * 128);
          const u32x4 tw = *(const u32x4*)(tmp + off + bj * 128); const f32x4 t0 = {bflo(tw.x), bfhi(tw.x), bflo(tw.y), bfhi(tw.y)}, t1 = {bflo(tw.z), bfhi(tw.z), bflo(tw.w), bfhi(tw.w)};
          f32x4 a = acc[ai][bj][m][0], b = acc[ai][bj][m][1];
          a[0] = t0[0] + a[0] * bflo(s.x); a[1] = t0[1] + a[1] * bfhi(s.x); a[2] = t0[2] + a[2] * bflo(s.y); a[3] = t0[3] + a[3] * bfhi(s.y);
          b[0] = t1[0] + b[0] * bflo(s.z); b[1] = t1[1] + b[1] * bfhi(s.z); b[2] = t1[2] + b[2] * bflo(s.w); b[3] = t1[3] + b[3] * bfhi(s.w);
          u32x4 w; w.x = cvt_pk_bf16(a[0], a[1]); w.y = cvt_pk_bf16(a[2], a[3]); w.z = cvt_pk_bf16(b[0], b[1]); w.w = cvt_pk_bf16(b[2], b[3]);
          *(u32x4*)(merged + off + bj * 128) = w; } }
  }
};
struct Epi3 {
  static constexpr bool PERM = false, AFTER_DRAIN = false;
  const float* x; const float* mod; float* y;
  __device__ __forceinline__ void operator()(const f32x4 (&acc)[2][2][4][2], const pg8::Unit& u, int wr, int wc, int fr, int fq) const {
    const int col0 = u.pn * 256 + wc * 32 + 4 * fq;
    const float* gate = mod + (size_t)(u.pm >> 5) * 6144 + 4096 + col0;
    f32x4 gv[2][2];
#pragma unroll
    for (int bj = 0; bj < 2; ++bj)
#pragma unroll
      for (int n = 0; n < 2; ++n) gv[bj][n] = *(const f32x4*)(gate + bj * 128 + n * 16);
#pragma unroll
    for (int ai = 0; ai < 2; ++ai)
#pragma unroll
      for (int m = 0; m < 4; ++m) { const size_t off = (size_t)(u.pm * 256 + ai * 128 + wr * 64 + fr + m * 16) * 2048 + col0;
#pragma unroll
        for (int bj = 0; bj < 2; ++bj)
#pragma unroll
          for (int n = 0; n < 2; ++n) { const f32x4 xv = *(const f32x4*)(x + off + bj * 128 + n * 16);
            *(f32x4*)(y + off + bj * 128 + n * 16) = xv * ALPHA_DN + gv[bj][n] * acc[ai][bj][m][n]; } }
  }
};

struct InProjOrder {
  pg8::StaticOrder base; int G, c;
  __device__ void init(int G_, int c_) { base.init(M_TOK, N1P, G_, c_); G = G_; c = c_; }
  __device__ bool next(int i, pg8::Unit& u) const {
    const long L = (long)i * G + c; if (L < base.nwg) return base.next(i, u);
    const int r = (int)(L - base.nwg); if (r >= 4 * 21) return false;
    u.pm = 128 + (r & 3); u.pn = r >> 2; return true; }
  __device__ __forceinline__ void a_ready(const pg8::Unit&) const {}
  __device__ __forceinline__ void done(const pg8::Unit&) const {}
};

__device__ __forceinline__ int orig_col(int n) {
  if (n < 4096) return n;
  if (n < 4608) return 4128 + (n - 4096);
  if (n < 5120) return 4640 + (n - 4608);
  if (n < 5152) return 4096 + (n - 5120);
  if (n < 5376) return -1;
  if (n < 9472) { const int t = n - 5376, j = t >> 8, r = t & 255; return r < 128 ? 5152 + 128 * j + r : 7200 + 128 * j + (r - 128); }
  if (n < 11520) return 9248 + (n - 9472);
  if (n < 13568) return 11296 + (n - 11520);
  return 13344 + (n - 13568);
}
__device__ void phase0_prep(const Params& p, unsigned char* lds) {
  int tid_l = threadIdx.x; asm volatile("" : "+v"(tid_l)); const int tid = tid_l, wid = tid >> 6, lane = tid & 63;
  unsigned char* ws = p.ws;
  for (int idx = blockIdx.x * 512 + tid; idx < 4096; idx += gridDim.x * 512) {
    const int pos = idx >> 5, i = idx & 31; const float inv = powf(10000.0f, -(float)(2 * i) / 64.0f); const float ang = (float)pos * inv;
    float2 cs; cs.x = cosf(ang); cs.y = sinf(ang); ((float2*)(ws + OFF_ROPE))[idx] = cs; }
  float* sl = (float*)lds; float* red = sl + 5 * 2048; bool did = false;
  for (int it = blockIdx.x; it < 192; it += gridDim.x) {
    if (!did) { for (int i = tid; i < 5 * 2048; i += 512) { const int r = i >> 11, k = i & 2047; const float c = (r < 4) ? p.in[1][r * 2048 + k] : p.in[3][k]; sl[i] = c / (1.0f + expf(-c)); }
      __syncthreads(); did = true; }
    const int col = lane & 31, kh = lane >> 5, n = it * 32 + col;
    float a0 = 0.f, a1 = 0.f, a2 = 0.f, a3 = 0.f, a4 = 0.f;
    const float* wp = p.in[4] + (size_t)(wid * 256 + kh) * 6144 + n;
#pragma unroll 8
    for (int i = 0; i < 128; ++i) { const int k = wid * 256 + 2 * i + kh; const float w = wp[(size_t)(2 * i) * 6144];
      a0 += sl[k] * w; a1 += sl[2048 + k] * w; a2 += sl[4096 + k] * w; a3 += sl[6144 + k] * w; a4 += sl[8192 + k] * w; }
    a0 += __shfl_xor(a0, 32); a1 += __shfl_xor(a1, 32); a2 += __shfl_xor(a2, 32); a3 += __shfl_xor(a3, 32); a4 += __shfl_xor(a4, 32);
    if (kh == 0) { red[(wid * 5 + 0) * 32 + col] = a0; red[(wid * 5 + 1) * 32 + col] = a1; red[(wid * 5 + 2) * 32 + col] = a2; red[(wid * 5 + 3) * 32 + col] = a3; red[(wid * 5 + 4) * 32 + col] = a4; }
    __syncthreads();
    if (tid < 160) { const int r = tid >> 5, c = tid & 31; float s = 0.f;
#pragma unroll
      for (int w = 0; w < 8; ++w) s += red[(w * 5 + r) * 32 + c];
      ((float*)(ws + OFF_MOD))[r * 6144 + it * 32 + c] = s + p.in[5][it * 32 + c]; }
    __syncthreads();
  }
  __syncthreads();
  float* tile = (float*)lds;
  constexpr int NT_IN = (N1P / 64) * 32, NT = NT_IN + 3 * 1024;
  for (int t = blockIdx.x; t < NT; t += gridDim.x) {
    const float* src; bf16_t* dst; int ldsrc, n0, k0; bool perm;
    if (t < NT_IN) { src = p.in[6]; dst = (bf16_t*)(ws + OFF_WT_IN); ldsrc = N_IN; n0 = (t >> 5) * 64; k0 = (t & 31) * 64; perm = true; }
    else { int q = t - NT_IN; const int w = q >> 10; q &= 1023; src = p.in[13 + w]; dst = (bf16_t*)(ws + OFF_WT_BA + (size_t)w * SZ_W2); ldsrc = 2048; n0 = (q >> 5) * 64; k0 = (q & 31) * 64; perm = false; }
#pragma unroll
    for (int i = 0; i < 2; ++i) { const int kk = (tid >> 4) + 32 * i, nq = (tid & 15) * 4; const int oc = perm ? orig_col(n0 + nq) : n0 + nq;
      float4 v = make_float4(0.f, 0.f, 0.f, 0.f); if (oc >= 0) v = *(const float4*)(src + (size_t)(k0 + kk) * ldsrc + oc);
      float* tp = tile + kk * 65 + nq; tp[0] = v.x; tp[1] = v.y; tp[2] = v.z; tp[3] = v.w; }
    __syncthreads();
    { const int nn = tid >> 3, kq = (tid & 7) * 8; float r[8];
#pragma unroll
      for (int e = 0; e < 8; ++e) r[e] = tile[(kq + e) * 65 + nn];
      u32x4 w; w.x = cvt_pk_bf16(r[0], r[1]); w.y = cvt_pk_bf16(r[2], r[3]); w.z = cvt_pk_bf16(r[4], r[5]); w.w = cvt_pk_bf16(r[6], r[7]);
      *(u32x4*)(dst + (size_t)(n0 + nn) * 2048 + k0 + kq) = w; }
    __syncthreads();
  }
}

__device__ void phase1_ln_mod(const Params& p) {
  int tid_l = threadIdx.x; asm volatile("" : "+v"(tid_l)); const int tid = tid_l, wid = tid >> 6, lane = tid & 63;
  const float* MOD = (const float*)(p.ws + OFF_MOD); bf16_t* U = (bf16_t*)(p.ws + OFF_U);
  for (int row = blockIdx.x * 8 + wid; row < M_ALL; row += gridDim.x * 8) {
    const float* src = row < M_TOK ? p.in[0] + (size_t)row * 2048 : p.in[2] + (size_t)(row - M_TOK) * 2048;
    const float* md = MOD + (size_t)(row < M_TOK ? (row >> 13) : 4) * 6144;
    float4 v[4][2]; float s = 0.f;
#pragma unroll
    for (int g = 0; g < 4; ++g) { const float4* q = (const float4*)(src + g * 512 + lane * 8); v[g][0] = q[0]; v[g][1] = q[1];
      s += (v[g][0].x + v[g][0].y) + (v[g][0].z + v[g][0].w) + (v[g][1].x + v[g][1].y) + (v[g][1].z + v[g][1].w); }
    s = wave_sum(s); const float mu = s * (1.0f / 2048.0f); float q2 = 0.f;
#pragma unroll
    for (int g = 0; g < 4; ++g)
#pragma unroll
      for (int h = 0; h < 2; ++h) { const float a = v[g][h].x - mu, b = v[g][h].y - mu, c = v[g][h].z - mu, d = v[g][h].w - mu; q2 += (a * a + b * b) + (c * c + d * d); }
    q2 = wave_sum(q2); const float rs = rsqrtf(q2 * (1.0f / 2048.0f) + LN_EPS);
#pragma unroll
    for (int g = 0; g < 4; ++g) { const int c0 = g * 512 + lane * 8; float r[8];
#pragma unroll
      for (int h = 0; h < 2; ++h) { const float4 sh = *(const float4*)(md + c0 + 4 * h), sc = *(const float4*)(md + 2048 + c0 + 4 * h);
        r[4 * h + 0] = (v[g][h].x - mu) * rs * (1.0f + sc.x) + sh.x; r[4 * h + 1] = (v[g][h].y - mu) * rs * (1.0f + sc.y) + sh.y;
        r[4 * h + 2] = (v[g][h].z - mu) * rs * (1.0f + sc.z) + sh.z; r[4 * h + 3] = (v[g][h].w - mu) * rs * (1.0f + sc.w) + sh.w; }
      u32x4 w; w.x = cvt_pk_bf16(r[0], r[1]); w.y = cvt_pk_bf16(r[2], r[3]); w.z = cvt_pk_bf16(r[4], r[5]); w.w = cvt_pk_bf16(r[6], r[7]);
      *(u32x4*)(U + (size_t)row * 2048 + c0) = w; }
  }
}

__device__ __forceinline__ void unpack8(const u32x4 w, float* f) { f[0] = bflo(w.x); f[1] = bfhi(w.x); f[2] = bflo(w.y); f[3] = bfhi(w.y); f[4] = bflo(w.z); f[5] = bfhi(w.z); f[6] = bflo(w.w); f[7] = bfhi(w.w); }
__device__ __forceinline__ u32x4 pack8(const float* r) { u32x4 w; w.x = cvt_pk_bf16(r[0], r[1]); w.y = cvt_pk_bf16(r[2], r[3]); w.z = cvt_pk_bf16(r[4], r[5]); w.w = cvt_pk_bf16(r[6], r[7]); return w; }
__device__ __forceinline__ u32x4 norm_rope_head(const u32x4 raw, const float* nw, const float2* rope, int j, int pos_r, int pos_c) {
  float x[8]; unpack8(raw, x); float ss = 0.f;
#pragma unroll
  for (int e = 0; e < 8; ++e) ss += x[e] * x[e];
  ss += __shfl_xor(ss, 1); ss += __shfl_xor(ss, 2); ss += __shfl_xor(ss, 4); ss += __shfl_xor(ss, 8);
  const float rs = rsqrtf(ss * (1.0f / 128.0f) + LN_EPS);
  const float4 w0 = *(const float4*)(nw + 8 * j), w1 = *(const float4*)(nw + 8 * j + 4);
  x[0] *= rs * w0.x; x[1] *= rs * w0.y; x[2] *= rs * w0.z; x[3] *= rs * w0.w; x[4] *= rs * w1.x; x[5] *= rs * w1.y; x[6] *= rs * w1.z; x[7] *= rs * w1.w;
  float o[8];
  const bool is_x1 = ((j >> 2) & 1) == 0; const int pos = (j < 8) ? pos_r : pos_c; const int fi = 8 * (j & 3);
#pragma unroll
  for (int e = 0; e < 8; ++e) { const float pv = __shfl_xor(x[e], 4);
    if (pos_r >= 0) { const float2 cs = rope[pos * 32 + fi + e]; o[e] = is_x1 ? (x[e] * cs.x - pv * cs.y) : (pv * cs.y + x[e] * cs.x); }
    else o[e] = x[e]; }
  return pack8(o);
}
__device__ void phase3_elem(const Params& p) {
  int tid_l = threadIdx.x; asm volatile("" : "+v"(tid_l)); const int tid = tid_l, wid = tid >> 6, lane = tid & 63;
  unsigned char* ws = p.ws;
  { const bf16_t* X = (const bf16_t*)(ws + OFF_QKPRE); bf16_t* Y = (bf16_t*)(ws + OFF_QAKA); const float* cw = p.in[8]; const float* cb = p.in[9];
    const int c8 = (tid & 255) * 8; const int rsub = tid >> 8;
    float w0[8], w1[8], w2[8], bb[8];
#pragma unroll
    for (int e = 0; e < 8; ++e) { w0[e] = cw[c8 + e]; w1[e] = cw[2048 + c8 + e]; w2[e] = cw[4096 + c8 + e]; bb[e] = cb[c8 + e]; }
    const float sc = c8 >= 1024 ? 0.08838834764831845f : 1.0f;
    const int rstep = (int)gridDim.x * 2;
    for (int row0 = (int)blockIdx.x * 2 + rsub; row0 < M_ALL; row0 += 4 * rstep) {
      u32x4 cu[4], pr[4], nx[4]; const u32x4 z = {0u, 0u, 0u, 0u};
#pragma unroll
      for (int u = 0; u < 4; ++u) { const int row = row0 + u * rstep; cu[u] = z; pr[u] = z; nx[u] = z;
        if (row < M_ALL) { bool first, last; if (row < M_TOK) { const int s = row & (SEQ - 1); first = s == 0; last = s == SEQ - 1; } else { const int t = (row - M_TOK) & (CTXL - 1); first = t == 0; last = t == CTXL - 1; }
          cu[u] = *(const u32x4*)(X + (size_t)row * 2048 + c8);
          if (!first) pr[u] = *(const u32x4*)(X + (size_t)(row - 1) * 2048 + c8);
          if (!last) nx[u] = *(const u32x4*)(X + (size_t)(row + 1) * 2048 + c8); } }
#pragma unroll
      for (int u = 0; u < 4; ++u) { const int row = row0 + u * rstep;
        if (row < M_ALL) { float a[8], b[8], c[8], r[8]; unpack8(pr[u], a); unpack8(cu[u], b); unpack8(nx[u], c);
#pragma unroll
          for (int e = 0; e < 8; ++e) { const float y = bb[e] + a[e] * w0[e] + b[e] * w1[e] + c[e] * w2[e]; r[e] = siluf_(y) * sc; }
          *(u32x4*)(Y + (size_t)row * 2048 + c8) = pack8(r); } } } }
  const float2* rope = (const float2*)(ws + OFF_ROPE);
  const int j = lane & 15, hl = lane >> 4;
  { const bf16_t* X = (const bf16_t*)(ws + OFF_KBRAW); bf16_t* Y = (bf16_t*)(ws + OFF_KALL); const int step = (int)gridDim.x * 8;
    for (int row0 = blockIdx.x * 8 + wid; row0 < M_ALL; row0 += 4 * step) {
      u32x4 raw[4];
#pragma unroll
      for (int u = 0; u < 4; ++u) { const int row = row0 + u * step; raw[u] = (u32x4){0u, 0u, 0u, 0u}; if (row < M_ALL) raw[u] = *(const u32x4*)(X + (size_t)row * 512 + hl * 128 + j * 8); }
#pragma unroll
      for (int u = 0; u < 4; ++u) { const int row = row0 + u * step; if (row < M_ALL) {
        size_t drow; int pr = -1, pc = -1;
        if (row < M_TOK) { const int b = row >> 13, s = row & (SEQ - 1); drow = (size_t)b * SKV + CTXL + s; pr = s >> 6; pc = s & 63; }
        else { const int b = (row - M_TOK) >> 8, t = (row - M_TOK) & (CTXL - 1); drow = (size_t)b * SKV + t; }
        *(u32x4*)(Y + drow * 512 + hl * 128 + j * 8) = norm_rope_head(raw[u], p.in[12], rope, j, pr, pc); } } } }
  { bf16_t* X = (bf16_t*)(ws + OFF_QB); const int step = (int)gridDim.x * 8;
    for (int it0 = blockIdx.x * 8 + wid; it0 < M_TOK * 4; it0 += 4 * step) {
      u32x4 raw[4];
#pragma unroll
      for (int u = 0; u < 4; ++u) { const int it = it0 + u * step; raw[u] = (u32x4){0u, 0u, 0u, 0u};
        if (it < M_TOK * 4) raw[u] = *(const u32x4*)(X + (size_t)(it >> 2) * 2048 + ((it & 3) * 4 + hl) * 128 + j * 8); }
#pragma unroll
      for (int u = 0; u < 4; ++u) { const int it = it0 + u * step; if (it < M_TOK * 4) { const int row = it >> 2, s = row & (SEQ - 1);
        *(u32x4*)(X + (size_t)row * 2048 + ((it & 3) * 4 + hl) * 128 + j * 8) = norm_rope_head(raw[u], p.in[11], rope, j, s >> 6, s & 63); } } } }
}

__device__ void phase5_gate(const Params& p) {
  int tid_l = threadIdx.x; asm volatile("" : "+v"(tid_l)); const int tid = tid_l, wid = tid >> 6, lane = tid & 63;
  const bf16_t* HF = (const bf16_t*)(p.ws + OFF_HF); const bf16_t* HB = (const bf16_t*)(p.ws + OFF_HB); bf16_t* OZ = (bf16_t*)(p.ws + OFF_OZ);
  const float* nw = p.in[10];
  const int j = lane & 31, hl = lane >> 5; const int step = (int)gridDim.x * 8;
  for (int it0 = blockIdx.x * 8 + wid; it0 < M_TOK * 4; it0 += 4 * step) {
    u32x4 ha[4], hb[4], gz[4];
#pragma unroll
    for (int u = 0; u < 4; ++u) { const int it = it0 + u * step; ha[u] = (u32x4){0u, 0u, 0u, 0u}; hb[u] = ha[u]; gz[u] = ha[u];
      if (it < M_TOK * 4) { const size_t off = (size_t)(it >> 2) * 2048 + ((it & 3) * 2 + hl) * 256 + j * 8;
        ha[u] = *(const u32x4*)(HF + off); hb[u] = *(const u32x4*)(HB + off); gz[u] = *(const u32x4*)(OZ + off); } }
#pragma unroll
    for (int u = 0; u < 4; ++u) { const int it = it0 + u * step; if (it < M_TOK * 4) {
      const size_t off = (size_t)(it >> 2) * 2048 + ((it & 3) * 2 + hl) * 256 + j * 8;
      float a[8], b[8], g[8], r[8]; unpack8(ha[u], a); unpack8(hb[u], b); unpack8(gz[u], g);
      float ss = 0.f;
#pragma unroll
      for (int e = 0; e < 8; ++e) { a[e] += b[e]; ss += a[e] * a[e]; }
      ss += __shfl_xor(ss, 1); ss += __shfl_xor(ss, 2); ss += __shfl_xor(ss, 4); ss += __shfl_xor(ss, 8); ss += __shfl_xor(ss, 16);
      const float rs = rsqrtf(ss * (1.0f / 256.0f) + LN_EPS);
      const float* w = nw + ((it & 3) * 2 + hl) * 256 + j * 8;
#pragma unroll
      for (int e = 0; e < 8; ++e) r[e] = a[e] * rs * w[e] * g[e];
      *(u32x4*)(OZ + off) = pack8(r); } }
  }
}

__device__ void phase8_final_ln(const Params& p) {
  int tid_l = threadIdx.x; asm volatile("" : "+v"(tid_l)); const int tid = tid_l, wid = tid >> 6, lane = tid & 63;
  const float* lw = p.in[16]; const float* lb = p.in[17];
  for (int row = blockIdx.x * 8 + wid; row < M_TOK; row += gridDim.x * 8) {
    float4* r = (float4*)(p.out + (size_t)row * 2048);
    float4 v[8]; float s = 0.f;
#pragma unroll
    for (int i = 0; i < 8; ++i) { v[i] = r[lane + 64 * i]; s += (v[i].x + v[i].y) + (v[i].z + v[i].w); }
    s = wave_sum(s); const float mu = s * (1.f / 2048.f); float q = 0.f;
#pragma unroll
    for (int i = 0; i < 8; ++i) { const float a = v[i].x - mu, b = v[i].y - mu, c = v[i].z - mu, d = v[i].w - mu; q += (a * a + b * b) + (c * c + d * d); }
    q = wave_sum(q); const float rs = rsqrtf(q * (1.f / 2048.f) + LN_EPS);
#pragma unroll
    for (int i = 0; i < 8; ++i) { const float4 w = ((const float4*)lw)[lane + 64 * i], b = ((const float4*)lb)[lane + 64 * i];
      float4 y; y.x = (v[i].x - mu) * rs * w.x + b.x; y.y = (v[i].y - mu) * rs * w.y + b.y; y.z = (v[i].z - mu) * rs * w.z + b.z; y.w = (v[i].w - mu) * rs * w.w + b.w;
      r[lane + 64 * i] = y; }
  }
}

namespace att {
constexpr int D = 128, NW = 8, QBLK = 32, KVBLK = 64;
constexpr float SCALE = 0.088388347648318440f;
constexpr float THR = 8.f;
constexpr int LDQ = 2048, LDK = 512;
constexpr size_t SHM_V = KVBLK * D * 2, SHM_K = KVBLK * D * 2, SHM_ATTN = 2 * SHM_V + 2 * SHM_K + NW * 64 * 4;
#define KSWZ(row, colB) ((row) * 256 + ((colB) ^ (((row) & 7) << 4)))
#define SBAR() __builtin_amdgcn_sched_barrier(0)
__device__ __forceinline__ int crow(int r, int hi) { return (r & 3) + 8 * (r >> 2) + 4 * hi; }
__device__ __forceinline__ unsigned cvtpk(float lo, float hi) { unsigned r; asm volatile("v_cvt_pk_bf16_f32 %0, %1, %2" : "=v"(r) : "v"(lo), "v"(hi)); return r; }
__device__ __forceinline__ void partialSM(f32x16& p0, f32x16& p1, float& m_reg, float& mn, float& alpha) {
  constexpr float C = SCALE * 1.4426950408889634f;
  float pmax = p0[0]; for (int r = 1; r < 16; ++r) pmax = fmaxf(pmax, p0[r]); for (int r = 0; r < 16; ++r) pmax = fmaxf(pmax, p1[r]);
  { auto rr = __builtin_amdgcn_permlane32_swap(__float_as_uint(pmax), __float_as_uint(pmax), false, false);
    pmax = fmaxf(__uint_as_float(rr[0]), __uint_as_float(rr[1])); }
  if (__builtin_expect(__all(pmax - m_reg <= THR / SCALE), 1)) { mn = m_reg; alpha = 1.f; }
  else { mn = fmaxf(m_reg, pmax); alpha = __builtin_amdgcn_exp2f((m_reg - mn) * C); m_reg = mn; }
  float mnC = -mn * C;
  for (int r = 0; r < 16; ++r) p0[r] = fmaf(p0[r], C, mnC); for (int r = 0; r < 16; ++r) p1[r] = fmaf(p1[r], C, mnC);
  for (int r = 0; r < 16; ++r) p0[r] = __builtin_amdgcn_exp2f(p0[r]);
}
__device__ __forceinline__ void finishSM(f32x16& p0, f32x16& p1, float alpha, float& l_reg, bf16x8& pa0, bf16x8& pa1, bf16x8& pa2, bf16x8& pa3) {
  for (int r = 0; r < 16; ++r) p1[r] = __builtin_amdgcn_exp2f(p1[r]);
  float ps = 0; for (int r = 0; r < 16; ++r) ps += p0[r]; for (int r = 0; r < 16; ++r) ps += p1[r];
  { auto rr = __builtin_amdgcn_permlane32_swap(__float_as_uint(ps), __float_as_uint(ps), false, false);
    ps = __uint_as_float(rr[0]) + __uint_as_float(rr[1]); }
  l_reg = l_reg * alpha + ps;
#define PK4(P, BASE, OUT) do { unsigned a0 = cvtpk(P[BASE + 0], P[BASE + 1]), a1 = cvtpk(P[BASE + 2], P[BASE + 3]);   \
    unsigned b0 = cvtpk(P[BASE + 4], P[BASE + 5]), b1 = cvtpk(P[BASE + 6], P[BASE + 7]);                              \
    auto r0 = __builtin_amdgcn_permlane32_swap(a0, b0, false, false); auto r1 = __builtin_amdgcn_permlane32_swap(a1, b1, false, false); \
    u32x4 w = {r0[0], r1[0], r0[1], r1[1]}; OUT = *reinterpret_cast<bf16x8*>(&w); } while (0)
  PK4(p0, 0, pa0); PK4(p0, 8, pa1); PK4(p1, 0, pa2); PK4(p1, 8, pa3);
#undef PK4
}
__device__ __forceinline__ void qkt(f32x16& p0, f32x16& p1, const char* Ks, const bf16x8* qr, int r32, int hi) {
  p0 = f32x16{}; p1 = f32x16{};
  for (int d0 = 0; d0 < 8; ++d0) { int cb = (d0 * 16 + hi * 8) * 2;
    bf16x8 b0 = *reinterpret_cast<const bf16x8*>(Ks + KSWZ(r32, cb));
    bf16x8 b1 = *reinterpret_cast<const bf16x8*>(Ks + KSWZ(32 + r32, cb));
    p0 = __builtin_amdgcn_mfma_f32_32x32x16_bf16(b0, qr[d0], p0, 0, 0, 0);
    p1 = __builtin_amdgcn_mfma_f32_32x32x16_bf16(b1, qr[d0], p1, 0, 0, 0); }
}
__device__ __forceinline__ int v_st(int k, int c) { const int kk = (k & ~0xC) | ((k & 4) << 1) | ((k & 8) >> 1); return ((kk >> 3) * 4 + (c >> 5)) * 512 + ((kk & 7) * 32 + (c & 31)) * 2; }
__device__ __forceinline__ int v_rd_base(int lane) { return ((lane & 3) << 3) | (((lane >> 2) & 3) << 6) | (((lane >> 4) & 1) << 5) | (((lane >> 5) & 1) << 8); }
constexpr int v_rd_off(int d0, int ks, int half) { return d0 * 512 + ks * 4096 + half * 2048; }
template <int OFF> __device__ __forceinline__ s16x4 tr_read(int vb) {
  s16x4 r; asm volatile("ds_read_b64_tr_b16 %0, %1 offset:%2" : "=&v"(r) : "v"(vb), "i"(OFF) : "memory"); return r;
}
#define PKLH(L, H) (bf16x8){L[0], L[1], L[2], L[3], H[0], H[1], H[2], H[3]}
template <int D0> __device__ __forceinline__ void pv_one(f32x16& od, int vb, bf16x8 pa0, bf16x8 pa1, bf16x8 pa2, bf16x8 pa3) {
  const s16x4 l0 = tr_read<v_rd_off(D0, 0, 0)>(vb), h0 = tr_read<v_rd_off(D0, 0, 1)>(vb), l1 = tr_read<v_rd_off(D0, 1, 0)>(vb), h1 = tr_read<v_rd_off(D0, 1, 1)>(vb);
  const s16x4 l2 = tr_read<v_rd_off(D0, 2, 0)>(vb), h2 = tr_read<v_rd_off(D0, 2, 1)>(vb), l3 = tr_read<v_rd_off(D0, 3, 0)>(vb), h3 = tr_read<v_rd_off(D0, 3, 1)>(vb);
  asm volatile("s_waitcnt lgkmcnt(0)" ::: "memory"); SBAR();
  od = __builtin_amdgcn_mfma_f32_32x32x16_bf16(pa0, PKLH(l0, h0), od, 0, 0, 0);
  od = __builtin_amdgcn_mfma_f32_32x32x16_bf16(pa1, PKLH(l1, h1), od, 0, 0, 0);
  od = __builtin_amdgcn_mfma_f32_32x32x16_bf16(pa2, PKLH(l2, h2), od, 0, 0, 0);
  od = __builtin_amdgcn_mfma_f32_32x32x16_bf16(pa3, PKLH(l3, h3), od, 0, 0, 0);
}
__device__ __forceinline__ void pv_d0(f32x16* o, int vb, bf16x8 pa0, bf16x8 pa1, bf16x8 pa2, bf16x8 pa3) {
  pv_one<0>(o[0], vb, pa0, pa1, pa2, pa3); pv_one<1>(o[1], vb, pa0, pa1, pa2, pa3); pv_one<2>(o[2], vb, pa0, pa1, pa2, pa3); pv_one<3>(o[3], vb, pa0, pa1, pa2, pa3);
}
__device__ __forceinline__ void attn_dense_body(bf16_t* __restrict__ Qb, const bf16_t* __restrict__ Kh, const bf16_t* __restrict__ Vh, int seq, char* lds) {
  int tid_l = threadIdx.x; asm volatile("" : "+v"(tid_l)); const int tid = tid_l, wid = tid >> 6, lane = tid & 63, r32 = lane & 31, hi = lane >> 5;
  char* V_lds = lds; char* K_lds = lds + 2 * SHM_V;
  float* wsf = (float*)(lds + 2 * SHM_V + 2 * SHM_K) + wid * 64; float* li_l = wsf; float* al_l = wsf + 32;
  float m_reg = -1e30f, l_reg = 0; f32x16 o[4] = {}; bf16x8 qr[8];
  const bf16_t* Qw = Qb + (long)(wid * QBLK + r32) * LDQ + hi * 8;
#pragma unroll
  for (int d0 = 0; d0 < 8; ++d0) qr[d0] = *reinterpret_cast<const bf16x8*>(Qw + d0 * 16);
  const int sr = tid >> 4, sc = (tid & 15) * 8, vst0 = v_st(sr, sc), vst1 = v_st(32 + sr, sc);
  const int vb0 = (int)(uintptr_t)V_lds + v_rd_base(lane);
  struct { bf16x8 vs0, vs1, ks0, ks1; } sr_[1];
#define SLOAD(i, k0) do { sr_[i].vs0 = *reinterpret_cast<const bf16x8*>(&Vh[(long)((k0) + sr) * LDK + sc]); sr_[i].vs1 = *reinterpret_cast<const bf16x8*>(&Vh[(long)((k0) + 32 + sr) * LDK + sc]); \
    sr_[i].ks0 = *reinterpret_cast<const bf16x8*>(&Kh[(long)((k0) + sr) * LDK + sc]); sr_[i].ks1 = *reinterpret_cast<const bf16x8*>(&Kh[(long)((k0) + 32 + sr) * LDK + sc]); } while (0)
#define SWRITE(b, i) do { *(bf16x8*)(V_lds + (b) * SHM_V + vst0) = sr_[i].vs0;          \
    *(bf16x8*)(V_lds + (b) * SHM_V + vst1) = sr_[i].vs1; int kc = sc * 2;               \
    *(bf16x8*)(K_lds + (b) * SHM_K + KSWZ(sr, kc)) = sr_[i].ks0;                       \
    *(bf16x8*)(K_lds + (b) * SHM_K + KSWZ(32 + sr, kc)) = sr_[i].ks1; } while (0)
#define SWAIT() asm volatile("s_waitcnt vmcnt(0)" ::: "memory")
#define RESC(a) do { if (__any((a) < 1.f)) { if (hi == 0) al_l[r32] = (a); asm volatile("s_waitcnt lgkmcnt(0)" ::: "memory"); \
    for (int d = 0; d < 4; ++d) for (int r = 0; r < 16; ++r) o[d][r] *= al_l[crow(r, hi)]; } } while (0)
  f32x16 pA0, pA1, pB0, pB1; float mnA, mnB, alA, alB; bf16x8 pa0, pa1, pa2, pa3; const int NT = seq / KVBLK;
  constexpr int SE = 0, SO = 0;
  SLOAD(SE, 0); asm volatile("s_waitcnt vmcnt(0)" ::: "memory"); SWRITE(0, SE); __syncthreads();
  qkt(pA0, pA1, K_lds, qr, r32, hi); partialSM(pA0, pA1, m_reg, mnA, alA);
  SLOAD(SO, KVBLK);
  SWAIT(); SWRITE(1, SO); __syncthreads();
  for (int j = 1; j + 1 < NT; j += 2) {
    SBAR(); qkt(pB0, pB1, K_lds + SHM_K, qr, r32, hi);
    finishSM(pA0, pA1, alA, l_reg, pa0, pa1, pa2, pa3); SBAR();
    SLOAD(SO, (j + 1) * KVBLK); SBAR();
    pv_d0(o, vb0, pa0, pa1, pa2, pa3); partialSM(pB0, pB1, m_reg, mnB, alB);
    __syncthreads(); SWAIT(); SWRITE(0, SE);
    RESC(alB); __syncthreads();
    SBAR(); qkt(pA0, pA1, K_lds, qr, r32, hi);
    finishSM(pB0, pB1, alB, l_reg, pa0, pa1, pa2, pa3); SBAR();
    SLOAD(SE, (j + 2) * KVBLK); SBAR();
    pv_d0(o, vb0 + (int)SHM_V, pa0, pa1, pa2, pa3); partialSM(pA0, pA1, m_reg, mnA, alA);
    __syncthreads(); SWAIT(); SWRITE(1, SO);
    RESC(alA); __syncthreads();
  }
  SBAR(); qkt(pB0, pB1, K_lds + SHM_K, qr, r32, hi);
  finishSM(pA0, pA1, alA, l_reg, pa0, pa1, pa2, pa3); SBAR();
  pv_d0(o, vb0, pa0, pa1, pa2, pa3); partialSM(pB0, pB1, m_reg, mnB, alB);
  __syncthreads(); RESC(alB);
  finishSM(pB0, pB1, alB, l_reg, pa0, pa1, pa2, pa3); SBAR();
  pv_d0(o, vb0 + (int)SHM_V, pa0, pa1, pa2, pa3);
  if (hi == 0) li_l[r32] = l_reg; asm volatile("s_waitcnt lgkmcnt(0)" ::: "memory");
  float rli[16];
#pragma unroll
  for (int r = 0; r < 16; ++r) rli[r] = __builtin_amdgcn_rcpf(li_l[crow(r, hi)]);
  bf16_t* qo = Qb + (long)(wid * QBLK + 4 * hi) * LDQ + r32; const bf16_t* zo = qo + (long)((OFF_ZB - OFF_QB) / 2);
  unsigned short zz[64];
#pragma unroll
  for (int r = 0; r < 16; ++r) { const int ro = ((r & 3) + 8 * (r >> 2)) * LDQ;
    zz[4 * r] = zo[ro]; zz[4 * r + 1] = zo[ro + 32]; zz[4 * r + 2] = zo[ro + 64]; zz[4 * r + 3] = zo[ro + 96]; }
  asm volatile("" ::: "memory");
#pragma unroll
  for (int r = 0; r < 16; ++r) { const int ro = ((r & 3) + 8 * (r >> 2)) * LDQ;
    const float v0 = o[0][r] * rli[r] * bf2f(zz[4 * r]), v1 = o[1][r] * rli[r] * bf2f(zz[4 * r + 1]), v2 = o[2][r] * rli[r] * bf2f(zz[4 * r + 2]), v3 = o[3][r] * rli[r] * bf2f(zz[4 * r + 3]);
    qo[ro] = (bf16_t)(cvtpk(v0, v0) & 0xffffu); qo[ro + 32] = (bf16_t)(cvtpk(v1, v1) & 0xffffu); qo[ro + 64] = (bf16_t)(cvtpk(v2, v2) & 0xffffu); qo[ro + 96] = (bf16_t)(cvtpk(v3, v3) & 0xffffu); }
#undef SLOAD
#undef SWRITE
#undef SWAIT
#undef RESC
}
}

namespace ml {
using att::crow; using att::cvtpk; using att::v_st; using att::v_rd_base; using att::v_rd_off; using att::tr_read;
constexpr int O_QS = 0, O_KS = 17408, O_C0 = 34816, O_KTR = 69632, O_VTR = 86016, O_VW = 102400, O_SP = 118784, O_F = 128000;
constexpr int NCH = 132;
template <int KS> __device__ __forceinline__ bf16x8 trfrag(int vb) {
  const s16x4 l = tr_read<v_rd_off(0, KS, 0)>(vb), h = tr_read<v_rd_off(0, KS, 1)>(vb);
  asm volatile("s_waitcnt lgkmcnt(0)" ::: "memory"); SBAR();
  return PKLH(l, h);
}
__device__ __forceinline__ bf16x8 scale_frag(bf16x8 v, const float* we) {
  const u32x4 w = *reinterpret_cast<const u32x4*>(&v); float f[8]; unpack8(w, f);
  const float4 s0 = *(const float4*)we, s1 = *(const float4*)(we + 4);
  f[0] *= s0.x; f[1] *= s0.y; f[2] *= s0.z; f[3] *= s0.w; f[4] *= s1.x; f[5] *= s1.y; f[6] *= s1.z; f[7] *= s1.w;
  const u32x4 o = pack8(f); return *reinterpret_cast<const bf16x8*>(&o);
}
__device__ __forceinline__ int chunk_row0(int c, int b, bool rev) {
  if (!rev) return c < 4 ? M_TOK + b * CTXL + 64 * c : b * SEQ + 64 * (c - 4);
  return c < 4 ? M_TOK + b * CTXL + 64 * (3 - c) : b * SEQ + 64 * (131 - c);
}
__device__ __forceinline__ void gate_scan(float gi, float gf, float bi, float bfb, float& m0, float* S, int lane, int jn) {
  const float li = gi + bi, xf = gf + bfb; const float lf = fminf(xf, 0.f) - __logf(1.0f + __expf(-fabsf(xf)));
  float bb = lf;
#define DPP_F(x, old, ctrl, rmask, bc) __int_as_float(__builtin_amdgcn_update_dpp(__float_as_int(old), __float_as_int(x), ctrl, rmask, 0xf, bc))
  bb += DPP_F(bb, 0.f, 0x111, 0xf, true); bb += DPP_F(bb, 0.f, 0x112, 0xf, true); bb += DPP_F(bb, 0.f, 0x114, 0xf, true); bb += DPP_F(bb, 0.f, 0x118, 0xf, true);
  bb += DPP_F(bb, 0.f, 0x142, 0xa, true); bb += DPP_F(bb, 0.f, 0x143, 0xc, true);
  const float g = li - bb; float cm = g; const float NI = -3.0e38f;
  cm = fmaxf(cm, DPP_F(cm, NI, 0x111, 0xf, false)); cm = fmaxf(cm, DPP_F(cm, NI, 0x112, 0xf, false)); cm = fmaxf(cm, DPP_F(cm, NI, 0x114, 0xf, false)); cm = fmaxf(cm, DPP_F(cm, NI, 0x118, 0xf, false));
  cm = fmaxf(cm, DPP_F(cm, NI, 0x142, 0xa, false)); cm = fmaxf(cm, DPP_F(cm, NI, 0x143, 0xc, false));
#undef DPP_F
  const float Mx = fmaxf(m0, cm), m = bb + Mx, a = __expf(m0 - Mx), em = __expf(-m);
  const float bL = __int_as_float(__builtin_amdgcn_readlane(__float_as_int(bb), 63)), ML = __int_as_float(__builtin_amdgcn_readlane(__float_as_int(Mx), 63)), aend = __int_as_float(__builtin_amdgcn_readlane(__float_as_int(a), 63));
  S[jn] = g; S[64 + jn] = Mx; S[128 + jn] = a; S[192 + jn] = em; S[256 + jn] = __expf(g - ML); if (lane == 0) S[320] = aend;
  m0 = bL + ML;
}
__device__ void mlstm_scan(const Params& p, char* lds, int item) {
  int tid_l = threadIdx.x; asm volatile("" : "+v"(tid_l)); const int tid = tid_l, wid = __builtin_amdgcn_readfirstlane(tid >> 6), lane = tid & 63, r32 = lane & 31, hi = lane >> 5;
  const int dir = item & 1, vs = (item >> 1) & 1, bh = item >> 2, b = bh >> 3, h = bh & 7;
  const bool rev = dir != 0, flip = !rev;
  const bf16_t* QK = (const bf16_t*)(p.ws + OFF_QAKA); const bf16_t* VA = (const bf16_t*)(p.ws + OFF_VA); const float* GT = (const float*)(p.ws + OFF_GATES);
  bf16_t* H = (bf16_t*)(p.ws + (rev ? OFF_HB : OFF_HF));
  float* F = (float*)(lds + O_F); float *NQ = F + 768, *RS = F + 832, *N0 = F + 960, *GSL = F + 1088, *PN = F + 1216;
  for (int i = tid; i < 128 * 272 / 4; i += 512) ((unsigned*)(lds + O_C0))[i] = 0u;
  if (tid < 128) N0[tid] = 0.f;
  f32x16 cacc0 = {}, cacc1 = {}; f32x16 acc1 = {}; float nreg = 0.f, m0 = -1e30f, aend_prev = 0.f; bool npend = false;
  const float bi = p.in[7][dir * 16 + h], bfb = p.in[7][dir * 16 + 8 + h];
  const int qrow0 = tid >> 4, qc = (tid & 15) * 8;
  const int jnat = 63 - lane, jg = flip ? lane : jnat;
  bf16x8 q0, q1, k0, k1, v0, v1; float gi1 = 0.f, gf1 = 0.f;
  u32x2 hw0 = {0u, 0u}, hw1 = {0u, 0u}, hw2 = {0u, 0u}, hw3 = {0u, 0u}; bf16_t* hpend = nullptr;
  { const int R0 = chunk_row0(0, b, rev); const bf16_t* qp = QK + (size_t)(R0 + qrow0) * 2048 + h * 128 + qc; const bf16_t* vp = VA + (size_t)(R0 + qrow0) * 2048 + h * 256 + vs * 128 + qc;
    q0 = *(const bf16x8*)qp; q1 = *(const bf16x8*)(qp + 32 * 2048); k0 = *(const bf16x8*)(qp + 1024); k1 = *(const bf16x8*)(qp + 1024 + 32 * 2048);
    v0 = *(const bf16x8*)vp; v1 = *(const bf16x8*)(vp + 32 * 2048);
    if (wid == 0) { const float g0i = GT[(size_t)(R0 + jg) * 32 + dir * 16 + h], g0f = GT[(size_t)(R0 + jg) * 32 + dir * 16 + 8 + h];
      const int R1 = chunk_row0(1, b, rev); gi1 = GT[(size_t)(R1 + jg) * 32 + dir * 16 + h]; gf1 = GT[(size_t)(R1 + jg) * 32 + dir * 16 + 8 + h];
      gate_scan(g0i, g0f, bi, bfb, m0, F, lane, jnat); } }
  const int w4 = wid & 3, t_hi = w4 >> 1, t_lo = w4 & 1;
  const int vt = wid >> 1, jt = wid & 1;
  for (int c = 0; c < NCH; ++c) {
    const int R0 = chunk_row0(c, b, rev); const bool isctx = c < 4;
    float* S = F + (c & 1) * 384; float *G = S, *MX = S + 64, *A = S + 128, *EM = S + 192, *WE = S + 256;
    __syncthreads();
    { const int ra = flip ? 63 - qrow0 : qrow0, rb = flip ? 31 - qrow0 : qrow0 + 32;
    *(bf16x8*)(lds + O_QS + ra * 272 + qc * 2) = q0; *(bf16x8*)(lds + O_QS + rb * 272 + qc * 2) = q1;
    *(bf16x8*)(lds + O_KS + ra * 272 + qc * 2) = k0; *(bf16x8*)(lds + O_KS + rb * 272 + qc * 2) = k1;
    *(bf16x8*)(lds + O_KTR + v_st(ra, qc)) = k0; *(bf16x8*)(lds + O_KTR + v_st(rb, qc)) = k1;
    *(bf16x8*)(lds + O_VTR + v_st(ra, qc)) = v0; *(bf16x8*)(lds + O_VTR + v_st(rb, qc)) = v1;
    { const float wa = WE[ra], wb = WE[rb]; float f[8];
      unpack8(*reinterpret_cast<const u32x4*>(&v0), f);
#pragma unroll
      for (int e = 0; e < 8; ++e) f[e] *= wa;
      *(u32x4*)(lds + O_VW + v_st(ra, qc)) = pack8(f);
      unpack8(*reinterpret_cast<const u32x4*>(&v1), f);
#pragma unroll
      for (int e = 0; e < 8; ++e) f[e] *= wb;
      *(u32x4*)(lds + O_VW + v_st(rb, qc)) = pack8(f); } }
    if (hpend) { *(u32x2*)(hpend) = hw0; *(u32x2*)(hpend + 8) = hw1; *(u32x2*)(hpend + 16) = hw2; *(u32x2*)(hpend + 24) = hw3; hpend = nullptr; }
    if (npend && tid < 128) { nreg = aend_prev * nreg + ((PN[tid] + PN[128 + tid]) + (PN[256 + tid] + PN[384 + tid])); N0[tid] = nreg; }
    npend = true;
    if (wid == 0) { GSL[lane] = gi1; GSL[64 + lane] = gf1;
      if (c + 2 < NCH) { const int R2 = chunk_row0(c + 2, b, rev); gi1 = GT[(size_t)(R2 + jg) * 32 + dir * 16 + h]; gf1 = GT[(size_t)(R2 + jg) * 32 + dir * 16 + 8 + h]; } }
    if (c + 1 < NCH) { const int R1 = chunk_row0(c + 1, b, rev); const bf16_t* qp = QK + (size_t)(R1 + qrow0) * 2048 + h * 128 + qc; const bf16_t* vp = VA + (size_t)(R1 + qrow0) * 2048 + h * 256 + vs * 128 + qc;
      q0 = *(const bf16x8*)qp; q1 = *(const bf16x8*)(qp + 32 * 2048); k0 = *(const bf16x8*)(qp + 1024); k1 = *(const bf16x8*)(qp + 1024 + 32 * 2048);
      v0 = *(const bf16x8*)vp; v1 = *(const bf16x8*)(vp + 32 * 2048); }
    __syncthreads();
    if (wid < 4) {
      f32x16 pS = {};
      const char* ka = lds + O_KS + (32 * t_hi + r32) * 272 + hi * 16; const char* qb = lds + O_QS + (32 * t_lo + r32) * 272 + hi * 16;
#pragma unroll
      for (int d0 = 0; d0 < 8; ++d0) pS = __builtin_amdgcn_mfma_f32_32x32x16_bf16(*(const bf16x8*)(ka + d0 * 32), *(const bf16x8*)(qb + d0 * 32), pS, 0, 0, 0);
      const int j = 32 * t_lo + r32; const float mxj = MX[j]; float ps = 0.f;
#pragma unroll
      for (int r = 0; r < 16; ++r) { const int s = 32 * t_hi + crow(r, hi); const bool ok = (s >= j);
        const float arg = ok ? (G[s] - mxj) : -1e30f; const float wv = __builtin_amdgcn_exp2f(arg * 1.4426950408889634f); pS[r] *= wv; ps += pS[r]; }
      ps += __shfl_xor(ps, 32); if (hi == 0) RS[t_hi * 64 + j] = ps;
#pragma unroll
      for (int g4 = 0; g4 < 4; ++g4) { u32x2 w; w.x = cvtpk(pS[4 * g4], pS[4 * g4 + 1]); w.y = cvtpk(pS[4 * g4 + 2], pS[4 * g4 + 3]);
        *(u32x2*)(lds + O_SP + j * 144 + (32 * t_hi + 8 * g4 + 4 * hi) * 2) = w; }
    } else {
      const int t4 = tid - 256, jq = t4 >> 2, part = t4 & 3; float sum = 0.f;
      const char* qrow = lds + O_QS + jq * 272 + part * 64;
#pragma unroll
      for (int i = 0; i < 4; ++i) { float f[8]; unpack8(*(const u32x4*)(qrow + 16 * i), f);
#pragma unroll
        for (int e = 0; e < 8; ++e) sum += f[e] * N0[part * 32 + 8 * i + e]; }
      sum += __shfl_xor(sum, 1); sum += __shfl_xor(sum, 2); if (part == 0) NQ[jq] = sum;
    }
    { acc1 = f32x16{};
      const char* ca = lds + O_C0 + (32 * vt + r32) * 272 + hi * 16; const char* qb = lds + O_QS + (32 * jt + r32) * 272 + hi * 16;
#pragma unroll
      for (int d0 = 0; d0 < 8; ++d0) acc1 = __builtin_amdgcn_mfma_f32_32x32x16_bf16(*(const bf16x8*)(ca + d0 * 32), *(const bf16x8*)(qb + d0 * 32), acc1, 0, 0, 0); }
    __syncthreads();
    const float aend = S[320];
    if (wid == 0 && c + 1 < NCH) gate_scan(GSL[lane], GSL[64 + lane], bi, bfb, m0, F + ((c + 1) & 1) * 384, lane, jnat);
    {
      f32x16 acc2 = {};
      const int vbv = (int)(uintptr_t)(lds + O_VTR) + v_rd_base(lane) + vt * 512;
      const char* sb = lds + O_SP + (32 * jt + r32) * 144 + hi * 16;
      const s16x4 l0 = tr_read<v_rd_off(0, 0, 0)>(vbv), h0 = tr_read<v_rd_off(0, 0, 1)>(vbv), l1 = tr_read<v_rd_off(0, 1, 0)>(vbv), h1 = tr_read<v_rd_off(0, 1, 1)>(vbv);
      const s16x4 l2 = tr_read<v_rd_off(0, 2, 0)>(vbv), h2 = tr_read<v_rd_off(0, 2, 1)>(vbv), l3 = tr_read<v_rd_off(0, 3, 0)>(vbv), h3 = tr_read<v_rd_off(0, 3, 1)>(vbv);
      const bf16x8 s0 = *(const bf16x8*)(sb), s1 = *(const bf16x8*)(sb + 32), s2 = *(const bf16x8*)(sb + 64), s3 = *(const bf16x8*)(sb + 96);
      asm volatile("s_waitcnt lgkmcnt(0)" ::: "memory"); SBAR();
      acc2 = __builtin_amdgcn_mfma_f32_32x32x16_bf16(PKLH(l0, h0), s0, acc2, 0, 0, 0);
      acc2 = __builtin_amdgcn_mfma_f32_32x32x16_bf16(PKLH(l1, h1), s1, acc2, 0, 0, 0);
      acc2 = __builtin_amdgcn_mfma_f32_32x32x16_bf16(PKLH(l2, h2), s2, acc2, 0, 0, 0);
      acc2 = __builtin_amdgcn_mfma_f32_32x32x16_bf16(PKLH(l3, h3), s3, acc2, 0, 0, 0);
      const int j = 32 * jt + r32; const float aj = A[j]; const float den = aj * NQ[j] + RS[j] + RS[64 + j];
      const float inv = 1.0f / fmaxf(fabsf(den), EM[j]);
      if (!isctx) { hpend = H + (size_t)(R0 + (flip ? 63 - j : j)) * 2048 + h * 256 + vs * 128 + 32 * vt + 4 * hi;
#define HPK(g4) (u32x2){cvtpk((aj * acc1[4 * g4] + acc2[4 * g4]) * inv, (aj * acc1[4 * g4 + 1] + acc2[4 * g4 + 1]) * inv), cvtpk((aj * acc1[4 * g4 + 2] + acc2[4 * g4 + 2]) * inv, (aj * acc1[4 * g4 + 3] + acc2[4 * g4 + 3]) * inv)}
        hw0 = HPK(0); hw1 = HPK(1); hw2 = HPK(2); hw3 = HPK(3);
#undef HPK
      }
    }
    { const int d = tid & 127, q4 = tid >> 7; float s = 0.f;
#pragma unroll
      for (int si = 0; si < 16; ++si) s += WE[16 * q4 + si] * bf2f(*(const bf16_t*)(lds + O_KS + (16 * q4 + si) * 272 + d * 2));
      PN[q4 * 128 + d] = s; }
    aend_prev = aend;
    { const int dt = wid & 3, vp2 = (wid >> 2) * 2;
      const int kb = (int)(uintptr_t)(lds + O_KTR) + v_rd_base(lane) + dt * 512;
      const int vb2 = (int)(uintptr_t)(lds + O_VW) + v_rd_base(lane) + vp2 * 512;
      const s16x4 kl0 = tr_read<v_rd_off(0, 0, 0)>(kb), kh0 = tr_read<v_rd_off(0, 0, 1)>(kb), kl1 = tr_read<v_rd_off(0, 1, 0)>(kb), kh1 = tr_read<v_rd_off(0, 1, 1)>(kb);
      const s16x4 kl2 = tr_read<v_rd_off(0, 2, 0)>(kb), kh2 = tr_read<v_rd_off(0, 2, 1)>(kb), kl3 = tr_read<v_rd_off(0, 3, 0)>(kb), kh3 = tr_read<v_rd_off(0, 3, 1)>(kb);
      const s16x4 vl0 = tr_read<v_rd_off(0, 0, 0)>(vb2), vh0 = tr_read<v_rd_off(0, 0, 1)>(vb2), vl1 = tr_read<v_rd_off(0, 1, 0)>(vb2), vh1 = tr_read<v_rd_off(0, 1, 1)>(vb2);
      const s16x4 vl2 = tr_read<v_rd_off(0, 2, 0)>(vb2), vh2 = tr_read<v_rd_off(0, 2, 1)>(vb2), vl3 = tr_read<v_rd_off(0, 3, 0)>(vb2), vh3 = tr_read<v_rd_off(0, 3, 1)>(vb2);
      const s16x4 wl0 = tr_read<v_rd_off(1, 0, 0)>(vb2), wh0 = tr_read<v_rd_off(1, 0, 1)>(vb2), wl1 = tr_read<v_rd_off(1, 1, 0)>(vb2), wh1 = tr_read<v_rd_off(1, 1, 1)>(vb2);
      const s16x4 wl2 = tr_read<v_rd_off(1, 2, 0)>(vb2), wh2 = tr_read<v_rd_off(1, 2, 1)>(vb2), wl3 = tr_read<v_rd_off(1, 3, 0)>(vb2), wh3 = tr_read<v_rd_off(1, 3, 1)>(vb2);
      asm volatile("s_waitcnt lgkmcnt(0)" ::: "memory"); SBAR();
#pragma unroll
      for (int r = 0; r < 16; ++r) { cacc0[r] *= aend; cacc1[r] *= aend; }
      const bf16x8 ka0 = PKLH(kl0, kh0), ka1 = PKLH(kl1, kh1), ka2 = PKLH(kl2, kh2), ka3 = PKLH(kl3, kh3);
      cacc0 = __builtin_amdgcn_mfma_f32_32x32x16_bf16(ka0, PKLH(vl0, vh0), cacc0, 0, 0, 0);
      cacc1 = __builtin_amdgcn_mfma_f32_32x32x16_bf16(ka0, PKLH(wl0, wh0), cacc1, 0, 0, 0);
      cacc0 = __builtin_amdgcn_mfma_f32_32x32x16_bf16(ka1, PKLH(vl1, vh1), cacc0, 0, 0, 0);
      cacc1 = __builtin_amdgcn_mfma_f32_32x32x16_bf16(ka1, PKLH(wl1, wh1), cacc1, 0, 0, 0);
      cacc0 = __builtin_amdgcn_mfma_f32_32x32x16_bf16(ka2, PKLH(vl2, vh2), cacc0, 0, 0, 0);
      cacc1 = __builtin_amdgcn_mfma_f32_32x32x16_bf16(ka2, PKLH(wl2, wh2), cacc1, 0, 0, 0);
      cacc0 = __builtin_amdgcn_mfma_f32_32x32x16_bf16(ka3, PKLH(vl3, vh3), cacc0, 0, 0, 0);
      cacc1 = __builtin_amdgcn_mfma_f32_32x32x16_bf16(ka3, PKLH(wl3, wh3), cacc1, 0, 0, 0);
#pragma unroll
      for (int g4 = 0; g4 < 4; ++g4) { u32x2 w; w.x = cvtpk(cacc0[4 * g4], cacc0[4 * g4 + 1]); w.y = cvtpk(cacc0[4 * g4 + 2], cacc0[4 * g4 + 3]);
        *(u32x2*)(lds + O_C0 + (32 * vp2 + r32) * 272 + (32 * dt + 8 * g4 + 4 * hi) * 2) = w;
        u32x2 x; x.x = cvtpk(cacc1[4 * g4], cacc1[4 * g4 + 1]); x.y = cvtpk(cacc1[4 * g4 + 2], cacc1[4 * g4 + 3]);
        *(u32x2*)(lds + O_C0 + (32 * vp2 + 32 + r32) * 272 + (32 * dt + 8 * g4 + 4 * hi) * 2) = x; }
    }
  }
  if (hpend) { *(u32x2*)(hpend) = hw0; *(u32x2*)(hpend + 8) = hw1; *(u32x2*)(hpend + 16) = hw2; *(u32x2*)(hpend + 24) = hw3; }
  __syncthreads();
}
}

__device__ void phase4_mixers(const Params& p, char* lds) {
  bf16_t* QB = (bf16_t*)(p.ws + OFF_QB);
  const bf16_t* KA = (const bf16_t*)(p.ws + OFF_KALL); const bf16_t* VAl = (const bf16_t*)(p.ws + OFF_VALL);
  const bool sched = gridDim.x == 256; const int bx = blockIdx.x;
  for (int item = bx; item < 128; item += gridDim.x) ml::mlstm_scan(p, lds, item);
  const int nslots = sched ? 9 : (2048 + (int)gridDim.x - 1) / (int)gridDim.x;
  for (int sl = (sched && bx < 128) ? 2 : 0; sl < nslots; ++sl) {
    int i;
    if (sched) i = sl < 2 ? sl * 128 + (bx - 128) : 256 + (sl - 2) * 256 + (bx < 128 ? 128 + bx : bx - 128);
    else { i = sl * (int)gridDim.x + bx; if (i >= 2048) break; }
    const int g = i >> 7, b = g >> 2, kvh = g & 3, hq = kvh * 4 + ((i >> 5) & 3), qb = i & 31;
    const size_t qoff = (size_t)(b * SEQ + qb * 256) * 2048 + hq * 128, koff = (size_t)b * SKV * 512 + kvh * 128;
    att::attn_dense_body(QB + qoff, KA + koff, VAl + koff, SKV, lds);
    __syncthreads();
  }
}

#define GRID_SYNC() do { asm volatile("s_waitcnt vmcnt(0) lgkmcnt(0)" ::: "memory"); grid.sync(); } while (0)
__global__ void __launch_bounds__(512, 2) fwd_megakernel(Params p) {
  extern __shared__ __attribute__((aligned(16))) unsigned char lds[];
  cg::grid_group grid = cg::this_grid();
  unsigned char* ws = p.ws;
  PG8_LAS unsigned char* lds3 = (PG8_LAS unsigned char*)lds;
  phase0_prep(p, lds);
  GRID_SYNC();
  phase1_ln_mod(p);
  GRID_SYNC();
  { pg8::Gemm g{(const bf16_t*)(ws + OFF_U), (const bf16_t*)(ws + OFF_WT_IN), M_ALL, N1P, 2048}; InProjOrder S; S.init((int)gridDim.x, (int)blockIdx.x);
    Epi1 E{ws, (unsigned char*)p.out}; pg8::gemm_phase<Epi1, InProjOrder>(lds3, g, S, E); }
  GRID_SYNC();
  phase3_elem(p);
  GRID_SYNC();
  phase4_mixers(p, (char*)lds);
  GRID_SYNC();
  phase5_gate(p);
  GRID_SYNC();
  { pg8::Gemm g{(const bf16_t*)(ws + OFF_OZ), (const bf16_t*)(ws + OFF_WT_BA), M_TOK, 2048, 2048}; pg8::StaticOrder S; S.init(M_TOK, 2048, (int)gridDim.x, (int)blockIdx.x);
    Epi2a E{(bf16_t*)(ws + OFF_TMP), (const bf16_t*)p.out}; pg8::gemm_phase<Epi2a, pg8::StaticOrder>(lds3, g, S, E); }
  __syncthreads();
  { pg8::Gemm g{(const bf16_t*)(ws + OFF_QB), (const bf16_t*)(ws + OFF_WT_BB), M_TOK, 2048, 2048}; pg8::StaticOrder S; S.init(M_TOK, 2048, (int)gridDim.x, (int)blockIdx.x);
    Epi2b E{(const bf16_t*)(ws + OFF_TMP), (const bf16_t*)p.out + (size_t)M_TOK * 2048, (bf16_t*)(ws + OFF_MERGED)}; pg8::gemm_phase<Epi2b, pg8::StaticOrder>(lds3, g, S, E); }
  GRID_SYNC();
  { pg8::Gemm g{(const bf16_t*)(ws + OFF_MERGED), (const bf16_t*)(ws + OFF_WT_OUT), M_TOK, 2048, 2048}; pg8::StaticOrder S; S.init(M_TOK, 2048, (int)gridDim.x, (int)blockIdx.x);
    Epi3 E{p.in[0], (const float*)(ws + OFF_MOD), p.out}; pg8::gemm_phase<Epi3, pg8::StaticOrder>(lds3, g, S, E); }
  GRID_SYNC();
  phase8_final_ln(p);
}

extern "C" void kernel_launch(void* const* d_in, const int* in_sizes, int n_in, void* d_out, int out_size, void* d_ws, size_t ws_size, hipStream_t stream) {
  static int grid_blocks = 0;
  if (!grid_blocks) {
    if (n_in != 18 || out_size != M_TOK * DM || ws_size < WS_END) { fprintf(stderr, "kernel_launch: unexpected shapes (n_in %d out %d ws %zu need %zu)\n", n_in, out_size, ws_size, (size_t)WS_END); grid_blocks = -1; return; }
    int dev = 0, cus = 0, per_cu = 0;
    (void)hipGetDevice(&dev);
    (void)hipDeviceGetAttribute(&cus, hipDeviceAttributeMultiprocessorCount, dev);
    (void)hipFuncSetAttribute((const void*)fwd_megakernel, hipFuncAttributeMaxDynamicSharedMemorySize, LDS_BYTES);
    (void)hipOccupancyMaxActiveBlocksPerMultiprocessor(&per_cu, fwd_megakernel, 512, LDS_BYTES);
    if (per_cu < 1) per_cu = 1;
    grid_blocks = cus * per_cu;
  }
  if (grid_blocks < 0) return;
  Params p{};
  for (int i = 0; i < 18; ++i) p.in[i] = (const float*)d_in[i];
  p.out = (float*)d_out; p.ws = (unsigned char*)d_ws;
  void* args[] = {&p};
  hipError_t e = hipLaunchCooperativeKernel((void*)fwd_megakernel, dim3(grid_blocks), dim3(512), args, LDS_BYTES, stream);
  if (e != hipSuccess) fprintf(stderr, "cooperative launch failed: %s (grid %d)\n", hipGetErrorString(e), grid_blocks);
}
```

```cpp
#include <hip/hip_runtime.h>
#include <hip/hip_cooperative_groups.h>
#include <cstdio>
#include <cstdint>
namespace cg = cooperative_groups;

constexpr int DM = 2048, NB = 4, SEQ = 8192, CTXL = 256;
constexpr int M_TOK = NB * SEQ, M_CTX = NB * CTXL, M_ALL = M_TOK + M_CTX;
constexpr int SKV = CTXL + SEQ;
constexpr int N_IN = 17440, N1P = 17664;
constexpr float LN_EPS = 1e-6f;
constexpr float ALPHA_DN = 1.189207115002721f;
constexpr int LDS_BYTES = 132 * 1024;

constexpr size_t SZ_W2 = (size_t)2048 * 2048 * 2;
constexpr size_t SZ_ALL = (size_t)M_ALL * 2048 * 2;
constexpr size_t SZ_TOK = (size_t)M_TOK * 2048 * 2;
constexpr size_t SZ_KV = (size_t)NB * SKV * 512 * 2;
constexpr size_t OFF_WT_BA = 0, OFF_WT_BB = SZ_W2, OFF_WT_OUT = 2 * SZ_W2;
constexpr size_t OFF_MOD = 3 * SZ_W2;
constexpr size_t OFF_ROPE = OFF_MOD + 131072;
constexpr size_t OFF_U = OFF_ROPE + 32768;
constexpr size_t OFF_QAKA = OFF_U;
constexpr size_t OFF_QKPRE = OFF_U + SZ_ALL;
constexpr size_t OFF_HF = OFF_QKPRE, OFF_MERGED = OFF_QKPRE;
constexpr size_t OFF_OZ = OFF_QKPRE + SZ_ALL;
constexpr size_t OFF_QB = OFF_OZ + SZ_TOK;
constexpr size_t OFF_ZB = OFF_QB + SZ_TOK;
constexpr size_t OFF_TMP = OFF_ZB;
constexpr size_t OFF_VA = OFF_ZB + SZ_TOK;
constexpr size_t OFF_VALL = OFF_VA + SZ_ALL;
constexpr size_t OFF_KALL = OFF_VALL + SZ_KV;
constexpr size_t OFF_GATES = OFF_KALL + SZ_KV;
constexpr size_t OFF_KBRAW = OFF_GATES + (size_t)M_ALL * 32 * 4;
constexpr size_t OFF_HB = OFF_KBRAW;
constexpr size_t OFF_WT_IN = OFF_KBRAW + SZ_KV;
constexpr size_t WS_END = OFF_HB + SZ_TOK;
static_assert(OFF_WT_IN + (size_t)N1P * 2048 * 2 <= WS_END, "ws map");
static_assert(OFF_TMP + (size_t)M_TOK * 2048 * 4 <= OFF_VALL, "tmp map");
static_assert(OFF_U % 256 == 0 && OFF_GATES % 256 == 0 && OFF_KBRAW % 256 == 0, "align");

typedef unsigned short bf16_t;
using f32x16 = __attribute__((ext_vector_type(16))) float;
using s16x4 = __attribute__((ext_vector_type(4))) short;
using u32x2 = __attribute__((ext_vector_type(2))) unsigned;

struct Params { const float* in[18]; float* out; unsigned char* ws; };

__device__ __forceinline__ float wave_sum(float v) {
#pragma unroll
  for (int o = 32; o >= 1; o >>= 1) v += __shfl_xor(v, o);
  return v;
}
__device__ __forceinline__ float bf2f(unsigned short b) { return __uint_as_float(((unsigned)b) << 16); }
__device__ __forceinline__ float bflo(unsigned w) { return __uint_as_float(w << 16); }
__device__ __forceinline__ float bfhi(unsigned w) { return __uint_as_float(w & 0xffff0000u); }
__device__ __forceinline__ float sigmoidf_(float x) { return __builtin_amdgcn_rcpf(1.0f + __expf(-x)); }
__device__ __forceinline__ float siluf_(float x) { return x * __builtin_amdgcn_rcpf(1.0f + __expf(-x)); }
namespace pg8 {
#define PG8_LAS __attribute__((address_space(3)))
typedef unsigned short bf16_t;
typedef short bf16x8 __attribute__((ext_vector_type(8)));
typedef float f32x4 __attribute__((ext_vector_type(4)));
typedef unsigned u32x4 __attribute__((ext_vector_type(4)));
constexpr int BM = 256, BK = 64, HALF = 128, HTB = HALF * BK * 2  , STAGE_BYTES = 8 * HTB, NXCD = 8, WGM = 8;

__host__ __device__ __forceinline__ int lds_byte(int r, int c) { const int st = (r >> 4) * 2 + (c >> 5), rr = r & 15, cc = c & 31, ob = rr * 64 + cc * 2; return st * 1024 + (ob ^ (((ob >> 9) & 1) << 5)); }
__host__ __device__ __forceinline__ void stage_rc(int b, int& R, int& C) { const int st = b / 1024, sb = b % 1024, swz = sb ^ (((sb >> 9) & 1) << 5); R = (st >> 1) * 16 + swz / 64; C = (st & 1) * 32 + (swz % 64) / 2; }
__host__ __device__ __forceinline__ int perm32(int rho) { const int n = rho >> 4, i = rho & 15; return 8 * (i >> 2) + 4 * n + (i & 3); }

struct Unit { int pm, pn; };
struct Gemm { const bf16_t* A; const bf16_t* Bt; int M, N, K; };

struct StaticOrder {
    int nM, nN, nwg, G, c;
    __host__ __device__ void init(int M, int N, int G_, int c_) { nM = M / BM; nN = N / BM; nwg = nM * nN; G = G_; c = c_; }
    __host__ __device__ bool next(int i, Unit& u) const {
        const long L = (long)i * G + c; if (L >= nwg) return false;
        int wgid = (int)L; { const int q = nwg / NXCD, r = nwg % NXCD, xcd = wgid % NXCD, off = wgid / NXCD; wgid = (xcd < r ? xcd * (q + 1) : r * (q + 1) + (xcd - r) * q) + off; }
        const int nig = WGM * nN, gid = wgid / nig, fm = gid * WGM, gsz = (nM - fm) < WGM ? (nM - fm) : WGM;
        u.pm = fm + ((wgid % nig) % gsz); u.pn = (wgid % nig) / gsz; return true;
    }
    __device__ __forceinline__ void a_ready(const Unit&) const {}
    __device__ __forceinline__ void done(const Unit&) const {}
};
__device__ __forceinline__ unsigned cvt_pk_bf16(float lo, float hi) { unsigned r; asm volatile("v_cvt_pk_bf16_f32 %0, %1, %2" : "=v"(r) : "v"(lo), "v"(hi)); return r; }
template <class Epi, class Sched, bool ALIGN_EPI = false, bool SP2 = false>
__device__ __forceinline__ void gemm_phase(PG8_LAS unsigned char* lds, const Gemm g, const Sched& S, const Epi& E) {
    int tid_l = threadIdx.x; asm volatile("" : "+v"(tid_l)); const int tid = tid_l, wid = __builtin_amdgcn_readfirstlane(tid >> 6), lane = tid & 63, wr = wid >> 2, wc = wid & 3, fr = lane & 15, fq = lane >> 4;
    const int K = g.K, nt = K / BK;
    unsigned voffA[2], voffB[2];
#pragma unroll
    for (int i = 0; i < 2; ++i) { int R, C; stage_rc(tid * 16 + i * 8192, R, C); const int Rb = Epi::PERM ? ((R & ~31) + perm32(R & 31)) : R;
        voffA[i] = (unsigned)(R * K + C) * 2u; voffB[i] = (unsigned)(Rb * K + C) * 2u; }
    const size_t kstep = (size_t)(BK * 2);
    const size_t hstep = (size_t)HALF * K * 2;
    const size_t tstep = 2 * hstep;
    const unsigned ldsw = (unsigned)wid * 1024u;
    const int aoff = lds_byte(wr * 64 + fr, fq * 8), boff = lds_byte(wc * 32 + fr, fq * 8);
#define PG8_SA(b, h) (((b) * 2 + (h)) * HTB)
#define PG8_SB(b, h) ((4 + (b) * 2 + (h)) * HTB)
#define PG8_STAGE(bufoff, gbase, voff) do { _Pragma("unroll") for (int _i = 0; _i < 2; ++_i) \
        __builtin_amdgcn_global_load_lds((const unsigned*)((const char*)(gbase) + (voff)[_i]), (PG8_LAS unsigned*)(lds + (bufoff) + ldsw + _i * 8192), 16, 0, 0); } while (0)
#define PG8_LDA(dst, b, h) do { _Pragma("unroll") for (int m = 0; m < 4; ++m) _Pragma("unroll") for (int k = 0; k < 2; ++k) dst[m][k] = *(const PG8_LAS bf16x8*)(lds + PG8_SA(b, h) + aoff + m * 2048 + k * 1024); } while (0)
#define PG8_LDB(dst, b, h) do { _Pragma("unroll") for (int n = 0; n < 2; ++n) _Pragma("unroll") for (int k = 0; k < 2; ++k) dst[n][k] = *(const PG8_LAS bf16x8*)(lds + PG8_SB(b, h) + boff + n * 2048 + k * 1024); } while (0)
#define PG8_MMA(ai, bj, At, Bt) do { __builtin_amdgcn_s_setprio(1); _Pragma("unroll") for (int m = 0; m < 4; ++m) _Pragma("unroll") for (int n = 0; n < 2; ++n) _Pragma("unroll") for (int k = 0; k < 2; ++k) \
        acc[ai][bj][m][n] = __builtin_amdgcn_mfma_f32_16x16x32_bf16(Bt[n][k], At[m][k], acc[ai][bj][m][n], 0, 0, 0); __builtin_amdgcn_s_setprio(0); } while (0)
#define PG8_WAIT_V(n) asm volatile("s_waitcnt vmcnt(" #n ")" ::: "memory")
#define PG8_WAIT_L(n) asm volatile("s_waitcnt lgkmcnt(" #n ")" ::: "memory")
#define PG8_BAR __builtin_amdgcn_s_barrier()
#define PG8_SCHED __builtin_amdgcn_sched_barrier(0)
    Unit cur, nxt; int ui = 0;
    if (!S.next(0, cur)) return;
    f32x4 acc[2][2][4][2];
#pragma unroll
    for (int a = 0; a < 2; ++a)
#pragma unroll
        for (int b = 0; b < 2; ++b)
#pragma unroll
            for (int m = 0; m < 4; ++m)
#pragma unroll
                for (int n = 0; n < 2; ++n) acc[a][b][m][n] = (f32x4){0.f, 0.f, 0.f, 0.f};
    bf16x8 At[4][2], B0[2][2], B1[2][2];
    const char* cA = (const char*)g.A + (size_t)cur.pm * tstep; const char* cB = (const char*)g.Bt + (size_t)cur.pn * tstep;
    S.a_ready(cur);
    if constexpr (SP2) {
        PG8_STAGE(PG8_SB(0, 0), cB, voffB); PG8_STAGE(PG8_SB(0, 1), cB + hstep, voffB); PG8_STAGE(PG8_SA(0, 0), cA, voffA); PG8_STAGE(PG8_SA(0, 1), cA + hstep, voffA);
        if (wr == 1) PG8_BAR;
        PG8_WAIT_V(2); PG8_BAR;
        PG8_STAGE(PG8_SB(1, 0), cB + kstep, voffB); PG8_STAGE(PG8_SA(1, 0), cA + kstep, voffA); PG8_STAGE(PG8_SB(1, 1), cB + hstep + kstep, voffB);
        PG8_WAIT_V(6); PG8_BAR;
    } else {
        PG8_STAGE(PG8_SB(0, 0), cB, voffB); PG8_STAGE(PG8_SA(0, 0), cA, voffA); PG8_STAGE(PG8_SB(0, 1), cB + hstep, voffB); PG8_STAGE(PG8_SA(0, 1), cA + hstep, voffA);
        if (wr == 1) PG8_BAR;
        PG8_WAIT_V(4); PG8_BAR;
        PG8_STAGE(PG8_SB(1, 0), cB + kstep, voffB); PG8_STAGE(PG8_SA(1, 0), cA + kstep, voffA); PG8_STAGE(PG8_SB(1, 1), cB + hstep + kstep, voffB);
        PG8_WAIT_V(6); PG8_BAR;
    }
    for (;;) {
        const bool has_next = S.next(ui + 1, nxt);
        const char* nA = has_next ? (const char*)g.A + (size_t)nxt.pm * tstep : cA; const char* nB = has_next ? (const char*)g.Bt + (size_t)nxt.pn * tstep : cB;
        for (int t = 0; t < nt; t += 2) {
            const bool last = (t == nt - 2);
            const char* a1 = cA + (size_t)(t + 1) * kstep;
            const char* a2 = last ? nA : cA + (size_t)(t + 2) * kstep; const char* b2 = last ? nB : cB + (size_t)(t + 2) * kstep;
            const char* a3 = a2 + kstep; const char* b3 = b2 + kstep;
            if (last && has_next) S.a_ready(nxt);
            if constexpr (SP2) {
            PG8_LDB(B0, 0, 0); PG8_LDB(B1, 0, 1); PG8_SCHED; PG8_LDA(At, 0, 0); PG8_STAGE(PG8_SA(1, 1), a1 + hstep, voffA);
            PG8_WAIT_V(8); PG8_WAIT_L(0); PG8_BAR; PG8_MMA(0, 0, At, B0); PG8_MMA(0, 1, At, B1); PG8_BAR; PG8_SCHED;
            PG8_LDA(At, 0, 1); PG8_STAGE(PG8_SB(0, 0), b2, voffB); PG8_STAGE(PG8_SB(0, 1), b2 + hstep, voffB); PG8_STAGE(PG8_SA(0, 0), a2, voffA);
            PG8_WAIT_V(8); PG8_WAIT_L(0); PG8_BAR; PG8_MMA(1, 0, At, B0); PG8_MMA(1, 1, At, B1); PG8_BAR; PG8_SCHED;
            PG8_LDB(B0, 1, 0); PG8_LDB(B1, 1, 1); PG8_SCHED; PG8_LDA(At, 1, 0); PG8_STAGE(PG8_SA(0, 1), a2 + hstep, voffA);
            PG8_WAIT_V(8); PG8_WAIT_L(0); PG8_BAR; PG8_MMA(0, 0, At, B0); PG8_MMA(0, 1, At, B1); PG8_BAR; PG8_SCHED;
            PG8_LDA(At, 1, 1); PG8_STAGE(PG8_SB(1, 0), b3, voffB); PG8_STAGE(PG8_SB(1, 1), b3 + hstep, voffB); PG8_STAGE(PG8_SA(1, 0), a3, voffA);
            PG8_WAIT_V(8); PG8_WAIT_L(0); PG8_BAR; PG8_MMA(1, 0, At, B0); PG8_MMA(1, 1, At, B1); PG8_BAR; PG8_SCHED;
            } else {
            PG8_LDB(B0, 0, 0); PG8_SCHED; PG8_LDA(At, 0, 0); PG8_STAGE(PG8_SA(1, 1), a1 + hstep, voffA);
            PG8_WAIT_L(8); PG8_BAR; PG8_WAIT_L(0); PG8_MMA(0, 0, At, B0); PG8_BAR; PG8_SCHED;
            PG8_LDB(B1, 0, 1); PG8_STAGE(PG8_SB(0, 0), b2, voffB);
            PG8_BAR; PG8_WAIT_L(0); PG8_MMA(0, 1, At, B1); PG8_BAR;
            PG8_LDA(At, 0, 1); PG8_STAGE(PG8_SA(0, 0), a2, voffA);
            PG8_BAR; PG8_WAIT_L(0); PG8_MMA(1, 0, At, B0); PG8_BAR; PG8_SCHED;
            PG8_STAGE(PG8_SB(0, 1), b2 + hstep, voffB);
            PG8_WAIT_V(6); PG8_BAR; PG8_MMA(1, 1, At, B1); PG8_BAR;
            PG8_LDB(B0, 1, 0); PG8_SCHED; PG8_LDA(At, 1, 0); PG8_STAGE(PG8_SA(0, 1), a2 + hstep, voffA);
            PG8_WAIT_L(8); PG8_BAR; PG8_WAIT_L(0); PG8_MMA(0, 0, At, B0); PG8_BAR; PG8_SCHED;
            PG8_LDB(B1, 1, 1); PG8_STAGE(PG8_SB(1, 0), b3, voffB);
            PG8_BAR; PG8_WAIT_L(0); PG8_MMA(0, 1, At, B1); PG8_BAR;
            PG8_LDA(At, 1, 1); PG8_STAGE(PG8_SA(1, 0), a3, voffA);
            PG8_BAR; PG8_WAIT_L(0); PG8_MMA(1, 0, At, B0); PG8_BAR; PG8_SCHED;
            PG8_STAGE(PG8_SB(1, 1), b3 + hstep, voffB);
            PG8_WAIT_V(6); PG8_BAR; PG8_MMA(1, 1, At, B1); PG8_BAR;
            }
        }
        if constexpr (ALIGN_EPI) { if (wr == 0) PG8_BAR; }
        if constexpr (!Epi::AFTER_DRAIN) { E(acc, cur, wr, wc, fr, fq); S.done(cur); }
        if (!has_next) break;
#pragma unroll
        for (int a = 0; a < 2; ++a)
#pragma unroll
            for (int b = 0; b < 2; ++b)
#pragma unroll
                for (int m = 0; m < 4; ++m)
#pragma unroll
                    for (int n = 0; n < 2; ++n) acc[a][b][m][n] = (f32x4){0.f, 0.f, 0.f, 0.f};
        cur = nxt; cA = nA; cB = nB; ++ui;
        if constexpr (ALIGN_EPI) { if (wr == 1) PG8_BAR; }
    }
    PG8_WAIT_V(0);
    if constexpr (!ALIGN_EPI) { if (wr == 0) PG8_BAR; }
    PG8_BAR;
    if constexpr (Epi::AFTER_DRAIN) { E.fused(acc, cur, wr, wc, fr, fq, lds, wid, lane); S.done(cur); }
#undef PG8_SA
#undef PG8_SB
#undef PG8_STAGE
#undef PG8_LDA
#undef PG8_LDB
#undef PG8_MMA
#undef PG8_WAIT_V
#undef PG8_WAIT_L
#undef PG8_BAR
#undef PG8_SCHED
}
}


using pg8::f32x4; using pg8::u32x4; using pg8::bf16x8; using pg8::cvt_pk_bf16;

struct Epi1 {
  static constexpr bool PERM = true, AFTER_DRAIN = false;
  unsigned char* ws; unsigned char* dout;
  __device__ __forceinline__ void operator()(const f32x4 (&acc)[2][2][4][2], const pg8::Unit& u, int wr, int wc, int fr, int fq) const {
    const int pn = u.pn, pm = u.pm; const bool lat = pm < 128;
    const int rl = wr * 64 + fr, cl = wc * 32 + 8 * fq;
    if (pn == 20) {
      if (wc == 0) { float* G = (float*)(ws + OFF_GATES);
#pragma unroll
        for (int ai = 0; ai < 2; ++ai)
#pragma unroll
          for (int m = 0; m < 4; ++m) { float* rp = G + (size_t)(pm * 256 + ai * 128 + rl + m * 16) * 32 + 8 * fq;
            *(f32x4*)rp = acc[ai][0][m][0]; *(f32x4*)(rp + 4) = acc[ai][0][m][1]; } }
      return;
    }
    if (pn >= 21 && pn < 37) {
      if (!lat) return;
      bf16_t* O = (bf16_t*)(ws + OFF_OZ) + (pn - 21) * 128 + cl;
#pragma unroll
      for (int ai = 0; ai < 2; ++ai)
#pragma unroll
        for (int m = 0; m < 4; ++m) { const size_t row = (size_t)pm * 256 + ai * 128 + rl + m * 16;
          float r[8];
#pragma unroll
          for (int n = 0; n < 2; ++n)
#pragma unroll
            for (int e = 0; e < 4; ++e) r[n * 4 + e] = sigmoidf_(acc[ai][0][m][n][e]) * siluf_(acc[ai][1][m][n][e]);
          u32x4 w; w.x = cvt_pk_bf16(r[0], r[1]); w.y = cvt_pk_bf16(r[2], r[3]); w.z = cvt_pk_bf16(r[4], r[5]); w.w = cvt_pk_bf16(r[6], r[7]);
          *(u32x4*)(O + row * 2048) = w; }
      return;
    }
    bf16_t* O; int ld = 2048, act = 0; size_t rowbase = (size_t)pm * 256;
    if (pn < 8) { O = (bf16_t*)(ws + OFF_QKPRE) + pn * 256; }
    else if (pn < 16) { O = (bf16_t*)(ws + OFF_VA) + (pn - 8) * 256; }
    else if (pn < 18) { O = (bf16_t*)(ws + OFF_KBRAW) + (pn - 16) * 256; ld = 512; }
    else if (pn < 20) { O = (bf16_t*)(ws + OFF_VALL) + (pn - 18) * 256; ld = 512;
      rowbase = lat ? (size_t)(pm >> 5) * SKV + CTXL + (size_t)(pm & 31) * 256 : (size_t)(pm - 128) * SKV; }
    else { if (!lat) return;
      if (pn < 45) { O = (bf16_t*)(ws + OFF_QB) + (pn - 37) * 256; }
      else if (pn < 53) { O = (bf16_t*)(ws + OFF_ZB) + (pn - 45) * 256; act = 1; }
      else if (pn < 61) { O = (bf16_t*)dout + (pn - 53) * 256; act = 2; }
      else { O = (bf16_t*)dout + (size_t)M_TOK * 2048 + (pn - 61) * 256; act = 2; } }
#pragma unroll
    for (int ai = 0; ai < 2; ++ai)
#pragma unroll
      for (int m = 0; m < 4; ++m) { bf16_t* rowp = O + (rowbase + ai * 128 + rl + m * 16) * ld + cl;
#pragma unroll
        for (int bj = 0; bj < 2; ++bj) { f32x4 v0 = acc[ai][bj][m][0], v1 = acc[ai][bj][m][1];
          if (act == 1) {
#pragma unroll
            for (int e = 0; e < 4; ++e) { v0[e] = siluf_(v0[e]); v1[e] = siluf_(v1[e]); } }
          else if (act == 2) {
#pragma unroll
            for (int e = 0; e < 4; ++e) { v0[e] = sigmoidf_(v0[e]); v1[e] = sigmoidf_(v1[e]); } }
          u32x4 w; w.x = cvt_pk_bf16(v0[0], v0[1]); w.y = cvt_pk_bf16(v0[2], v0[3]); w.z = cvt_pk_bf16(v1[0], v1[1]); w.w = cvt_pk_bf16(v1[2], v1[3]);
          *(u32x4*)(rowp + bj * 128) = w; } }
  }
};
struct Epi2a {
  static constexpr bool PERM = true, AFTER_DRAIN = false;
  bf16_t* tmp; const bf16_t* sg;
  __device__ __forceinline__ void operator()(const f32x4 (&acc)[2][2][4][2], const pg8::Unit& u, int wr, int wc, int fr, int fq) const {
    const int col0 = u.pn * 256 + wc * 32 + 8 * fq;
#pragma unroll
    for (int ai = 0; ai < 2; ++ai)
#pragma unroll
      for (int m = 0; m < 4; ++m) { const size_t off = (size_t)(u.pm * 256 + ai * 128 + wr * 64 + fr + m * 16) * 2048 + col0;
#pragma unroll
        for (int bj = 0; bj < 2; ++bj) { const u32x4 s = *(const u32x4*)(sg + off + bj * 128);
          f32x4 a = acc[ai][bj][m][0], b = acc[ai][bj][m][1];
          a[0] *= bflo(s.x); a[1] *= bfhi(s.x); a[2] *= bflo(s.y); a[3] *= bfhi(s.y);
          b[0] *= bflo(s.z); b[1] *= bfhi(s.z); b[2] *= bflo(s.w); b[3] *= bfhi(s.w);
          u32x4 w; w.x = cvt_pk_bf16(a[0], a[1]); w.y = cvt_pk_bf16(a[2], a[3]); w.z = cvt_pk_bf16(b[0], b[1]); w.w = cvt_pk_bf16(b[2], b[3]);
          *(u32x4*)(tmp + off + bj * 128) = w; } }
  }
};
struct Epi2b {
  static constexpr bool PERM = true, AFTER_DRAIN = false;
  const bf16_t* tmp; const bf16_t* sg; bf16_t* merged;
  __device__ __forceinline__ void operator()(const f32x4 (&acc)[2][2][4][2], const pg8::Unit& u, int wr, int wc, int fr, int fq) const {
    const int col0 = u.pn * 256 + wc * 32 + 8 * fq;
#pragma unroll
    for (int ai = 0; ai < 2; ++ai)
#pragma unroll
      for (int m = 0; m < 4; ++m) { const size_t off = (size_t)(u.pm * 256 + ai * 128 + wr * 64 + fr + m * 16) * 2048 + col0;
#pragma unroll
        for (int bj = 0; bj < 2; ++bj) { const u32x4 s = *(const u32x4*)(sg + off + bj * 128);
          const u32x4 tw = *(const u32x4*)(tmp + off + bj * 128); const f32x4 t0 = {bflo(tw.x), bfhi(tw.x), bflo(tw.y), bfhi(tw.y)}, t1 = {bflo(tw.z), bfhi(tw.z), bflo(tw.w), bfhi(tw.w)};
          f32x4 a = acc[ai][bj][m][0], b = acc[ai][bj][m][1];
          a[0] = t0[0] + a[0] * bflo(s.x); a[1] = t0[1] + a[1] * bfhi(s.x); a[2] = t0[2] + a[2] * bflo(s.y); a[3] = t0[3] + a[3] * bfhi(s.y);
          b[0] = t1[0] + b[0] * bflo(s.z); b[1] = t1[1] + b[1] * bfhi(s.z); b[2] = t1[2] + b[2] * bflo(s.w); b[3] = t1[3] + b[3] * bfhi(s.w);
          u32x4 w; w.x = cvt_pk_bf16(a[0], a[1]); w.y = cvt_pk_bf16(a[2], a[3]); w.z = cvt_pk_bf16(b[0], b[1]); w.w = cvt_pk_bf16(b[2], b[3]);
          *(u32x4*)(merged + off + bj * 128) = w; } }
  }
};
struct Epi3 {
  static constexpr bool PERM = false, AFTER_DRAIN = false;
  const float* x; const float* mod; float* y;
  __device__ __forceinline__ void operator()(const f32x4 (&acc)[2][2][4][2], const pg8::Unit& u, int wr, int wc, int fr, int fq) const {
    const int col0 = u.pn * 256 + wc * 32 + 4 * fq;
    const float* gate = mod + (size_t)(u.pm >> 5) * 6144 + 4096 + col0;
    f32x4 gv[2][2];
#pragma unroll
    for (int bj = 0; bj < 2; ++bj)
#pragma unroll
      for (int n = 0; n < 2; ++n) gv[bj][n] = *(const f32x4*)(gate + bj * 128 + n * 16);
#pragma unroll
    for (int ai = 0; ai < 2; ++ai)
#pragma unroll
      for (int m = 0; m < 4; ++m) { const size_t off = (size_t)(u.pm * 256 + ai * 128 + wr * 64 + fr + m * 16) * 2048 + col0;
#pragma unroll
        for (int bj = 0; bj < 2; ++bj)
#pragma unroll
          for (int n = 0; n < 2; ++n) { const f32x4 xv = *(const f32x4*)(x + off + bj * 128 + n * 16);
            *(f32x4*)(y + off + bj * 128 + n * 16) = xv * ALPHA_DN + gv[bj][n] * acc[ai][bj][m][n]; } }
  }
};

struct InProjOrder {
  pg8::StaticOrder base; int G, c;
  __device__ void init(int G_, int c_) { base.init(M_TOK, N1P, G_, c_); G = G_; c = c_; }
  __device__ bool next(int i, pg8::Unit& u) const {
    const long L = (long)i * G + c; if (L < base.nwg) return base.next(i, u);
    const int r = (int)(L - base.nwg); if (r >= 4 * 21) return false;
    u.pm = 128 + (r & 3); u.pn = r >> 2; return true; }
  __device__ __forceinline__ void a_ready(const pg8::Unit&) const {}
  __device__ __forceinline__ void done(const pg8::Unit&) const {}
};

__device__ __forceinline__ int orig_col(int n) {
  if (n < 4096) return n;
  if (n < 4608) return 4128 + (n - 4096);
  if (n < 5120) return 4640 + (n - 4608);
  if (n < 5152) return 4096 + (n - 5120);
  if (n < 5376) return -1;
  if (n < 9472) { const int t = n - 5376, j = t >> 8, r = t & 255; return r < 128 ? 5152 + 128 * j + r : 7200 + 128 * j + (r - 128); }
  if (n < 11520) return 9248 + (n - 9472);
  if (n < 13568) return 11296 + (n - 11520);
  return 13344 + (n - 13568);
}
__device__ void phase0_prep(const Params& p, unsigned char* lds) {
  int tid_l = threadIdx.x; asm volatile("" : "+v"(tid_l)); const int tid = tid_l, wid = tid >> 6, lane = tid & 63;
  unsigned char* ws = p.ws;
  for (int idx = blockIdx.x * 512 + tid; idx < 4096; idx += gridDim.x * 512) {
    const int pos = idx >> 5, i = idx & 31; const float inv = powf(10000.0f, -(float)(2 * i) / 64.0f); const float ang = (float)pos * inv;
    float2 cs; cs.x = cosf(ang); cs.y = sinf(ang); ((float2*)(ws + OFF_ROPE))[idx] = cs; }
  float* sl = (float*)lds; float* red = sl + 5 * 2048; bool did = false;
  for (int it = blockIdx.x; it < 192; it += gridDim.x) {
    if (!did) { for (int i = tid; i < 5 * 2048; i += 512) { const int r = i >> 11, k = i & 2047; const float c = (r < 4) ? p.in[1][r * 2048 + k] : p.in[3][k]; sl[i] = c / (1.0f + expf(-c)); }
      __syncthreads(); did = true; }
    const int col = lane & 31, kh = lane >> 5, n = it * 32 + col;
    float a0 = 0.f, a1 = 0.f, a2 = 0.f, a3 = 0.f, a4 = 0.f;
    const float* wp = p.in[4] + (size_t)(wid * 256 + kh) * 6144 + n;
#pragma unroll 8
    for (int i = 0; i < 128; ++i) { const int k = wid * 256 + 2 * i + kh; const float w = wp[(size_t)(2 * i) * 6144];
      a0 += sl[k] * w; a1 += sl[2048 + k] * w; a2 += sl[4096 + k] * w; a3 += sl[6144 + k] * w; a4 += sl[8192 + k] * w; }
    a0 += __shfl_xor(a0, 32); a1 += __shfl_xor(a1, 32); a2 += __shfl_xor(a2, 32); a3 += __shfl_xor(a3, 32); a4 += __shfl_xor(a4, 32);
    if (kh == 0) { red[(wid * 5 + 0) * 32 + col] = a0; red[(wid * 5 + 1) * 32 + col] = a1; red[(wid * 5 + 2) * 32 + col] = a2; red[(wid * 5 + 3) * 32 + col] = a3; red[(wid * 5 + 4) * 32 + col] = a4; }
    __syncthreads();
    if (tid < 160) { const int r = tid >> 5, c = tid & 31; float s = 0.f;
#pragma unroll
      for (int w = 0; w < 8; ++w) s += red[(w * 5 + r) * 32 + c];
      ((float*)(ws + OFF_MOD))[r * 6144 + it * 32 + c] = s + p.in[5][it * 32 + c]; }
    __syncthreads();
  }
  __syncthreads();
  float* tile = (float*)lds;
  constexpr int NT_IN = (N1P / 64) * 32, NT = NT_IN + 3 * 1024;
  for (int t = blockIdx.x; t < NT; t += gridDim.x) {
    const float* src; bf16_t* dst; int ldsrc, n0, k0; bool perm;
    if (t < NT_IN) { src = p.in[6]; dst = (bf16_t*)(ws + OFF_WT_IN); ldsrc = N_IN; n0 = (t >> 5) * 64; k0 = (t & 31) * 64; perm = true; }
    else { int q = t - NT_IN; const int w = q >> 10; q &= 1023; src = p.in[13 + w]; dst = (bf16_t*)(ws + OFF_WT_BA + (size_t)w * SZ_W2); ldsrc = 2048; n0 = (q >> 5) * 64; k0 = (q & 31) * 64; perm = false; }
#pragma unroll
    for (int i = 0; i < 2; ++i) { const int kk = (tid >> 4) + 32 * i, nq = (tid & 15) * 4; const int oc = perm ? orig_col(n0 + nq) : n0 + nq;
      float4 v = make_float4(0.f, 0.f, 0.f, 0.f); if (oc >= 0) v = *(const float4*)(src + (size_t)(k0 + kk) * ldsrc + oc);
      float* tp = tile + kk * 65 + nq; tp[0] = v.x; tp[1] = v.y; tp[2] = v.z; tp[3] = v.w; }
    __syncthreads();
    { const int nn = tid >> 3, kq = (tid & 7) * 8; float r[8];
#pragma unroll
      for (int e = 0; e < 8; ++e) r[e] = tile[(kq + e) * 65 + nn];
      u32x4 w; w.x = cvt_pk_bf16(r[0], r[1]); w.y = cvt_pk_bf16(r[2], r[3]); w.z = cvt_pk_bf16(r[4], r[5]); w.w = cvt_pk_bf16(r[6], r[7]);
      *(u32x4*)(dst + (size_t)(n0 + nn) * 2048 + k0 + kq) = w; }
    __syncthreads();
  }
}

__device__ void phase1_ln_mod(const Params& p) {
  int tid_l = threadIdx.x; asm volatile("" : "+v"(tid_l)); const int tid = tid_l, wid = tid >> 6, lane = tid & 63;
  const float* MOD = (const float*)(p.ws + OFF_MOD); bf16_t* U = (bf16_t*)(p.ws + OFF_U);
  for (int row = blockIdx.x * 8 + wid; row < M_ALL; row += gridDim.x * 8) {
    const float* src = row < M_TOK ? p.in[0] + (size_t)row * 2048 : p.in[2] + (size_t)(row - M_TOK) * 2048;
    const float* md = MOD + (size_t)(row < M_TOK ? (row >> 13) : 4) * 6144;
    float4 v[4][2]; float s = 0.f;
#pragma unroll
    for (int g = 0; g < 4; ++g) { const float4* q = (const float4*)(src + g * 512 + lane * 8); v[g][0] = q[0]; v[g][1] = q[1];
      s += (v[g][0].x + v[g][0].y) + (v[g][0].z + v[g][0].w) + (v[g][1].x + v[g][1].y) + (v[g][1].z + v[g][1].w); }
    s = wave_sum(s); const float mu = s * (1.0f / 2048.0f); float q2 = 0.f;
#pragma unroll
    for (int g = 0; g < 4; ++g)
#pragma unroll
      for (int h = 0; h < 2; ++h) { const float a = v[g][h].x - mu, b = v[g][h].y - mu, c = v[g][h].z - mu, d = v[g][h].w - mu; q2 += (a * a + b * b) + (c * c + d * d); }
    q2 = wave_sum(q2); const float rs = rsqrtf(q2 * (1.0f / 2048.0f) + LN_EPS);
#pragma unroll
    for (int g = 0; g < 4; ++g) { const int c0 = g * 512 + lane * 8; float r[8];
#pragma unroll
      for (int h = 0; h < 2; ++h) { const float4 sh = *(const float4*)(md + c0 + 4 * h), sc = *(const float4*)(md + 2048 + c0 + 4 * h);
        r[4 * h + 0] = (v[g][h].x - mu) * rs * (1.0f + sc.x) + sh.x; r[4 * h + 1] = (v[g][h].y - mu) * rs * (1.0f + sc.y) + sh.y;
        r[4 * h + 2] = (v[g][h].z - mu) * rs * (1.0f + sc.z) + sh.z; r[4 * h + 3] = (v[g][h].w - mu) * rs * (1.0f + sc.w) + sh.w; }
      u32x4 w; w.x = cvt_pk_bf16(r[0], r[1]); w.y = cvt_pk_bf16(r[2], r[3]); w.z = cvt_pk_bf16(r[4], r[5]); w.w = cvt_pk_bf16(r[6], r[7]);
      *(u32x4*)(U + (size_t)row * 2048 + c0) = w; }
  }
}

__device__ __forceinline__ void unpack8(const u32x4 w, float* f) { f[0] = bflo(w.x); f[1] = bfhi(w.x); f[2] = bflo(w.y); f[3] = bfhi(w.y); f[4] = bflo(w.z); f[5] = bfhi(w.z); f[6] = bflo(w.w); f[7] = bfhi(w.w); }
__device__ __forceinline__ u32x4 pack8(const float* r) { u32x4 w; w.x = cvt_pk_bf16(r[0], r[1]); w.y = cvt_pk_bf16(r[2], r[3]); w.z = cvt_pk_bf16(r[4], r[5]); w.w = cvt_pk_bf16(r[6], r[7]); return w; }
__device__ __forceinline__ u32x4 norm_rope_head(const u32x4 raw, const float* nw, const float2* rope, int j, int pos_r, int pos_c) {
  float x[8]; unpack8(raw, x); float ss = 0.f;
#pragma unroll
  for (int e = 0; e < 8; ++e) ss += x[e] * x[e];
  ss += __shfl_xor(ss, 1); ss += __shfl_xor(ss, 2); ss += __shfl_xor(ss, 4); ss += __shfl_xor(ss, 8);
  const float rs = rsqrtf(ss * (1.0f / 128.0f) + LN_EPS);
  const float4 w0 = *(const float4*)(nw + 8 * j), w1 = *(const float4*)(nw + 8 * j + 4);
  x[0] *= rs * w0.x; x[1] *= rs * w0.y; x[2] *= rs * w0.z; x[3] *= rs * w0.w; x[4] *= rs * w1.x; x[5] *= rs * w1.y; x[6] *= rs * w1.z; x[7] *= rs * w1.w;
  float o[8];
  const bool is_x1 = ((j >> 2) & 1) == 0; const int pos = (j < 8) ? pos_r : pos_c; const int fi = 8 * (j & 3);
#pragma unroll
  for (int e = 0; e < 8; ++e) { const float pv = __shfl_xor(x[e], 4);
    if (pos_r >= 0) { const float2 cs = rope[pos * 32 + fi + e]; o[e] = is_x1 ? (x[e] * cs.x - pv * cs.y) : (pv * cs.y + x[e] * cs.x); }
    else o[e] = x[e]; }
  return pack8(o);
}
__device__ void phase3_elem(const Params& p) {
  int tid_l = threadIdx.x; asm volatile("" : "+v"(tid_l)); const int tid = tid_l, wid = tid >> 6, lane = tid & 63;
  unsigned char* ws = p.ws;
  { const bf16_t* X = (const bf16_t*)(ws + OFF_QKPRE); bf16_t* Y = (bf16_t*)(ws + OFF_QAKA); const float* cw = p.in[8]; const float* cb = p.in[9];
    const int c8 = (tid & 255) * 8; const int rsub = tid >> 8;
    float w0[8], w1[8], w2[8], bb[8];
#pragma unroll
    for (int e = 0; e < 8; ++e) { w0[e] = cw[c8 + e]; w1[e] = cw[2048 + c8 + e]; w2[e] = cw[4096 + c8 + e]; bb[e] = cb[c8 + e]; }
    const float sc = c8 >= 1024 ? 0.08838834764831845f : 1.0f;
    const int rstep = (int)gridDim.x * 2;
    for (int row0 = (int)blockIdx.x * 2 + rsub; row0 < M_ALL; row0 += 4 * rstep) {
      u32x4 cu[4], pr[4], nx[4]; const u32x4 z = {0u, 0u, 0u, 0u};
#pragma unroll
      for (int u = 0; u < 4; ++u) { const int row = row0 + u * rstep; cu[u] = z; pr[u] = z; nx[u] = z;
        if (row < M_ALL) { bool first, last; if (row < M_TOK) { const int s = row & (SEQ - 1); first = s == 0; last = s == SEQ - 1; } else { const int t = (row - M_TOK) & (CTXL - 1); first = t == 0; last = t == CTXL - 1; }
          cu[u] = *(const u32x4*)(X + (size_t)row * 2048 + c8);
          if (!first) pr[u] = *(const u32x4*)(X + (size_t)(row - 1) * 2048 + c8);
          if (!last) nx[u] = *(const u32x4*)(X + (size_t)(row + 1) * 2048 + c8); } }
#pragma unroll
      for (int u = 0; u < 4; ++u) { const int row = row0 + u * rstep;
        if (row < M_ALL) { float a[8], b[8], c[8], r[8]; unpack8(pr[u], a); unpack8(cu[u], b); unpack8(nx[u], c);
#pragma unroll
          for (int e = 0; e < 8; ++e) { const float y = bb[e] + a[e] * w0[e] + b[e] * w1[e] + c[e] * w2[e]; r[e] = siluf_(y) * sc; }
          *(u32x4*)(Y + (size_t)row * 2048 + c8) = pack8(r); } } } }
  const float2* rope = (const float2*)(ws + OFF_ROPE);
  const int j = lane & 15, hl = lane >> 4;
  { const bf16_t* X = (const bf16_t*)(ws + OFF_KBRAW); bf16_t* Y = (bf16_t*)(ws + OFF_KALL); const int step = (int)gridDim.x * 8;
    for (int row0 = blockIdx.x * 8 + wid; row0 < M_ALL; row0 += 4 * step) {
      u32x4 raw[4];
#pragma unroll
      for (int u = 0; u < 4; ++u) { const int row = row0 + u * step; raw[u] = (u32x4){0u, 0u, 0u, 0u}; if (row < M_ALL) raw[u] = *(const u32x4*)(X + (size_t)row * 512 + hl * 128 + j * 8); }
#pragma unroll
      for (int u = 0; u < 4; ++u) { const int row = row0 + u * step; if (row < M_ALL) {
        size_t drow; int pr = -1, pc = -1;
        if (row < M_TOK) { const int b = row >> 13, s = row & (SEQ - 1); drow = (size_t)b * SKV + CTXL + s; pr = s >> 6; pc = s & 63; }
        else { const int b = (row - M_TOK) >> 8, t = (row - M_TOK) & (CTXL - 1); drow = (size_t)b * SKV + t; }
        *(u32x4*)(Y + drow * 512 + hl * 128 + j * 8) = norm_rope_head(raw[u], p.in[12], rope, j, pr, pc); } } } }
  { bf16_t* X = (bf16_t*)(ws + OFF_QB); const int step = (int)gridDim.x * 8;
    for (int it0 = blockIdx.x * 8 + wid; it0 < M_TOK * 4; it0 += 4 * step) {
      u32x4 raw[4];
#pragma unroll
      for (int u = 0; u < 4; ++u) { const int it = it0 + u * step; raw[u] = (u32x4){0u, 0u, 0u, 0u};
        if (it < M_TOK * 4) raw[u] = *(const u32x4*)(X + (size_t)(it >> 2) * 2048 + ((it & 3) * 4 + hl) * 128 + j * 8); }
#pragma unroll
      for (int u = 0; u < 4; ++u) { const int it = it0 + u * step; if (it < M_TOK * 4) { const int row = it >> 2, s = row & (SEQ - 1);
        *(u32x4*)(X + (size_t)row * 2048 + ((it & 3) * 4 + hl) * 128 + j * 8) = norm_rope_head(raw[u], p.in[11], rope, j, s >> 6, s & 63); } } } }
}

__device__ void phase5_gate(const Params& p) {
  int tid_l = threadIdx.x; asm volatile("" : "+v"(tid_l)); const int tid = tid_l, wid = tid >> 6, lane = tid & 63;
  const bf16_t* HF = (const bf16_t*)(p.ws + OFF_HF); const bf16_t* HB = (const bf16_t*)(p.ws + OFF_HB); bf16_t* OZ = (bf16_t*)(p.ws + OFF_OZ);
  const float* nw = p.in[10];
  const int j = lane & 31, hl = lane >> 5; const int step = (int)gridDim.x * 8;
  for (int it0 = blockIdx.x * 8 + wid; it0 < M_TOK * 4; it0 += 4 * step) {
    u32x4 ha[4], hb[4], gz[4];
#pragma unroll
    for (int u = 0; u < 4; ++u) { const int it = it0 + u * step; ha[u] = (u32x4){0u, 0u, 0u, 0u}; hb[u] = ha[u]; gz[u] = ha[u];
      if (it < M_TOK * 4) { const size_t off = (size_t)(it >> 2) * 2048 + ((it & 3) * 2 + hl) * 256 + j * 8;
        ha[u] = *(const u32x4*)(HF + off); hb[u] = *(const u32x4*)(HB + off); gz[u] = *(const u32x4*)(OZ + off); } }
#pragma unroll
    for (int u = 0; u < 4; ++u) { const int it = it0 + u * step; if (it < M_TOK * 4) {
      const size_t off = (size_t)(it >> 2) * 2048 + ((it & 3) * 2 + hl) * 256 + j * 8;
      float a[8], b[8], g[8], r[8]; unpack8(ha[u], a); unpack8(hb[u], b); unpack8(gz[u], g);
      float ss = 0.f;
#pragma unroll
      for (int e = 0; e < 8; ++e) { a[e] += b[e]; ss += a[e] * a[e]; }
      ss += __shfl_xor(ss, 1); ss += __shfl_xor(ss, 2); ss += __shfl_xor(ss, 4); ss += __shfl_xor(ss, 8); ss += __shfl_xor(ss, 16);
      const float rs = rsqrtf(ss * (1.0f / 256.0f) + LN_EPS);
      const float* w = nw + ((it & 3) * 2 + hl) * 256 + j * 8;
#pragma unroll
      for (int e = 0; e < 8; ++e) r[e] = a[e] * rs * w[e] * g[e];
      *(u32x4*)(OZ + off) = pack8(r); } }
  }
}

__device__ void phase8_final_ln(const Params& p) {
  int tid_l = threadIdx.x; asm volatile("" : "+v"(tid_l)); const int tid = tid_l, wid = tid >> 6, lane = tid & 63;
  const float* lw = p.in[16]; const float* lb = p.in[17];
  for (int row = blockIdx.x * 8 + wid; row < M_TOK; row += gridDim.x * 8) {
    float4* r = (float4*)(p.out + (size_t)row * 2048);
    float4 v[8]; float s = 0.f;
#pragma unroll
    for (int i = 0; i < 8; ++i) { v[i] = r[lane + 64 * i]; s += (v[i].x + v[i].y) + (v[i].z + v[i].w); }
    s = wave_sum(s); const float mu = s * (1.f / 2048.f); float q = 0.f;
#pragma unroll
    for (int i = 0; i < 8; ++i) { const float a = v[i].x - mu, b = v[i].y - mu, c = v[i].z - mu, d = v[i].w - mu; q += (a * a + b * b) + (c * c + d * d); }
    q = wave_sum(q); const float rs = rsqrtf(q * (1.f / 2048.f) + LN_EPS);
#pragma unroll
    for (int i = 0; i < 8; ++i) { const float4 w = ((const float4*)lw)[lane + 64 * i], b = ((const float4*)lb)[lane + 64 * i];
      float4 y; y.x = (v[i].x - mu) * rs * w.x + b.x; y.y = (v[i].y - mu) * rs * w.y + b.y; y.z = (v[i].z - mu) * rs * w.z + b.z; y.w = (v[i].w - mu) * rs * w.w + b.w;
      r[lane + 64 * i] = y; }
  }
}

namespace att {
constexpr int D = 128, NW = 8, QBLK = 32, KVBLK = 64;
constexpr float SCALE = 0.088388347648318440f;
constexpr float THR = 8.f;
constexpr int LDQ = 2048, LDK = 512;
constexpr size_t SHM_V = KVBLK * D * 2, SHM_K = KVBLK * D * 2, SHM_ATTN = 2 * SHM_V + 2 * SHM_K + NW * 64 * 4;
#define KSWZ(row, colB) ((row) * 256 + ((colB) ^ (((row) & 7) << 4)))
#define SBAR() __builtin_amdgcn_sched_barrier(0)
__device__ __forceinline__ int crow(int r, int hi) { return (r & 3) + 8 * (r >> 2) + 4 * hi; }
__device__ __forceinline__ unsigned cvtpk(float lo, float hi) { unsigned r; asm volatile("v_cvt_pk_bf16_f32 %0, %1, %2" : "=v"(r) : "v"(lo), "v"(hi)); return r; }
__device__ __forceinline__ void partialSM(f32x16& p0, f32x16& p1, float& m_reg, float& mn, float& alpha) {
  constexpr float C = SCALE * 1.4426950408889634f;
  float pmax = p0[0]; for (int r = 1; r < 16; ++r) pmax = fmaxf(pmax, p0[r]); for (int r = 0; r < 16; ++r) pmax = fmaxf(pmax, p1[r]);
  { auto rr = __builtin_amdgcn_permlane32_swap(__float_as_uint(pmax), __float_as_uint(pmax), false, false);
    pmax = fmaxf(__uint_as_float(rr[0]), __uint_as_float(rr[1])); }
  if (__builtin_expect(__all(pmax - m_reg <= THR / SCALE), 1)) { mn = m_reg; alpha = 1.f; }
  else { mn = fmaxf(m_reg, pmax); alpha = __builtin_amdgcn_exp2f((m_reg - mn) * C); m_reg = mn; }
  float mnC = -mn * C;
  for (int r = 0; r < 16; ++r) p0[r] = fmaf(p0[r], C, mnC); for (int r = 0; r < 16; ++r) p1[r] = fmaf(p1[r], C, mnC);
  for (int r = 0; r < 16; ++r) p0[r] = __builtin_amdgcn_exp2f(p0[r]);
}
__device__ __forceinline__ void finishSM(f32x16& p0, f32x16& p1, float alpha, float& l_reg, bf16x8& pa0, bf16x8& pa1, bf16x8& pa2, bf16x8& pa3) {
  for (int r = 0; r < 16; ++r) p1[r] = __builtin_amdgcn_exp2f(p1[r]);
  float ps = 0; for (int r = 0; r < 16; ++r) ps += p0[r]; for (int r = 0; r < 16; ++r) ps += p1[r];
  { auto rr = __builtin_amdgcn_permlane32_swap(__float_as_uint(ps), __float_as_uint(ps), false, false);
    ps = __uint_as_float(rr[0]) + __uint_as_float(rr[1]); }
  l_reg = l_reg * alpha + ps;
#define PK4(P, BASE, OUT) do { unsigned a0 = cvtpk(P[BASE + 0], P[BASE + 1]), a1 = cvtpk(P[BASE + 2], P[BASE + 3]);   \
    unsigned b0 = cvtpk(P[BASE + 4], P[BASE + 5]), b1 = cvtpk(P[BASE + 6], P[BASE + 7]);                              \
    auto r0 = __builtin_amdgcn_permlane32_swap(a0, b0, false, false); auto r1 = __builtin_amdgcn_permlane32_swap(a1, b1, false, false); \
    u32x4 w = {r0[0], r1[0], r0[1], r1[1]}; OUT = *reinterpret_cast<bf16x8*>(&w); } while (0)
  PK4(p0, 0, pa0); PK4(p0, 8, pa1); PK4(p1, 0, pa2); PK4(p1, 8, pa3);
#undef PK4
}
__device__ __forceinline__ void qkt(f32x16& p0, f32x16& p1, const char* Ks, const bf16x8* qr, int r32, int hi) {
  p0 = f32x16{}; p1 = f32x16{};
  for (int d0 = 0; d0 < 8; ++d0) { int cb = (d0 * 16 + hi * 8) * 2;
    bf16x8 b0 = *reinterpret_cast<const bf16x8*>(Ks + KSWZ(r32, cb));
    bf16x8 b1 = *reinterpret_cast<const bf16x8*>(Ks + KSWZ(32 + r32, cb));
    p0 = __builtin_amdgcn_mfma_f32_32x32x16_bf16(b0, qr[d0], p0, 0, 0, 0);
    p1 = __builtin_amdgcn_mfma_f32_32x32x16_bf16(b1, qr[d0], p1, 0, 0, 0); }
}
__device__ __forceinline__ int v_st(int k, int c) { const int kk = (k & ~0xC) | ((k & 4) << 1) | ((k & 8) >> 1); return ((kk >> 3) * 4 + (c >> 5)) * 512 + ((kk & 7) * 32 + (c & 31)) * 2; }
__device__ __forceinline__ int v_rd_base(int lane) { return ((lane & 3) << 3) | (((lane >> 2) & 3) << 6) | (((lane >> 4) & 1) << 5) | (((lane >> 5) & 1) << 8); }
constexpr int v_rd_off(int d0, int ks, int half) { return d0 * 512 + ks * 4096 + half * 2048; }
template <int OFF> __device__ __forceinline__ s16x4 tr_read(int vb) {
  s16x4 r; asm volatile("ds_read_b64_tr_b16 %0, %1 offset:%2" : "=&v"(r) : "v"(vb), "i"(OFF) : "memory"); return r;
}
#define PKLH(L, H) (bf16x8){L[0], L[1], L[2], L[3], H[0], H[1], H[2], H[3]}
template <int D0> __device__ __forceinline__ void pv_one(f32x16& od, int vb, bf16x8 pa0, bf16x8 pa1, bf16x8 pa2, bf16x8 pa3) {
  const s16x4 l0 = tr_read<v_rd_off(D0, 0, 0)>(vb), h0 = tr_read<v_rd_off(D0, 0, 1)>(vb), l1 = tr_read<v_rd_off(D0, 1, 0)>(vb), h1 = tr_read<v_rd_off(D0, 1, 1)>(vb);
  const s16x4 l2 = tr_read<v_rd_off(D0, 2, 0)>(vb), h2 = tr_read<v_rd_off(D0, 2, 1)>(vb), l3 = tr_read<v_rd_off(D0, 3, 0)>(vb), h3 = tr_read<v_rd_off(D0, 3, 1)>(vb);
  asm volatile("s_waitcnt lgkmcnt(0)" ::: "memory"); SBAR();
  od = __builtin_amdgcn_mfma_f32_32x32x16_bf16(pa0, PKLH(l0, h0), od, 0, 0, 0);
  od = __builtin_amdgcn_mfma_f32_32x32x16_bf16(pa1, PKLH(l1, h1), od, 0, 0, 0);
  od = __builtin_amdgcn_mfma_f32_32x32x16_bf16(pa2, PKLH(l2, h2), od, 0, 0, 0);
  od = __builtin_amdgcn_mfma_f32_32x32x16_bf16(pa3, PKLH(l3, h3), od, 0, 0, 0);
}
__device__ __forceinline__ void pv_d0(f32x16* o, int vb, bf16x8 pa0, bf16x8 pa1, bf16x8 pa2, bf16x8 pa3) {
  pv_one<0>(o[0], vb, pa0, pa1, pa2, pa3); pv_one<1>(o[1], vb, pa0, pa1, pa2, pa3); pv_one<2>(o[2], vb, pa0, pa1, pa2, pa3); pv_one<3>(o[3], vb, pa0, pa1, pa2, pa3);
}
__device__ __forceinline__ void attn_dense_body(bf16_t* __restrict__ Qb, const bf16_t* __restrict__ Kh, const bf16_t* __restrict__ Vh, int seq, char* lds) {
  int tid_l = threadIdx.x; asm volatile("" : "+v"(tid_l)); const int tid = tid_l, wid = tid >> 6, lane = tid & 63, r32 = lane & 31, hi = lane >> 5;
  char* V_lds = lds; char* K_lds = lds + 2 * SHM_V;
  float* wsf = (float*)(lds + 2 * SHM_V + 2 * SHM_K) + wid * 64; float* li_l = wsf; float* al_l = wsf + 32;
  float m_reg = -1e30f, l_reg = 0; f32x16 o[4] = {}; bf16x8 qr[8];
  const bf16_t* Qw = Qb + (long)(wid * QBLK + r32) * LDQ + hi * 8;
#pragma unroll
  for (int d0 = 0; d0 < 8; ++d0) qr[d0] = *reinterpret_cast<const bf16x8*>(Qw + d0 * 16);
  const int sr = tid >> 4, sc = (tid & 15) * 8, vst0 = v_st(sr, sc), vst1 = v_st(32 + sr, sc);
  const int vb0 = (int)(uintptr_t)V_lds + v_rd_base(lane);
  struct { bf16x8 vs0, vs1, ks0, ks1; } sr_[1];
#define SLOAD(i, k0) do { sr_[i].vs0 = *reinterpret_cast<const bf16x8*>(&Vh[(long)((k0) + sr) * LDK + sc]); sr_[i].vs1 = *reinterpret_cast<const bf16x8*>(&Vh[(long)((k0) + 32 + sr) * LDK + sc]); \
    sr_[i].ks0 = *reinterpret_cast<const bf16x8*>(&Kh[(long)((k0) + sr) * LDK + sc]); sr_[i].ks1 = *reinterpret_cast<const bf16x8*>(&Kh[(long)((k0) + 32 + sr) * LDK + sc]); } while (0)
#define SWRITE(b, i) do { *(bf16x8*)(V_lds + (b) * SHM_V + vst0) = sr_[i].vs0;          \
    *(bf16x8*)(V_lds + (b) * SHM_V + vst1) = sr_[i].vs1; int kc = sc * 2;               \
    *(bf16x8*)(K_lds + (b) * SHM_K + KSWZ(sr, kc)) = sr_[i].ks0;                       \
    *(bf16x8*)(K_lds + (b) * SHM_K + KSWZ(32 + sr, kc)) = sr_[i].ks1; } while (0)
#define SWAIT() asm volatile("s_waitcnt vmcnt(0)" ::: "memory")
#define RESC(a) do { if (__any((a) < 1.f)) { if (hi == 0) al_l[r32] = (a); asm volatile("s_waitcnt lgkmcnt(0)" ::: "memory"); \
    for (int d = 0; d < 4; ++d) for (int r = 0; r < 16; ++r) o[d][r] *= al_l[crow(r, hi)]; } } while (0)
  f32x16 pA0, pA1, pB0, pB1; float mnA, mnB, alA, alB; bf16x8 pa0, pa1, pa2, pa3; const int NT = seq / KVBLK;
  constexpr int SE = 0, SO = 0;
  SLOAD(SE, 0); asm volatile("s_waitcnt vmcnt(0)" ::: "memory"); SWRITE(0, SE); __syncthreads();
  qkt(pA0, pA1, K_lds, qr, r32, hi); partialSM(pA0, pA1, m_reg, mnA, alA);
  SLOAD(SO, KVBLK);
  SWAIT(); SWRITE(1, SO); __syncthreads();
  for (int j = 1; j + 1 < NT; j += 2) {
    SBAR(); qkt(pB0, pB1, K_lds + SHM_K, qr, r32, hi);
    finishSM(pA0, pA1, alA, l_reg, pa0, pa1, pa2, pa3); SBAR();
    SLOAD(SO, (j + 1) * KVBLK); SBAR();
    pv_d0(o, vb0, pa0, pa1, pa2, pa3); partialSM(pB0, pB1, m_reg, mnB, alB);
    __syncthreads(); SWAIT(); SWRITE(0, SE);
    RESC(alB); __syncthreads();
    SBAR(); qkt(pA0, pA1, K_lds, qr, r32, hi);
    finishSM(pB0, pB1, alB, l_reg, pa0, pa1, pa2, pa3); SBAR();
    SLOAD(SE, (j + 2) * KVBLK); SBAR();
    pv_d0(o, vb0 + (int)SHM_V, pa0, pa1, pa2, pa3); partialSM(pA0, pA1, m_reg, mnA, alA);
    __syncthreads(); SWAIT(); SWRITE(1, SO);
    RESC(alA); __syncthreads();
  }
  SBAR(); qkt(pB0, pB1, K_lds + SHM_K, qr, r32, hi);
  finishSM(pA0, pA1, alA, l_reg, pa0, pa1, pa2, pa3); SBAR();
  pv_d0(o, vb0, pa0, pa1, pa2, pa3); partialSM(pB0, pB1, m_reg, mnB, alB);
  __syncthreads(); RESC(alB);
  finishSM(pB0, pB1, alB, l_reg, pa0, pa1, pa2, pa3); SBAR();
  pv_d0(o, vb0 + (int)SHM_V, pa0, pa1, pa2, pa3);
  if (hi == 0) li_l[r32] = l_reg; asm volatile("s_waitcnt lgkmcnt(0)" ::: "memory");
  float rli[16];
#pragma unroll
  for (int r = 0; r < 16; ++r) rli[r] = __builtin_amdgcn_rcpf(li_l[crow(r, hi)]);
  bf16_t* qo = Qb + (long)(wid * QBLK + 4 * hi) * LDQ + r32; const bf16_t* zo = qo + (long)((OFF_ZB - OFF_QB) / 2);
  unsigned short zz[64];
#pragma unroll
  for (int r = 0; r < 16; ++r) { const int ro = ((r & 3) + 8 * (r >> 2)) * LDQ;
    zz[4 * r] = zo[ro]; zz[4 * r + 1] = zo[ro + 32]; zz[4 * r + 2] = zo[ro + 64]; zz[4 * r + 3] = zo[ro + 96]; }
  asm volatile("" ::: "memory");
#pragma unroll
  for (int r = 0; r < 16; ++r) { const int ro = ((r & 3) + 8 * (r >> 2)) * LDQ;
    const float v0 = o[0][r] * rli[r] * bf2f(zz[4 * r]), v1 = o[1][r] * rli[r] * bf2f(zz[4 * r + 1]), v2 = o[2][r] * rli[r] * bf2f(zz[4 * r + 2]), v3 = o[3][r] * rli[r] * bf2f(zz[4 * r + 3]);
    qo[ro] = (bf16_t)(cvtpk(v0, v0) & 0xffffu); qo[ro + 32] = (bf16_t)(cvtpk(v1, v1) & 0xffffu); qo[ro + 64] = (bf16_t)(cvtpk(v2, v2) & 0xffffu); qo[ro + 96] = (bf16_t)(cvtpk(v3, v3) & 0xffffu); }
#undef SLOAD
#undef SWRITE
#undef SWAIT
#undef RESC
}
}

namespace ml {
using att::crow; using att::cvtpk; using att::v_st; using att::v_rd_base; using att::v_rd_off; using att::tr_read;
constexpr int O_QS = 0, O_KS = 17408, O_C0 = 34816, O_KTR = 69632, O_VTR = 86016, O_VW = 102400, O_SP = 118784, O_F = 128000;
constexpr int NCH = 132;
template <int KS> __device__ __forceinline__ bf16x8 trfrag(int vb) {
  const s16x4 l = tr_read<v_rd_off(0, KS, 0)>(vb), h = tr_read<v_rd_off(0, KS, 1)>(vb);
  asm volatile("s_waitcnt lgkmcnt(0)" ::: "memory"); SBAR();
  return PKLH(l, h);
}
__device__ __forceinline__ bf16x8 scale_frag(bf16x8 v, const float* we) {
  const u32x4 w = *reinterpret_cast<const u32x4*>(&v); float f[8]; unpack8(w, f);
  const float4 s0 = *(const float4*)we, s1 = *(const float4*)(we + 4);
  f[0] *= s0.x; f[1] *= s0.y; f[2] *= s0.z; f[3] *= s0.w; f[4] *= s1.x; f[5] *= s1.y; f[6] *= s1.z; f[7] *= s1.w;
  const u32x4 o = pack8(f); return *reinterpret_cast<const bf16x8*>(&o);
}
__device__ __forceinline__ int chunk_row0(int c, int b, bool rev) {
  if (!rev) return c < 4 ? M_TOK + b * CTXL + 64 * c : b * SEQ + 64 * (c - 4);
  return c < 4 ? M_TOK + b * CTXL + 64 * (3 - c) : b * SEQ + 64 * (131 - c);
}
__device__ __forceinline__ void gate_scan(float gi, float gf, float bi, float bfb, float& m0, float* S, int lane, int jn) {
  const float li = gi + bi, xf = gf + bfb; const float lf = fminf(xf, 0.f) - __logf(1.0f + __expf(-fabsf(xf)));
  float bb = lf;
#define DPP_F(x, old, ctrl, rmask, bc) __int_as_float(__builtin_amdgcn_update_dpp(__float_as_int(old), __float_as_int(x), ctrl, rmask, 0xf, bc))
  bb += DPP_F(bb, 0.f, 0x111, 0xf, true); bb += DPP_F(bb, 0.f, 0x112, 0xf, true); bb += DPP_F(bb, 0.f, 0x114, 0xf, true); bb += DPP_F(bb, 0.f, 0x118, 0xf, true);
  bb += DPP_F(bb, 0.f, 0x142, 0xa, true); bb += DPP_F(bb, 0.f, 0x143, 0xc, true);
  const float g = li - bb; float cm = g; const float NI = -3.0e38f;
  cm = fmaxf(cm, DPP_F(cm, NI, 0x111, 0xf, false)); cm = fmaxf(cm, DPP_F(cm, NI, 0x112, 0xf, false)); cm = fmaxf(cm, DPP_F(cm, NI, 0x114, 0xf, false)); cm = fmaxf(cm, DPP_F(cm, NI, 0x118, 0xf, false));
  cm = fmaxf(cm, DPP_F(cm, NI, 0x142, 0xa, false)); cm = fmaxf(cm, DPP_F(cm, NI, 0x143, 0xc, false));
#undef DPP_F
  const float Mx = fmaxf(m0, cm), m = bb + Mx, a = __expf(m0 - Mx), em = __expf(-m);
  const float bL = __int_as_float(__builtin_amdgcn_readlane(__float_as_int(bb), 63)), ML = __int_as_float(__builtin_amdgcn_readlane(__float_as_int(Mx), 63)), aend = __int_as_float(__builtin_amdgcn_readlane(__float_as_int(a), 63));
  S[jn] = g; S[64 + jn] = Mx; S[128 + jn] = a; S[192 + jn] = em; S[256 + jn] = __expf(g - ML); if (lane == 0) S[320] = aend;
  m0 = bL + ML;
}
__device__ void mlstm_scan(const Params& p, char* lds, int item) {
  int tid_l = threadIdx.x; asm volatile("" : "+v"(tid_l)); const int tid = tid_l, wid = __builtin_amdgcn_readfirstlane(tid >> 6), lane = tid & 63, r32 = lane & 31, hi = lane >> 5;
  const int dir = item & 1, vs = (item >> 1) & 1, bh = item >> 2, b = bh >> 3, h = bh & 7;
  const bool rev = dir != 0, flip = !rev;
  const bf16_t* QK = (const bf16_t*)(p.ws + OFF_QAKA); const bf16_t* VA = (const bf16_t*)(p.ws + OFF_VA); const float* GT = (const float*)(p.ws + OFF_GATES);
  bf16_t* H = (bf16_t*)(p.ws + (rev ? OFF_HB : OFF_HF));
  float* F = (float*)(lds + O_F); float *NQ = F + 768, *RS = F + 832, *N0 = F + 960, *GSL = F + 1088, *PN = F + 1216;
  for (int i = tid; i < 128 * 272 / 4; i += 512) ((unsigned*)(lds + O_C0))[i] = 0u;
  if (tid < 128) N0[tid] = 0.f;
  f32x16 cacc0 = {}, cacc1 = {}; f32x16 acc1 = {}; float nreg = 0.f, m0 = -1e30f, aend_prev = 0.f; bool npend = false;
  const float bi = p.in[7][dir * 16 + h], bfb = p.in[7][dir * 16 + 8 + h];
  const int qrow0 = tid >> 4, qc = (tid & 15) * 8;
  const int jnat = 63 - lane, jg = flip ? lane : jnat;
  bf16x8 q0, q1, k0, k1, v0, v1; float gi1 = 0.f, gf1 = 0.f;
  u32x2 hw0 = {0u, 0u}, hw1 = {0u, 0u}, hw2 = {0u, 0u}, hw3 = {0u, 0u}; bf16_t* hpend = nullptr;
  { const int R0 = chunk_row0(0, b, rev); const bf16_t* qp = QK + (size_t)(R0 + qrow0) * 2048 + h * 128 + qc; const bf16_t* vp = VA + (size_t)(R0 + qrow0) * 2048 + h * 256 + vs * 128 + qc;
    q0 = *(const bf16x8*)qp; q1 = *(const bf16x8*)(qp + 32 * 2048); k0 = *(const bf16x8*)(qp + 1024); k1 = *(const bf16x8*)(qp + 1024 + 32 * 2048);
    v0 = *(const bf16x8*)vp; v1 = *(const bf16x8*)(vp + 32 * 2048);
    if (wid == 0) { const float g0i = GT[(size_t)(R0 + jg) * 32 + dir * 16 + h], g0f = GT[(size_t)(R0 + jg) * 32 + dir * 16 + 8 + h];
      const int R1 = chunk_row0(1, b, rev); gi1 = GT[(size_t)(R1 + jg) * 32 + dir * 16 + h]; gf1 = GT[(size_t)(R1 + jg) * 32 + dir * 16 + 8 + h];
      gate_scan(g0i, g0f, bi, bfb, m0, F, lane, jnat); } }
  const int w4 = wid & 3, t_hi = w4 >> 1, t_lo = w4 & 1;
  const int vt = wid >> 1, jt = wid & 1;
  for (int c = 0; c < NCH; ++c) {
    const int R0 = chunk_row0(c, b, rev); const bool isctx = c < 4;
    float* S = F + (c & 1) * 384; float *G = S, *MX = S + 64, *A = S + 128, *EM = S + 192, *WE = S + 256;
    __syncthreads();
    { const int ra = flip ? 63 - qrow0 : qrow0, rb = flip ? 31 - qrow0 : qrow0 + 32;
    *(bf16x8*)(lds + O_QS + ra * 272 + qc * 2) = q0; *(bf16x8*)(lds + O_QS + rb * 272 + qc * 2) = q1;
    *(bf16x8*)(lds + O_KS + ra * 272 + qc * 2) = k0; *(bf16x8*)(lds + O_KS + rb * 272 + qc * 2) = k1;
    *(bf16x8*)(lds + O_KTR + v_st(ra, qc)) = k0; *(bf16x8*)(lds + O_KTR + v_st(rb, qc)) = k1;
    *(bf16x8*)(lds + O_VTR + v_st(ra, qc)) = v0; *(bf16x8*)(lds + O_VTR + v_st(rb, qc)) = v1;
    { const float wa = WE[ra], wb = WE[rb]; float f[8];
      unpack8(*reinterpret_cast<const u32x4*>(&v0), f);
#pragma unroll
      for (int e = 0; e < 8; ++e) f[e] *= wa;
      *(u32x4*)(lds + O_VW + v_st(ra, qc)) = pack8(f);
      unpack8(*reinterpret_cast<const u32x4*>(&v1), f);
#pragma unroll
      for (int e = 0; e < 8; ++e) f[e] *= wb;
      *(u32x4*)(lds + O_VW + v_st(rb, qc)) = pack8(f); } }
    if (hpend) { *(u32x2*)(hpend) = hw0; *(u32x2*)(hpend + 8) = hw1; *(u32x2*)(hpend + 16) = hw2; *(u32x2*)(hpend + 24) = hw3; hpend = nullptr; }
    if (npend && tid < 128) { nreg = aend_prev * nreg + ((PN[tid] + PN[128 + tid]) + (PN[256 + tid] + PN[384 + tid])); N0[tid] = nreg; }
    npend = true;
    if (wid == 0) { GSL[lane] = gi1; GSL[64 + lane] = gf1;
      if (c + 2 < NCH) { const int R2 = chunk_row0(c + 2, b, rev); gi1 = GT[(size_t)(R2 + jg) * 32 + dir * 16 + h]; gf1 = GT[(size_t)(R2 + jg) * 32 + dir * 16 + 8 + h]; } }
    if (c + 1 < NCH) { const int R1 = chunk_row0(c + 1, b, rev); const bf16_t* qp = QK + (size_t)(R1 + qrow0) * 2048 + h * 128 + qc; const bf16_t* vp = VA + (size_t)(R1 + qrow0) * 2048 + h * 256 + vs * 128 + qc;
      q0 = *(const bf16x8*)qp; q1 = *(const bf16x8*)(qp + 32 * 2048); k0 = *(const bf16x8*)(qp + 1024); k1 = *(const bf16x8*)(qp + 1024 + 32 * 2048);
      v0 = *(const bf16x8*)vp; v1 = *(const bf16x8*)(vp + 32 * 2048); }
    __syncthreads();
    if (wid < 4) {
      f32x16 pS = {};
      const char* ka = lds + O_KS + (32 * t_hi + r32) * 272 + hi * 16; const char* qb = lds + O_QS + (32 * t_lo + r32) * 272 + hi * 16;
#pragma unroll
      for (int d0 = 0; d0 < 8; ++d0) pS = __builtin_amdgcn_mfma_f32_32x32x16_bf16(*(const bf16x8*)(ka + d0 * 32), *(const bf16x8*)(qb + d0 * 32), pS, 0, 0, 0);
      const int j = 32 * t_lo + r32; const float mxj = MX[j]; float ps = 0.f;
#pragma unroll
      for (int r = 0; r < 16; ++r) { const int s = 32 * t_hi + crow(r, hi); const bool ok = (s >= j);
        const float arg = ok ? (G[s] - mxj) : -1e30f; const float wv = __builtin_amdgcn_exp2f(arg * 1.4426950408889634f); pS[r] *= wv; ps += pS[r]; }
      ps += __shfl_xor(ps, 32); if (hi == 0) RS[t_hi * 64 + j] = ps;
#pragma unroll
      for (int g4 = 0; g4 < 4; ++g4) { u32x2 w; w.x = cvtpk(pS[4 * g4], pS[4 * g4 + 1]); w.y = cvtpk(pS[4 * g4 + 2], pS[4 * g4 + 3]);
        *(u32x2*)(lds + O_SP + j * 144 + (32 * t_hi + 8 * g4 + 4 * hi) * 2) = w; }
    } else {
      const int t4 = tid - 256, jq = t4 >> 2, part = t4 & 3; float sum = 0.f;
      const char* qrow = lds + O_QS + jq * 272 + part * 64;
#pragma unroll
      for (int i = 0; i < 4; ++i) { float f[8]; unpack8(*(const u32x4*)(qrow + 16 * i), f);
#pragma unroll
        for (int e = 0; e < 8; ++e) sum += f[e] * N0[part * 32 + 8 * i + e]; }
      sum += __shfl_xor(sum, 1); sum += __shfl_xor(sum, 2); if (part == 0) NQ[jq] = sum;
    }
    { acc1 = f32x16{};
      const char* ca = lds + O_C0 + (32 * vt + r32) * 272 + hi * 16; const char* qb = lds + O_QS + (32 * jt + r32) * 272 + hi * 16;
#pragma unroll
      for (int d0 = 0; d0 < 8; ++d0) acc1 = __builtin_amdgcn_mfma_f32_32x32x16_bf16(*(const bf16x8*)(ca + d0 * 32), *(const bf16x8*)(qb + d0 * 32), acc1, 0, 0, 0); }
    __syncthreads();
    const float aend = S[320];
    if (wid == 0 && c + 1 < NCH) gate_scan(GSL[lane], GSL[64 + lane], bi, bfb, m0, F + ((c + 1) & 1) * 384, lane, jnat);
    {
      f32x16 acc2 = {};
      const int vbv = (int)(uintptr_t)(lds + O_VTR) + v_rd_base(lane) + vt * 512;
      const char* sb = lds + O_SP + (32 * jt + r32) * 144 + hi * 16;
      const s16x4 l0 = tr_read<v_rd_off(0, 0, 0)>(vbv), h0 = tr_read<v_rd_off(0, 0, 1)>(vbv), l1 = tr_read<v_rd_off(0, 1, 0)>(vbv), h1 = tr_read<v_rd_off(0, 1, 1)>(vbv);
      const s16x4 l2 = tr_read<v_rd_off(0, 2, 0)>(vbv), h2 = tr_read<v_rd_off(0, 2, 1)>(vbv), l3 = tr_read<v_rd_off(0, 3, 0)>(vbv), h3 = tr_read<v_rd_off(0, 3, 1)>(vbv);
      const bf16x8 s0 = *(const bf16x8*)(sb), s1 = *(const bf16x8*)(sb + 32), s2 = *(const bf16x8*)(sb + 64), s3 = *(const bf16x8*)(sb + 96);
      asm volatile("s_waitcnt lgkmcnt(0)" ::: "memory"); SBAR();
      acc2 = __builtin_amdgcn_mfma_f32_32x32x16_bf16(PKLH(l0, h0), s0, acc2, 0, 0, 0);
      acc2 = __builtin_amdgcn_mfma_f32_32x32x16_bf16(PKLH(l1, h1), s1, acc2, 0, 0, 0);
      acc2 = __builtin_amdgcn_mfma_f32_32x32x16_bf16(PKLH(l2, h2), s2, acc2, 0, 0, 0);
      acc2 = __builtin_amdgcn_mfma_f32_32x32x16_bf16(PKLH(l3, h3), s3, acc2, 0, 0, 0);
      const int j = 32 * jt + r32; const float aj = A[j]; const float den = aj * NQ[j] + RS[j] + RS[64 + j];
      const float inv = 1.0f / fmaxf(fabsf(den), EM[j]);
      if (!isctx) { hpend = H + (size_t)(R0 + (flip ? 63 - j : j)) * 2048 + h * 256 + vs * 128 + 32 * vt + 4 * hi;
#define HPK(g4) (u32x2){cvtpk((aj * acc1[4 * g4] + acc2[4 * g4]) * inv, (aj * acc1[4 * g4 + 1] + acc2[4 * g4 + 1]) * inv), cvtpk((aj * acc1[4 * g4 + 2] + acc2[4 * g4 + 2]) * inv, (aj * acc1[4 * g4 + 3] + acc2[4 * g4 + 3]) * inv)}
        hw0 = HPK(0); hw1 = HPK(1); hw2 = HPK(2); hw3 = HPK(3);
#undef HPK
      }
    }
    { const int d = tid & 127, q4 = tid >> 7; float s = 0.f;
#pragma unroll
      for (int si = 0; si < 16; ++si) s += WE[16 * q4 + si] * bf2f(*(const bf16_t*)(lds + O_KS + (16 * q4 + si) * 272 + d * 2));
      PN[q4 * 128 + d] = s; }
    aend_prev = aend;
    { const int dt = wid & 3, vp2 = (wid >> 2) * 2;
      const int kb = (int)(uintptr_t)(lds + O_KTR) + v_rd_base(lane) + dt * 512;
      const int vb2 = (int)(uintptr_t)(lds + O_VW) + v_rd_base(lane) + vp2 * 512;
      const s16x4 kl0 = tr_read<v_rd_off(0, 0, 0)>(kb), kh0 = tr_read<v_rd_off(0, 0, 1)>(kb), kl1 = tr_read<v_rd_off(0, 1, 0)>(kb), kh1 = tr_read<v_rd_off(0, 1, 1)>(kb);
      const s16x4 kl2 = tr_read<v_rd_off(0, 2, 0)>(kb), kh2 = tr_read<v_rd_off(0, 2, 1)>(kb), kl3 = tr_read<v_rd_off(0, 3, 0)>(kb), kh3 = tr_read<v_rd_off(0, 3, 1)>(kb);
      const s16x4 vl0 = tr_read<v_rd_off(0, 0, 0)>(vb2), vh0 = tr_read<v_rd_off(0, 0, 1)>(vb2), vl1 = tr_read<v_rd_off(0, 1, 0)>(vb2), vh1 = tr_read<v_rd_off(0, 1, 1)>(vb2);
      const s16x4 vl2 = tr_read<v_rd_off(0, 2, 0)>(vb2), vh2 = tr_read<v_rd_off(0, 2, 1)>(vb2), vl3 = tr_read<v_rd_off(0, 3, 0)>(vb2), vh3 = tr_read<v_rd_off(0, 3, 1)>(vb2);
      const s16x4 wl0 = tr_read<v_rd_off(1, 0, 0)>(vb2), wh0 = tr_read<v_rd_off(1, 0, 1)>(vb2), wl1 = tr_read<v_rd_off(1, 1, 0)>(vb2), wh1 = tr_read<v_rd_off(1, 1, 1)>(vb2);
      const s16x4 wl2 = tr_read<v_rd_off(1, 2, 0)>(vb2), wh2 = tr_read<v_rd_off(1, 2, 1)>(vb2), wl3 = tr_read<v_rd_off(1, 3, 0)>(vb2), wh3 = tr_read<v_rd_off(1, 3, 1)>(vb2);
      asm volatile("s_waitcnt lgkmcnt(0)" ::: "memory"); SBAR();
#pragma unroll
      for (int r = 0; r < 16; ++r) { cacc0[r] *= aend; cacc1[r] *= aend; }
      const bf16x8 ka0 = PKLH(kl0, kh0), ka1 = PKLH(kl1, kh1), ka2 = PKLH(kl2, kh2), ka3 = PKLH(kl3, kh3);
      cacc0 = __builtin_amdgcn_mfma_f32_32x32x16_bf16(ka0, PKLH(vl0, vh0), cacc0, 0, 0, 0);
      cacc1 = __builtin_amdgcn_mfma_f32_32x32x16_bf16(ka0, PKLH(wl0, wh0), cacc1, 0, 0, 0);
      cacc0 = __builtin_amdgcn_mfma_f32_32x32x16_bf16(ka1, PKLH(vl1, vh1), cacc0, 0, 0, 0);
      cacc1 = __builtin_amdgcn_mfma_f32_32x32x16_bf16(ka1, PKLH(wl1, wh1), cacc1, 0, 0, 0);
      cacc0 = __builtin_amdgcn_mfma_f32_32x32x16_bf16(ka2, PKLH(vl2, vh2), cacc0, 0, 0, 0);
      cacc1 = __builtin_amdgcn_mfma_f32_32x32x16_bf16(ka2, PKLH(wl2, wh2), cacc1, 0, 0, 0);
      cacc0 = __builtin_amdgcn_mfma_f32_32x32x16_bf16(ka3, PKLH(vl3, vh3), cacc0, 0, 0, 0);
      cacc1 = __builtin_amdgcn_mfma_f32_32x32x16_bf16(ka3, PKLH(wl3, wh3), cacc1, 0, 0, 0);
#pragma unroll
      for (int g4 = 0; g4 < 4; ++g4) { u32x2 w; w.x = cvtpk(cacc0[4 * g4], cacc0[4 * g4 + 1]); w.y = cvtpk(cacc0[4 * g4 + 2], cacc0[4 * g4 + 3]);
        *(u32x2*)(lds + O_C0 + (32 * vp2 + r32) * 272 + (32 * dt + 8 * g4 + 4 * hi) * 2) = w;
        u32x2 x; x.x = cvtpk(cacc1[4 * g4], cacc1[4 * g4 + 1]); x.y = cvtpk(cacc1[4 * g4 + 2], cacc1[4 * g4 + 3]);
        *(u32x2*)(lds + O_C0 + (32 * vp2 + 32 + r32) * 272 + (32 * dt + 8 * g4 + 4 * hi) * 2) = x; }
    }
  }
  if (hpend) { *(u32x2*)(hpend) = hw0; *(u32x2*)(hpend + 8) = hw1; *(u32x2*)(hpend + 16) = hw2; *(u32x2*)(hpend + 24) = hw3; }
  __syncthreads();
}
}

__device__ void phase4_mixers(const Params& p, char* lds) {
  bf16_t* QB = (bf16_t*)(p.ws + OFF_QB);
  const bf16_t* KA = (const bf16_t*)(p.ws + OFF_KALL); const bf16_t* VAl = (const bf16_t*)(p.ws + OFF_VALL);
  const bool sched = gridDim.x == 256; const int bx = blockIdx.x;
  for (int item = bx; item < 128; item += gridDim.x) ml::mlstm_scan(p, lds, item);
  const int nslots = sched ? 9 : (2048 + (int)gridDim.x - 1) / (int)gridDim.x;
  for (int sl = (sched && bx < 128) ? 2 : 0; sl < nslots; ++sl) {
    int i;
    if (sched) i = sl < 2 ? sl * 128 + (bx - 128) : 256 + (sl - 2) * 256 + (bx < 128 ? 128 + bx : bx - 128);
    else { i = sl * (int)gridDim.x + bx; if (i >= 2048) break; }
    const int g = i >> 7, b = g >> 2, kvh = g & 3, hq = kvh * 4 + ((i >> 5) & 3), qb = i & 31;
    const size_t qoff = (size_t)(b * SEQ + qb * 256) * 2048 + hq * 128, koff = (size_t)b * SKV * 512 + kvh * 128;
    att::attn_dense_body(QB + qoff, KA + koff, VAl + koff, SKV, lds);
    __syncthreads();
  }
}

#define GRID_SYNC() do { asm volatile("s_waitcnt vmcnt(0) lgkmcnt(0)" ::: "memory"); grid.sync(); } while (0)
__global__ void __launch_bounds__(512, 2) fwd_megakernel(Params p) {
  extern __shared__ __attribute__((aligned(16))) unsigned char lds[];
  cg::grid_group grid = cg::this_grid();
  unsigned char* ws = p.ws;
  PG8_LAS unsigned char* lds3 = (PG8_LAS unsigned char*)lds;
  phase0_prep(p, lds);
  GRID_SYNC();
  phase1_ln_mod(p);
  GRID_SYNC();
  { pg8::Gemm g{(const bf16_t*)(ws + OFF_U), (const bf16_t*)(ws + OFF_WT_IN), M_ALL, N1P, 2048}; InProjOrder S; S.init((int)gridDim.x, (int)blockIdx.x);
    Epi1 E{ws, (unsigned char*)p.out}; pg8::gemm_phase<Epi1, InProjOrder, true, true>(lds3, g, S, E); }
  GRID_SYNC();
  phase3_elem(p);
  GRID_SYNC();
  phase4_mixers(p, (char*)lds);
  GRID_SYNC();
  phase5_gate(p);
  GRID_SYNC();
  { pg8::Gemm g{(const bf16_t*)(ws + OFF_OZ), (const bf16_t*)(ws + OFF_WT_BA), M_TOK, 2048, 2048}; pg8::StaticOrder S; S.init(M_TOK, 2048, (int)gridDim.x, (int)blockIdx.x);
    Epi2a E{(bf16_t*)(ws + OFF_TMP), (const bf16_t*)p.out}; pg8::gemm_phase<Epi2a, pg8::StaticOrder, true, true>(lds3, g, S, E); }
  __syncthreads();
  { pg8::Gemm g{(const bf16_t*)(ws + OFF_QB), (const bf16_t*)(ws + OFF_WT_BB), M_TOK, 2048, 2048}; pg8::StaticOrder S; S.init(M_TOK, 2048, (int)gridDim.x, (int)blockIdx.x);
    Epi2b E{(const bf16_t*)(ws + OFF_TMP), (const bf16_t*)p.out + (size_t)M_TOK * 2048, (bf16_t*)(ws + OFF_MERGED)}; pg8::gemm_phase<Epi2b, pg8::StaticOrder, true, true>(lds3, g, S, E); }
  GRID_SYNC();
  { pg8::Gemm g{(const bf16_t*)(ws + OFF_MERGED), (const bf16_t*)(ws + OFF_WT_OUT), M_TOK, 2048, 2048}; pg8::StaticOrder S; S.init(M_TOK, 2048, (int)gridDim.x, (int)blockIdx.x);
    Epi3 E{p.in[0], (const float*)(ws + OFF_MOD), p.out}; pg8::gemm_phase<Epi3, pg8::StaticOrder, true, true>(lds3, g, S, E); }
  GRID_SYNC();
  phase8_final_ln(p);
}

extern "C" void kernel_launch(void* const* d_in, const int* in_sizes, int n_in, void* d_out, int out_size, void* d_ws, size_t ws_size, hipStream_t stream) {
  static int grid_blocks = 0;
  if (!grid_blocks) {
    if (n_in != 18 || out_size != M_TOK * DM || ws_size < WS_END) { fprintf(stderr, "kernel_launch: unexpected shapes (n_in %d out %d ws %zu need %zu)\n", n_in, out_size, ws_size, (size_t)WS_END); grid_blocks = -1; return; }
    int dev = 0, cus = 0, per_cu = 0;
    (void)hipGetDevice(&dev);
    (void)hipDeviceGetAttribute(&cus, hipDeviceAttributeMultiprocessorCount, dev);
    (void)hipFuncSetAttribute((const void*)fwd_megakernel, hipFuncAttributeMaxDynamicSharedMemorySize, LDS_BYTES);
    (void)hipOccupancyMaxActiveBlocksPerMultiprocessor(&per_cu, fwd_megakernel, 512, LDS_BYTES);
    if (per_cu < 1) per_cu = 1;
    grid_blocks = cus * per_cu;
  }
  if (grid_blocks < 0) return;
  Params p{};
  for (int i = 0; i < 18; ++i) p.in[i] = (const float*)d_in[i];
  p.out = (float*)d_out; p.ws = (unsigned char*)d_ws;
  void* args[] = {&p};
  hipError_t e = hipLaunchCooperativeKernel((void*)fwd_megakernel, dim3(grid_blocks), dim3(512), args, LDS_BYTES, stream);
  if (e != hipSuccess) fprintf(stderr, "cooperative launch failed: %s (grid %d)\n", hipGetErrorString(e), grid_blocks);
}
```

```cpp
#include <hip/hip_runtime.h>
#include <hip/hip_cooperative_groups.h>
#include <cstdio>
#include <cstdint>
namespace cg = cooperative_groups;

constexpr int DM = 2048, NB = 4, SEQ = 8192, CTXL = 256;
constexpr int M_TOK = NB * SEQ, M_CTX = NB * CTXL, M_ALL = M_TOK + M_CTX;
constexpr int SKV = CTXL + SEQ;
constexpr int N_IN = 17440, N1P = 17664;
constexpr float LN_EPS = 1e-6f;
constexpr float ALPHA_DN = 1.189207115002721f;
constexpr int LDS_BYTES = 132 * 1024;

constexpr size_t SZ_W2 = (size_t)2048 * 2048 * 2;
constexpr size_t SZ_ALL = (size_t)M_ALL * 2048 * 2;
constexpr size_t SZ_TOK = (size_t)M_TOK * 2048 * 2;
constexpr size_t SZ_KV = (size_t)NB * SKV * 512 * 2;
constexpr size_t OFF_WT_BA = 0, OFF_WT_BB = SZ_W2, OFF_WT_OUT = 2 * SZ_W2;
constexpr size_t OFF_MOD = 3 * SZ_W2;
constexpr size_t OFF_ROPE = OFF_MOD + 131072;
constexpr size_t OFF_U = OFF_ROPE + 32768;
constexpr size_t OFF_QAKA = OFF_U;
constexpr size_t OFF_QKPRE = OFF_U + SZ_ALL;
constexpr size_t OFF_HF = OFF_QKPRE, OFF_MERGED = OFF_QKPRE;
constexpr size_t OFF_OZ = OFF_QKPRE + SZ_ALL;
constexpr size_t OFF_QB = OFF_OZ + SZ_TOK;
constexpr size_t OFF_ZB = OFF_QB + SZ_TOK;
constexpr size_t OFF_TMP = OFF_ZB;
constexpr size_t OFF_VA = OFF_ZB + SZ_TOK;
constexpr size_t OFF_VALL = OFF_VA + SZ_ALL;
constexpr size_t OFF_KALL = OFF_VALL + SZ_KV;
constexpr size_t OFF_GATES = OFF_KALL + SZ_KV;
constexpr size_t OFF_KBRAW = OFF_GATES + (size_t)M_ALL * 32 * 4;
constexpr size_t OFF_HB = OFF_KBRAW;
constexpr size_t OFF_WT_IN = OFF_KBRAW + SZ_KV;
constexpr size_t WS_END = OFF_HB + SZ_TOK;
static_assert(OFF_WT_IN + (size_t)N1P * 2048 * 2 <= WS_END, "ws map");
static_assert(OFF_TMP + (size_t)M_TOK * 2048 * 4 <= OFF_VALL, "tmp map");
static_assert(OFF_U % 256 == 0 && OFF_GATES % 256 == 0 && OFF_KBRAW % 256 == 0, "align");

typedef unsigned short bf16_t;
using f32x16 = __attribute__((ext_vector_type(16))) float;
using s16x4 = __attribute__((ext_vector_type(4))) short;
using u32x2 = __attribute__((ext_vector_type(2))) unsigned;

struct Params { const float* in[18]; float* out; unsigned char* ws; };

__device__ __forceinline__ float wave_sum(float v) {
#pragma unroll
  for (int o = 32; o >= 1; o >>= 1) v += __shfl_xor(v, o);
  return v;
}
__device__ __forceinline__ float bf2f(unsigned short b) { return __uint_as_float(((unsigned)b) << 16); }
__device__ __forceinline__ float bflo(unsigned w) { return __uint_as_float(w << 16); }
__device__ __forceinline__ float bfhi(unsigned w) { return __uint_as_float(w & 0xffff0000u); }
__device__ __forceinline__ float sigmoidf_(float x) { return __builtin_amdgcn_rcpf(1.0f + __expf(-x)); }
__device__ __forceinline__ float siluf_(float x) { return x * __builtin_amdgcn_rcpf(1.0f + __expf(-x)); }
namespace pg8 {
#define PG8_LAS __attribute__((address_space(3)))
typedef unsigned short bf16_t;
typedef short bf16x8 __attribute__((ext_vector_type(8)));
typedef float f32x4 __attribute__((ext_vector_type(4)));
typedef unsigned u32x4 __attribute__((ext_vector_type(4)));
constexpr int BM = 256, BK = 64, HALF = 128, HTB = HALF * BK * 2  , STAGE_BYTES = 8 * HTB, NXCD = 8, WGM = 2;

__host__ __device__ __forceinline__ int lds_byte(int r, int c) { const int st = (r >> 4) * 2 + (c >> 5), rr = r & 15, cc = c & 31, ob = rr * 64 + cc * 2; return st * 1024 + (ob ^ (((ob >> 9) & 1) << 5)); }
__host__ __device__ __forceinline__ void stage_rc(int b, int& R, int& C) { const int st = b / 1024, sb = b % 1024, swz = sb ^ (((sb >> 9) & 1) << 5); R = (st >> 1) * 16 + swz / 64; C = (st & 1) * 32 + (swz % 64) / 2; }
__host__ __device__ __forceinline__ int perm32(int rho) { const int n = rho >> 4, i = rho & 15; return 8 * (i >> 2) + 4 * n + (i & 3); }

struct Unit { int pm, pn; };
struct Gemm { const bf16_t* A; const bf16_t* Bt; int M, N, K; };

struct StaticOrder {
    int nM, nN, nwg, G, c;
    __host__ __device__ void init(int M, int N, int G_, int c_) { nM = M / BM; nN = N / BM; nwg = nM * nN; G = G_; c = c_; }
    __host__ __device__ bool next(int i, Unit& u) const {
        const long L = (long)i * G + c; if (L >= nwg) return false;
        int wgid = (int)L; { const int q = nwg / NXCD, r = nwg % NXCD, xcd = wgid % NXCD, off = wgid / NXCD; wgid = (xcd < r ? xcd * (q + 1) : r * (q + 1) + (xcd - r) * q) + off; }
        const int nig = WGM * nN, gid = wgid / nig, fm = gid * WGM, gsz = (nM - fm) < WGM ? (nM - fm) : WGM;
        u.pm = fm + ((wgid % nig) % gsz); u.pn = (wgid % nig) / gsz; return true;
    }
    __device__ __forceinline__ void a_ready(const Unit&) const {}
    __device__ __forceinline__ void done(const Unit&) const {}
};
__device__ __forceinline__ unsigned cvt_pk_bf16(float lo, float hi) { unsigned r; asm volatile("v_cvt_pk_bf16_f32 %0, %1, %2" : "=v"(r) : "v"(lo), "v"(hi)); return r; }
template <class Epi, class Sched, bool ALIGN_EPI = false, bool SP2 = false>
__device__ __forceinline__ void gemm_phase(PG8_LAS unsigned char* lds, const Gemm g, const Sched& S, const Epi& E) {
    int tid_l = threadIdx.x; asm volatile("" : "+v"(tid_l)); const int tid = tid_l, wid = __builtin_amdgcn_readfirstlane(tid >> 6), lane = tid & 63, wr = wid >> 2, wc = wid & 3, fr = lane & 15, fq = lane >> 4;
    const int K = g.K, nt = K / BK;
    unsigned voffA[2], voffB[2];
#pragma unroll
    for (int i = 0; i < 2; ++i) { int R, C; stage_rc(tid * 16 + i * 8192, R, C); const int Rb = Epi::PERM ? ((R & ~31) + perm32(R & 31)) : R;
        voffA[i] = (unsigned)(R * K + C) * 2u; voffB[i] = (unsigned)(Rb * K + C) * 2u; }
    const size_t kstep = (size_t)(BK * 2);
    const size_t hstep = (size_t)HALF * K * 2;
    const size_t tstep = 2 * hstep;
    const unsigned ldsw = (unsigned)wid * 1024u;
    const int aoff = lds_byte(wr * 64 + fr, fq * 8), boff = lds_byte(wc * 32 + fr, fq * 8);
#define PG8_SA(b, h) (((b) * 2 + (h)) * HTB)
#define PG8_SB(b, h) ((4 + (b) * 2 + (h)) * HTB)
#define PG8_STAGE(bufoff, gbase, voff) do { _Pragma("unroll") for (int _i = 0; _i < 2; ++_i) \
        __builtin_amdgcn_global_load_lds((const unsigned*)((const char*)(gbase) + (voff)[_i]), (PG8_LAS unsigned*)(lds + (bufoff) + ldsw + _i * 8192), 16, 0, 0); } while (0)
#define PG8_LDA(dst, b, h) do { _Pragma("unroll") for (int m = 0; m < 4; ++m) _Pragma("unroll") for (int k = 0; k < 2; ++k) dst[m][k] = *(const PG8_LAS bf16x8*)(lds + PG8_SA(b, h) + aoff + m * 2048 + k * 1024); } while (0)
#define PG8_LDB(dst, b, h) do { _Pragma("unroll") for (int n = 0; n < 2; ++n) _Pragma("unroll") for (int k = 0; k < 2; ++k) dst[n][k] = *(const PG8_LAS bf16x8*)(lds + PG8_SB(b, h) + boff + n * 2048 + k * 1024); } while (0)
#define PG8_MMA(ai, bj, At, Bt) do { __builtin_amdgcn_s_setprio(1); _Pragma("unroll") for (int m = 0; m < 4; ++m) _Pragma("unroll") for (int n = 0; n < 2; ++n) _Pragma("unroll") for (int k = 0; k < 2; ++k) \
        acc[ai][bj][m][n] = __builtin_amdgcn_mfma_f32_16x16x32_bf16(Bt[n][k], At[m][k], acc[ai][bj][m][n], 0, 0, 0); __builtin_amdgcn_s_setprio(0); } while (0)
#define PG8_WAIT_V(n) asm volatile("s_waitcnt vmcnt(" #n ")" ::: "memory")
#define PG8_WAIT_L(n) asm volatile("s_waitcnt lgkmcnt(" #n ")" ::: "memory")
#define PG8_BAR __builtin_amdgcn_s_barrier()
#define PG8_SCHED __builtin_amdgcn_sched_barrier(0)
    Unit cur, nxt; int ui = 0;
    if (!S.next(0, cur)) return;
    f32x4 acc[2][2][4][2];
#pragma unroll
    for (int a = 0; a < 2; ++a)
#pragma unroll
        for (int b = 0; b < 2; ++b)
#pragma unroll
            for (int m = 0; m < 4; ++m)
#pragma unroll
                for (int n = 0; n < 2; ++n) acc[a][b][m][n] = (f32x4){0.f, 0.f, 0.f, 0.f};
    bf16x8 At[4][2], B0[2][2], B1[2][2];
    const char* cA = (const char*)g.A + (size_t)cur.pm * tstep; const char* cB = (const char*)g.Bt + (size_t)cur.pn * tstep;
    S.a_ready(cur);
    if constexpr (SP2) {
        PG8_STAGE(PG8_SB(0, 0), cB, voffB); PG8_STAGE(PG8_SB(0, 1), cB + hstep, voffB); PG8_STAGE(PG8_SA(0, 0), cA, voffA); PG8_STAGE(PG8_SA(0, 1), cA + hstep, voffA);
        if (wr == 1) PG8_BAR;
        PG8_WAIT_V(2); PG8_BAR;
        PG8_STAGE(PG8_SB(1, 0), cB + kstep, voffB); PG8_STAGE(PG8_SA(1, 0), cA + kstep, voffA); PG8_STAGE(PG8_SB(1, 1), cB + hstep + kstep, voffB);
        PG8_WAIT_V(6); PG8_BAR;
    } else {
        PG8_STAGE(PG8_SB(0, 0), cB, voffB); PG8_STAGE(PG8_SA(0, 0), cA, voffA); PG8_STAGE(PG8_SB(0, 1), cB + hstep, voffB); PG8_STAGE(PG8_SA(0, 1), cA + hstep, voffA);
        if (wr == 1) PG8_BAR;
        PG8_WAIT_V(4); PG8_BAR;
        PG8_STAGE(PG8_SB(1, 0), cB + kstep, voffB); PG8_STAGE(PG8_SA(1, 0), cA + kstep, voffA); PG8_STAGE(PG8_SB(1, 1), cB + hstep + kstep, voffB);
        PG8_WAIT_V(6); PG8_BAR;
    }
    for (;;) {
        const bool has_next = S.next(ui + 1, nxt);
        const char* nA = has_next ? (const char*)g.A + (size_t)nxt.pm * tstep : cA; const char* nB = has_next ? (const char*)g.Bt + (size_t)nxt.pn * tstep : cB;
        for (int t = 0; t < nt; t += 2) {
            const bool last = (t == nt - 2);
            const char* a1 = cA + (size_t)(t + 1) * kstep;
            const char* a2 = last ? nA : cA + (size_t)(t + 2) * kstep; const char* b2 = last ? nB : cB + (size_t)(t + 2) * kstep;
            const char* a3 = a2 + kstep; const char* b3 = b2 + kstep;
            if (last && has_next) S.a_ready(nxt);
            if constexpr (SP2) {
            PG8_LDB(B0, 0, 0); PG8_LDB(B1, 0, 1); PG8_SCHED; PG8_LDA(At, 0, 0); PG8_STAGE(PG8_SA(1, 1), a1 + hstep, voffA);
            PG8_WAIT_V(8); PG8_WAIT_L(0); PG8_BAR; PG8_MMA(0, 0, At, B0); PG8_MMA(0, 1, At, B1); PG8_BAR; PG8_SCHED;
            PG8_LDA(At, 0, 1); PG8_STAGE(PG8_SB(0, 0), b2, voffB); PG8_STAGE(PG8_SB(0, 1), b2 + hstep, voffB); PG8_STAGE(PG8_SA(0, 0), a2, voffA);
            PG8_WAIT_V(8); PG8_WAIT_L(0); PG8_BAR; PG8_MMA(1, 0, At, B0); PG8_MMA(1, 1, At, B1); PG8_BAR; PG8_SCHED;
            PG8_LDB(B0, 1, 0); PG8_LDB(B1, 1, 1); PG8_SCHED; PG8_LDA(At, 1, 0); PG8_STAGE(PG8_SA(0, 1), a2 + hstep, voffA);
            PG8_WAIT_V(8); PG8_WAIT_L(0); PG8_BAR; PG8_MMA(0, 0, At, B0); PG8_MMA(0, 1, At, B1); PG8_BAR; PG8_SCHED;
            PG8_LDA(At, 1, 1); PG8_STAGE(PG8_SB(1, 0), b3, voffB); PG8_STAGE(PG8_SB(1, 1), b3 + hstep, voffB); PG8_STAGE(PG8_SA(1, 0), a3, voffA);
            PG8_WAIT_V(8); PG8_WAIT_L(0); PG8_BAR; PG8_MMA(1, 0, At, B0); PG8_MMA(1, 1, At, B1); PG8_BAR; PG8_SCHED;
            } else {
            PG8_LDB(B0, 0, 0); PG8_SCHED; PG8_LDA(At, 0, 0); PG8_STAGE(PG8_SA(1, 1), a1 + hstep, voffA);
            PG8_WAIT_L(8); PG8_BAR; PG8_WAIT_L(0); PG8_MMA(0, 0, At, B0); PG8_BAR; PG8_SCHED;
            PG8_LDB(B1, 0, 1); PG8_STAGE(PG8_SB(0, 0), b2, voffB);
            PG8_BAR; PG8_WAIT_L(0); PG8_MMA(0, 1, At, B1); PG8_BAR;
            PG8_LDA(At, 0, 1); PG8_STAGE(PG8_SA(0, 0), a2, voffA);
            PG8_BAR; PG8_WAIT_L(0); PG8_MMA(1, 0, At, B0); PG8_BAR; PG8_SCHED;
            PG8_STAGE(PG8_SB(0, 1), b2 + hstep, voffB);
            PG8_WAIT_V(6); PG8_BAR; PG8_MMA(1, 1, At, B1); PG8_BAR;
            PG8_LDB(B0, 1, 0); PG8_SCHED; PG8_LDA(At, 1, 0); PG8_STAGE(PG8_SA(0, 1), a2 + hstep, voffA);
            PG8_WAIT_L(8); PG8_BAR; PG8_WAIT_L(0); PG8_MMA(0, 0, At, B0); PG8_BAR; PG8_SCHED;
            PG8_LDB(B1, 1, 1); PG8_STAGE(PG8_SB(1, 0), b3, voffB);
            PG8_BAR; PG8_WAIT_L(0); PG8_MMA(0, 1, At, B1); PG8_BAR;
            PG8_LDA(At, 1, 1); PG8_STAGE(PG8_SA(1, 0), a3, voffA);
            PG8_BAR; PG8_WAIT_L(0); PG8_MMA(1, 0, At, B0); PG8_BAR; PG8_SCHED;
            PG8_STAGE(PG8_SB(1, 1), b3 + hstep, voffB);
            PG8_WAIT_V(6); PG8_BAR; PG8_MMA(1, 1, At, B1); PG8_BAR;
            }
        }
        if constexpr (ALIGN_EPI) { if (wr == 0) PG8_BAR; }
        if constexpr (!Epi::AFTER_DRAIN) { E(acc, cur, wr, wc, fr, fq); S.done(cur); }
        if (!has_next) break;
#pragma unroll
        for (int a = 0; a < 2; ++a)
#pragma unroll
            for (int b = 0; b < 2; ++b)
#pragma unroll
                for (int m = 0; m < 4; ++m)
#pragma unroll
                    for (int n = 0; n < 2; ++n) acc[a][b][m][n] = (f32x4){0.f, 0.f, 0.f, 0.f};
        cur = nxt; cA = nA; cB = nB; ++ui;
        if constexpr (ALIGN_EPI) { if (wr == 1) PG8_BAR; }
    }
    PG8_WAIT_V(0);
    if constexpr (!ALIGN_EPI) { if (wr == 0) PG8_BAR; }
    PG8_BAR;
    if constexpr (Epi::AFTER_DRAIN) { E.fused(acc, cur, wr, wc, fr, fq, lds, wid, lane); S.done(cur); }
#undef PG8_SA
#undef PG8_SB
#undef PG8_STAGE
#undef PG8_LDA
#undef PG8_LDB
#undef PG8_MMA
#undef PG8_WAIT_V
#undef PG8_WAIT_L
#undef PG8_BAR
#undef PG8_SCHED
}
}


using pg8::f32x4; using pg8::u32x4; using pg8::bf16x8; using pg8::cvt_pk_bf16;

struct Epi1 {
  static constexpr bool PERM = true, AFTER_DRAIN = false;
  unsigned char* ws; unsigned char* dout;
  __device__ __forceinline__ void operator()(const f32x4 (&acc)[2][2][4][2], const pg8::Unit& u, int wr, int wc, int fr, int fq) const {
    const int pn = u.pn, pm = u.pm; const bool lat = pm < 128;
    const int rl = wr * 64 + fr, cl = wc * 32 + 8 * fq;
    if (pn == 20) {
      if (wc == 0) { float* G = (float*)(ws + OFF_GATES);
#pragma unroll
        for (int ai = 0; ai < 2; ++ai)
#pragma unroll
          for (int m = 0; m < 4; ++m) { float* rp = G + (size_t)(pm * 256 + ai * 128 + rl + m * 16) * 32 + 8 * fq;
            *(f32x4*)rp = acc[ai][0][m][0]; *(f32x4*)(rp + 4) = acc[ai][0][m][1]; } }
      return;
    }
    if (pn >= 21 && pn < 37) {
      if (!lat) return;
      bf16_t* O = (bf16_t*)(ws + OFF_OZ) + (pn - 21) * 128 + cl;
#pragma unroll
      for (int ai = 0; ai < 2; ++ai)
#pragma unroll
        for (int m = 0; m < 4; ++m) { const size_t row = (size_t)pm * 256 + ai * 128 + rl + m * 16;
          float r[8];
#pragma unroll
          for (int n = 0; n < 2; ++n)
#pragma unroll
            for (int e = 0; e < 4; ++e) r[n * 4 + e] = sigmoidf_(acc[ai][0][m][n][e]) * siluf_(acc[ai][1][m][n][e]);
          u32x4 w; w.x = cvt_pk_bf16(r[0], r[1]); w.y = cvt_pk_bf16(r[2], r[3]); w.z = cvt_pk_bf16(r[4], r[5]); w.w = cvt_pk_bf16(r[6], r[7]);
          *(u32x4*)(O + row * 2048) = w; }
      return;
    }
    bf16_t* O; int ld = 2048, act = 0; size_t rowbase = (size_t)pm * 256;
    if (pn < 8) { O = (bf16_t*)(ws + OFF_QKPRE) + pn * 256; }
    else if (pn < 16) { O = (bf16_t*)(ws + OFF_VA) + (pn - 8) * 256; }
    else if (pn < 18) { O = (bf16_t*)(ws + OFF_KBRAW) + (pn - 16) * 256; ld = 512; }
    else if (pn < 20) { O = (bf16_t*)(ws + OFF_VALL) + (pn - 18) * 256; ld = 512;
      rowbase = lat ? (size_t)(pm >> 5) * SKV + CTXL + (size_t)(pm & 31) * 256 : (size_t)(pm - 128) * SKV; }
    else { if (!lat) return;
      if (pn < 45) { O = (bf16_t*)(ws + OFF_QB) + (pn - 37) * 256; }
      else if (pn < 53) { O = (bf16_t*)(ws + OFF_ZB) + (pn - 45) * 256; act = 1; }
      else if (pn < 61) { O = (bf16_t*)dout + (pn - 53) * 256; act = 2; }
      else { O = (bf16_t*)dout + (size_t)M_TOK * 2048 + (pn - 61) * 256; act = 2; } }
#pragma unroll
    for (int ai = 0; ai < 2; ++ai)
#pragma unroll
      for (int m = 0; m < 4; ++m) { bf16_t* rowp = O + (rowbase + ai * 128 + rl + m * 16) * ld + cl;
#pragma unroll
        for (int bj = 0; bj < 2; ++bj) { f32x4 v0 = acc[ai][bj][m][0], v1 = acc[ai][bj][m][1];
          if (act == 1) {
#pragma unroll
            for (int e = 0; e < 4; ++e) { v0[e] = siluf_(v0[e]); v1[e] = siluf_(v1[e]); } }
          else if (act == 2) {
#pragma unroll
            for (int e = 0; e < 4; ++e) { v0[e] = sigmoidf_(v0[e]); v1[e] = sigmoidf_(v1[e]); } }
          u32x4 w; w.x = cvt_pk_bf16(v0[0], v0[1]); w.y = cvt_pk_bf16(v0[2], v0[3]); w.z = cvt_pk_bf16(v1[0], v1[1]); w.w = cvt_pk_bf16(v1[2], v1[3]);
          *(u32x4*)(rowp + bj * 128) = w; } }
  }
};
struct Epi2a {
  static constexpr bool PERM = true, AFTER_DRAIN = false;
  bf16_t* tmp; const bf16_t* sg;
  __device__ __forceinline__ void operator()(const f32x4 (&acc)[2][2][4][2], const pg8::Unit& u, int wr, int wc, int fr, int fq) const {
    const int col0 = u.pn * 256 + wc * 32 + 8 * fq;
#pragma unroll
    for (int ai = 0; ai < 2; ++ai)
#pragma unroll
      for (int m = 0; m < 4; ++m) { const size_t off = (size_t)(u.pm * 256 + ai * 128 + wr * 64 + fr + m * 16) * 2048 + col0;
#pragma unroll
        for (int bj = 0; bj < 2; ++bj) { const u32x4 s = *(const u32x4*)(sg + off + bj * 128);
          f32x4 a = acc[ai][bj][m][0], b = acc[ai][bj][m][1];
          a[0] *= bflo(s.x); a[1] *= bfhi(s.x); a[2] *= bflo(s.y); a[3] *= bfhi(s.y);
          b[0] *= bflo(s.z); b[1] *= bfhi(s.z); b[2] *= bflo(s.w); b[3] *= bfhi(s.w);
          u32x4 w; w.x = cvt_pk_bf16(a[0], a[1]); w.y = cvt_pk_bf16(a[2], a[3]); w.z = cvt_pk_bf16(b[0], b[1]); w.w = cvt_pk_bf16(b[2], b[3]);
          *(u32x4*)(tmp + off + bj * 128) = w; } }
  }
};
struct Epi2b {
  static constexpr bool PERM = true, AFTER_DRAIN = false;
  const bf16_t* tmp; const bf16_t* sg; bf16_t* merged;
  __device__ __forceinline__ void operator()(const f32x4 (&acc)[2][2][4][2], const pg8::Unit& u, int wr, int wc, int fr, int fq) const {
    const int col0 = u.pn * 256 + wc * 32 + 8 * fq;
#pragma unroll
    for (int ai = 0; ai < 2; ++ai)
#pragma unroll
      for (int m = 0; m < 4; ++m) { const size_t off = (size_t)(u.pm * 256 + ai * 128 + wr * 64 + fr + m * 16) * 2048 + col0;
#pragma unroll
        for (int bj = 0; bj < 2; ++bj) { const u32x4 s = *(const u32x4*)(sg + off + bj * 128);
          const u32x4 tw = *(const u32x4*)(tmp + off + bj * 128); const f32x4 t0 = {bflo(tw.x), bfhi(tw.x), bflo(tw.y), bfhi(tw.y)}, t1 = {bflo(tw.z), bfhi(tw.z), bflo(tw.w), bfhi(tw.w)};
          f32x4 a = acc[ai][bj][m][0], b = acc[ai][bj][m][1];
          a[0] = t0[0] + a[0] * bflo(s.x); a[1] = t0[1] + a[1] * bfhi(s.x); a[2] = t0[2] + a[2] * bflo(s.y); a[3] = t0[3] + a[3] * bfhi(s.y);
          b[0] = t1[0] + b[0] * bflo(s.z); b[1] = t1[1] + b[1] * bfhi(s.z); b[2] = t1[2] + b[2] * bflo(s.w); b[3] = t1[3] + b[3] * bfhi(s.w);
          u32x4 w; w.x = cvt_pk_bf16(a[0], a[1]); w.y = cvt_pk_bf16(a[2], a[3]); w.z = cvt_pk_bf16(b[0], b[1]); w.w = cvt_pk_bf16(b[2], b[3]);
          *(u32x4*)(merged + off + bj * 128) = w; } }
  }
};
struct Epi3 {
  static constexpr bool PERM = false, AFTER_DRAIN = false;
  const float* x; const float* mod; float* y;
  __device__ __forceinline__ void operator()(const f32x4 (&acc)[2][2][4][2], const pg8::Unit& u, int wr, int wc, int fr, int fq) const {
    const int col0 = u.pn * 256 + wc * 32 + 4 * fq;
    const float* gate = mod + (size_t)(u.pm >> 5) * 6144 + 4096 + col0;
    f32x4 gv[2][2];
#pragma unroll
    for (int bj = 0; bj < 2; ++bj)
#pragma unroll
      for (int n = 0; n < 2; ++n) gv[bj][n] = *(const f32x4*)(gate + bj * 128 + n * 16);
#pragma unroll
    for (int ai = 0; ai < 2; ++ai)
#pragma unroll
      for (int m = 0; m < 4; ++m) { const size_t off = (size_t)(u.pm * 256 + ai * 128 + wr * 64 + fr + m * 16) * 2048 + col0;
#pragma unroll
        for (int bj = 0; bj < 2; ++bj)
#pragma unroll
          for (int n = 0; n < 2; ++n) { const f32x4 xv = *(const f32x4*)(x + off + bj * 128 + n * 16);
            *(f32x4*)(y + off + bj * 128 + n * 16) = xv * ALPHA_DN + gv[bj][n] * acc[ai][bj][m][n]; } }
  }
};

struct InProjOrder {
  pg8::StaticOrder base; int G, c;
  __device__ void init(int G_, int c_) { base.init(M_TOK, N1P, G_, c_); G = G_; c = c_; }
  __device__ bool next(int i, pg8::Unit& u) const {
    const long L = (long)i * G + c; if (L < base.nwg) return base.next(i, u);
    const int r = (int)(L - base.nwg); if (r >= 4 * 21) return false;
    u.pm = 128 + (r & 3); u.pn = r >> 2; return true; }
  __device__ __forceinline__ void a_ready(const pg8::Unit&) const {}
  __device__ __forceinline__ void done(const pg8::Unit&) const {}
};

__device__ __forceinline__ int orig_col(int n) {
  if (n < 4096) return n;
  if (n < 4608) return 4128 + (n - 4096);
  if (n < 5120) return 4640 + (n - 4608);
  if (n < 5152) return 4096 + (n - 5120);
  if (n < 5376) return -1;
  if (n < 9472) { const int t = n - 5376, j = t >> 8, r = t & 255; return r < 128 ? 5152 + 128 * j + r : 7200 + 128 * j + (r - 128); }
  if (n < 11520) return 9248 + (n - 9472);
  if (n < 13568) return 11296 + (n - 11520);
  return 13344 + (n - 13568);
}
__device__ void phase0_prep(const Params& p, unsigned char* lds) {
  int tid_l = threadIdx.x; asm volatile("" : "+v"(tid_l)); const int tid = tid_l, wid = tid >> 6, lane = tid & 63;
  unsigned char* ws = p.ws;
  for (int idx = blockIdx.x * 512 + tid; idx < 4096; idx += gridDim.x * 512) {
    const int pos = idx >> 5, i = idx & 31; const float inv = powf(10000.0f, -(float)(2 * i) / 64.0f); const float ang = (float)pos * inv;
    float2 cs; cs.x = cosf(ang); cs.y = sinf(ang); ((float2*)(ws + OFF_ROPE))[idx] = cs; }
  float* sl = (float*)lds; float* red = sl + 5 * 2048; bool did = false;
  for (int it = blockIdx.x; it < 192; it += gridDim.x) {
    if (!did) { for (int i = tid; i < 5 * 2048; i += 512) { const int r = i >> 11, k = i & 2047; const float c = (r < 4) ? p.in[1][r * 2048 + k] : p.in[3][k]; sl[i] = c / (1.0f + expf(-c)); }
      __syncthreads(); did = true; }
    const int col = lane & 31, kh = lane >> 5, n = it * 32 + col;
    float a0 = 0.f, a1 = 0.f, a2 = 0.f, a3 = 0.f, a4 = 0.f;
    const float* wp = p.in[4] + (size_t)(wid * 256 + kh) * 6144 + n;
#pragma unroll 8
    for (int i = 0; i < 128; ++i) { const int k = wid * 256 + 2 * i + kh; const float w = wp[(size_t)(2 * i) * 6144];
      a0 += sl[k] * w; a1 += sl[2048 + k] * w; a2 += sl[4096 + k] * w; a3 += sl[6144 + k] * w; a4 += sl[8192 + k] * w; }
    a0 += __shfl_xor(a0, 32); a1 += __shfl_xor(a1, 32); a2 += __shfl_xor(a2, 32); a3 += __shfl_xor(a3, 32); a4 += __shfl_xor(a4, 32);
    if (kh == 0) { red[(wid * 5 + 0) * 32 + col] = a0; red[(wid * 5 + 1) * 32 + col] = a1; red[(wid * 5 + 2) * 32 + col] = a2; red[(wid * 5 + 3) * 32 + col] = a3; red[(wid * 5 + 4) * 32 + col] = a4; }
    __syncthreads();
    if (tid < 160) { const int r = tid >> 5, c = tid & 31; float s = 0.f;
#pragma unroll
      for (int w = 0; w < 8; ++w) s += red[(w * 5 + r) * 32 + c];
      ((float*)(ws + OFF_MOD))[r * 6144 + it * 32 + c] = s + p.in[5][it * 32 + c]; }
    __syncthreads();
  }
  __syncthreads();
  float* tile = (float*)lds;
  constexpr int NT_IN = (N1P / 64) * 32, NT = NT_IN + 3 * 1024;
  for (int t = blockIdx.x; t < NT; t += gridDim.x) {
    const float* src; bf16_t* dst; int ldsrc, n0, k0; bool perm;
    if (t < NT_IN) { src = p.in[6]; dst = (bf16_t*)(ws + OFF_WT_IN); ldsrc = N_IN; n0 = (t >> 5) * 64; k0 = (t & 31) * 64; perm = true; }
    else { int q = t - NT_IN; const int w = q >> 10; q &= 1023; src = p.in[13 + w]; dst = (bf16_t*)(ws + OFF_WT_BA + (size_t)w * SZ_W2); ldsrc = 2048; n0 = (q >> 5) * 64; k0 = (q & 31) * 64; perm = false; }
#pragma unroll
    for (int i = 0; i < 2; ++i) { const int kk = (tid >> 4) + 32 * i, nq = (tid & 15) * 4; const int oc = perm ? orig_col(n0 + nq) : n0 + nq;
      float4 v = make_float4(0.f, 0.f, 0.f, 0.f); if (oc >= 0) v = *(const float4*)(src + (size_t)(k0 + kk) * ldsrc + oc);
      float* tp = tile + kk * 65 + nq; tp[0] = v.x; tp[1] = v.y; tp[2] = v.z; tp[3] = v.w; }
    __syncthreads();
    { const int nn = tid >> 3, kq = (tid & 7) * 8; float r[8];
#pragma unroll
      for (int e = 0; e < 8; ++e) r[e] = tile[(kq + e) * 65 + nn];
      u32x4 w; w.x = cvt_pk_bf16(r[0], r[1]); w.y = cvt_pk_bf16(r[2], r[3]); w.z = cvt_pk_bf16(r[4], r[5]); w.w = cvt_pk_bf16(r[6], r[7]);
      *(u32x4*)(dst + (size_t)(n0 + nn) * 2048 + k0 + kq) = w; }
    __syncthreads();
  }
}

__device__ void phase1_ln_mod(const Params& p) {
  int tid_l = threadIdx.x; asm volatile("" : "+v"(tid_l)); const int tid = tid_l, wid = tid >> 6, lane = tid & 63;
  const float* MOD = (const float*)(p.ws + OFF_MOD); bf16_t* U = (bf16_t*)(p.ws + OFF_U);
  for (int row = blockIdx.x * 8 + wid; row < M_ALL; row += gridDim.x * 8) {
    const float* src = row < M_TOK ? p.in[0] + (size_t)row * 2048 : p.in[2] + (size_t)(row - M_TOK) * 2048;
    const float* md = MOD + (size_t)(row < M_TOK ? (row >> 13) : 4) * 6144;
    float4 v[4][2]; float s = 0.f;
#pragma unroll
    for (int g = 0; g < 4; ++g) { const float4* q = (const float4*)(src + g * 512 + lane * 8); v[g][0] = q[0]; v[g][1] = q[1];
      s += (v[g][0].x + v[g][0].y) + (v[g][0].z + v[g][0].w) + (v[g][1].x + v[g][1].y) + (v[g][1].z + v[g][1].w); }
    s = wave_sum(s); const float mu = s * (1.0f / 2048.0f); float q2 = 0.f;
#pragma unroll
    for (int g = 0; g < 4; ++g)
#pragma unroll
      for (int h = 0; h < 2; ++h) { const float a = v[g][h].x - mu, b = v[g][h].y - mu, c = v[g][h].z - mu, d = v[g][h].w - mu; q2 += (a * a + b * b) + (c * c + d * d); }
    q2 = wave_sum(q2); const float rs = rsqrtf(q2 * (1.0f / 2048.0f) + LN_EPS);
#pragma unroll
    for (int g = 0; g < 4; ++g) { const int c0 = g * 512 + lane * 8; float r[8];
#pragma unroll
      for (int h = 0; h < 2; ++h) { const float4 sh = *(const float4*)(md + c0 + 4 * h), sc = *(const float4*)(md + 2048 + c0 + 4 * h);
        r[4 * h + 0] = (v[g][h].x - mu) * rs * (1.0f + sc.x) + sh.x; r[4 * h + 1] = (v[g][h].y - mu) * rs * (1.0f + sc.y) + sh.y;
        r[4 * h + 2] = (v[g][h].z - mu) * rs * (1.0f + sc.z) + sh.z; r[4 * h + 3] = (v[g][h].w - mu) * rs * (1.0f + sc.w) + sh.w; }
      u32x4 w; w.x = cvt_pk_bf16(r[0], r[1]); w.y = cvt_pk_bf16(r[2], r[3]); w.z = cvt_pk_bf16(r[4], r[5]); w.w = cvt_pk_bf16(r[6], r[7]);
      *(u32x4*)(U + (size_t)row * 2048 + c0) = w; }
  }
}

__device__ __forceinline__ void unpack8(const u32x4 w, float* f) { f[0] = bflo(w.x); f[1] = bfhi(w.x); f[2] = bflo(w.y); f[3] = bfhi(w.y); f[4] = bflo(w.z); f[5] = bfhi(w.z); f[6] = bflo(w.w); f[7] = bfhi(w.w); }
__device__ __forceinline__ u32x4 pack8(const float* r) { u32x4 w; w.x = cvt_pk_bf16(r[0], r[1]); w.y = cvt_pk_bf16(r[2], r[3]); w.z = cvt_pk_bf16(r[4], r[5]); w.w = cvt_pk_bf16(r[6], r[7]); return w; }
__device__ __forceinline__ u32x4 norm_rope_head(const u32x4 raw, const float* nw, const float2* rope, int j, int pos_r, int pos_c) {
  float x[8]; unpack8(raw, x); float ss = 0.f;
#pragma unroll
  for (int e = 0; e < 8; ++e) ss += x[e] * x[e];
  ss += __shfl_xor(ss, 1); ss += __shfl_xor(ss, 2); ss += __shfl_xor(ss, 4); ss += __shfl_xor(ss, 8);
  const float rs = rsqrtf(ss * (1.0f / 128.0f) + LN_EPS);
  const float4 w0 = *(const float4*)(nw + 8 * j), w1 = *(const float4*)(nw + 8 * j + 4);
  x[0] *= rs * w0.x; x[1] *= rs * w0.y; x[2] *= rs * w0.z; x[3] *= rs * w0.w; x[4] *= rs * w1.x; x[5] *= rs * w1.y; x[6] *= rs * w1.z; x[7] *= rs * w1.w;
  float o[8];
  const bool is_x1 = ((j >> 2) & 1) == 0; const int pos = (j < 8) ? pos_r : pos_c; const int fi = 8 * (j & 3);
#pragma unroll
  for (int e = 0; e < 8; ++e) { const float pv = __shfl_xor(x[e], 4);
    if (pos_r >= 0) { const float2 cs = rope[pos * 32 + fi + e]; o[e] = is_x1 ? (x[e] * cs.x - pv * cs.y) : (pv * cs.y + x[e] * cs.x); }
    else o[e] = x[e]; }
  return pack8(o);
}
__device__ void phase3_elem(const Params& p) {
  int tid_l = threadIdx.x; asm volatile("" : "+v"(tid_l)); const int tid = tid_l, wid = tid >> 6, lane = tid & 63;
  unsigned char* ws = p.ws;
  { const bf16_t* X = (const bf16_t*)(ws + OFF_QKPRE); bf16_t* Y = (bf16_t*)(ws + OFF_QAKA); const float* cw = p.in[8]; const float* cb = p.in[9];
    const int c8 = (tid & 255) * 8; const int rsub = tid >> 8;
    float w0[8], w1[8], w2[8], bb[8];
#pragma unroll
    for (int e = 0; e < 8; ++e) { w0[e] = cw[c8 + e]; w1[e] = cw[2048 + c8 + e]; w2[e] = cw[4096 + c8 + e]; bb[e] = cb[c8 + e]; }
    const float sc = c8 >= 1024 ? 0.08838834764831845f : 1.0f;
    const int rstep = (int)gridDim.x * 2;
    for (int row0 = (int)blockIdx.x * 2 + rsub; row0 < M_ALL; row0 += 4 * rstep) {
      u32x4 cu[4], pr[4], nx[4]; const u32x4 z = {0u, 0u, 0u, 0u};
#pragma unroll
      for (int u = 0; u < 4; ++u) { const int row = row0 + u * rstep; cu[u] = z; pr[u] = z; nx[u] = z;
        if (row < M_ALL) { bool first, last; if (row < M_TOK) { const int s = row & (SEQ - 1); first = s == 0; last = s == SEQ - 1; } else { const int t = (row - M_TOK) & (CTXL - 1); first = t == 0; last = t == CTXL - 1; }
          cu[u] = *(const u32x4*)(X + (size_t)row * 2048 + c8);
          if (!first) pr[u] = *(const u32x4*)(X + (size_t)(row - 1) * 2048 + c8);
          if (!last) nx[u] = *(const u32x4*)(X + (size_t)(row + 1) * 2048 + c8); } }
#pragma unroll
      for (int u = 0; u < 4; ++u) { const int row = row0 + u * rstep;
        if (row < M_ALL) { float a[8], b[8], c[8], r[8]; unpack8(pr[u], a); unpack8(cu[u], b); unpack8(nx[u], c);
#pragma unroll
          for (int e = 0; e < 8; ++e) { const float y = bb[e] + a[e] * w0[e] + b[e] * w1[e] + c[e] * w2[e]; r[e] = siluf_(y) * sc; }
          *(u32x4*)(Y + (size_t)row * 2048 + c8) = pack8(r); } } } }
  const float2* rope = (const float2*)(ws + OFF_ROPE);
  const int j = lane & 15, hl = lane >> 4;
  { const bf16_t* X = (const bf16_t*)(ws + OFF_KBRAW); bf16_t* Y = (bf16_t*)(ws + OFF_KALL); const int step = (int)gridDim.x * 8;
    for (int row0 = blockIdx.x * 8 + wid; row0 < M_ALL; row0 += 4 * step) {
      u32x4 raw[4];
#pragma unroll
      for (int u = 0; u < 4; ++u) { const int row = row0 + u * step; raw[u] = (u32x4){0u, 0u, 0u, 0u}; if (row < M_ALL) raw[u] = *(const u32x4*)(X + (size_t)row * 512 + hl * 128 + j * 8); }
#pragma unroll
      for (int u = 0; u < 4; ++u) { const int row = row0 + u * step; if (row < M_ALL) {
        size_t drow; int pr = -1, pc = -1;
        if (row < M_TOK) { const int b = row >> 13, s = row & (SEQ - 1); drow = (size_t)b * SKV + CTXL + s; pr = s >> 6; pc = s & 63; }
        else { const int b = (row - M_TOK) >> 8, t = (row - M_TOK) & (CTXL - 1); drow = (size_t)b * SKV + t; }
        *(u32x4*)(Y + drow * 512 + hl * 128 + j * 8) = norm_rope_head(raw[u], p.in[12], rope, j, pr, pc); } } } }
  { bf16_t* X = (bf16_t*)(ws + OFF_QB); const int step = (int)gridDim.x * 8;
    for (int it0 = blockIdx.x * 8 + wid; it0 < M_TOK * 4; it0 += 4 * step) {
      u32x4 raw[4];
#pragma unroll
      for (int u = 0; u < 4; ++u) { const int it = it0 + u * step; raw[u] = (u32x4){0u, 0u, 0u, 0u};
        if (it < M_TOK * 4) raw[u] = *(const u32x4*)(X + (size_t)(it >> 2) * 2048 + ((it & 3) * 4 + hl) * 128 + j * 8); }
#pragma unroll
      for (int u = 0; u < 4; ++u) { const int it = it0 + u * step; if (it < M_TOK * 4) { const int row = it >> 2, s = row & (SEQ - 1);
        *(u32x4*)(X + (size_t)row * 2048 + ((it & 3) * 4 + hl) * 128 + j * 8) = norm_rope_head(raw[u], p.in[11], rope, j, s >> 6, s & 63); } } } }
}

__device__ void phase5_gate(const Params& p) {
  int tid_l = threadIdx.x; asm volatile("" : "+v"(tid_l)); const int tid = tid_l, wid = tid >> 6, lane = tid & 63;
  const bf16_t* HF = (const bf16_t*)(p.ws + OFF_HF); const bf16_t* HB = (const bf16_t*)(p.ws + OFF_HB); bf16_t* OZ = (bf16_t*)(p.ws + OFF_OZ);
  const float* nw = p.in[10];
  const int j = lane & 31, hl = lane >> 5; const int step = (int)gridDim.x * 8;
  for (int it0 = blockIdx.x * 8 + wid; it0 < M_TOK * 4; it0 += 4 * step) {
    u32x4 ha[4], hb[4], gz[4];
#pragma unroll
    for (int u = 0; u < 4; ++u) { const int it = it0 + u * step; ha[u] = (u32x4){0u, 0u, 0u, 0u}; hb[u] = ha[u]; gz[u] = ha[u];
      if (it < M_TOK * 4) { const size_t off = (size_t)(it >> 2) * 2048 + ((it & 3) * 2 + hl) * 256 + j * 8;
        ha[u] = *(const u32x4*)(HF + off); hb[u] = *(const u32x4*)(HB + off); gz[u] = *(const u32x4*)(OZ + off); } }
#pragma unroll
    for (int u = 0; u < 4; ++u) { const int it = it0 + u * step; if (it < M_TOK * 4) {
      const size_t off = (size_t)(it >> 2) * 2048 + ((it & 3) * 2 + hl) * 256 + j * 8;
      float a[8], b[8], g[8], r[8]; unpack8(ha[u], a); unpack8(hb[u], b); unpack8(gz[u], g);
      float ss = 0.f;
#pragma unroll
      for (int e = 0; e < 8; ++e) { a[e] += b[e]; ss += a[e] * a[e]; }
      ss += __shfl_xor(ss, 1); ss += __shfl_xor(ss, 2); ss += __shfl_xor(ss, 4); ss += __shfl_xor(ss, 8); ss += __shfl_xor(ss, 16);
      const float rs = rsqrtf(ss * (1.0f / 256.0f) + LN_EPS);
      const float* w = nw + ((it & 3) * 2 + hl) * 256 + j * 8;
#pragma unroll
      for (int e = 0; e < 8; ++e) r[e] = a[e] * rs * w[e] * g[e];
      *(u32x4*)(OZ + off) = pack8(r); } }
  }
}

__device__ void phase8_final_ln(const Params& p) {
  int tid_l = threadIdx.x; asm volatile("" : "+v"(tid_l)); const int tid = tid_l, wid = tid >> 6, lane = tid & 63;
  const float* lw = p.in[16]; const float* lb = p.in[17];
  for (int row = blockIdx.x * 8 + wid; row < M_TOK; row += gridDim.x * 8) {
    float4* r = (float4*)(p.out + (size_t)row * 2048);
    float4 v[8]; float s = 0.f;
#pragma unroll
    for (int i = 0; i < 8; ++i) { v[i] = r[lane + 64 * i]; s += (v[i].x + v[i].y) + (v[i].z + v[i].w); }
    s = wave_sum(s); const float mu = s * (1.f / 2048.f); float q = 0.f;
#pragma unroll
    for (int i = 0; i < 8; ++i) { const float a = v[i].x - mu, b = v[i].y - mu, c = v[i].z - mu, d = v[i].w - mu; q += (a * a + b * b) + (c * c + d * d); }
    q = wave_sum(q); const float rs = rsqrtf(q * (1.f / 2048.f) + LN_EPS);
#pragma unroll
    for (int i = 0; i < 8; ++i) { const float4 w = ((const float4*)lw)[lane + 64 * i], b = ((const float4*)lb)[lane + 64 * i];
      float4 y; y.x = (v[i].x - mu) * rs * w.x + b.x; y.y = (v[i].y - mu) * rs * w.y + b.y; y.z = (v[i].z - mu) * rs * w.z + b.z; y.w = (v[i].w - mu) * rs * w.w + b.w;
      r[lane + 64 * i] = y; }
  }
}

namespace att {
constexpr int D = 128, NW = 8, QBLK = 32, KVBLK = 64;
constexpr float SCALE = 0.088388347648318440f;
constexpr float THR = 8.f;
constexpr int LDQ = 2048, LDK = 512;
constexpr size_t SHM_V = KVBLK * D * 2, SHM_K = KVBLK * D * 2, SHM_ATTN = 2 * SHM_V + 2 * SHM_K + NW * 64 * 4;
#define KSWZ(row, colB) ((row) * 256 + ((colB) ^ (((row) & 7) << 4)))
#define SBAR() __builtin_amdgcn_sched_barrier(0)
__device__ __forceinline__ int crow(int r, int hi) { return (r & 3) + 8 * (r >> 2) + 4 * hi; }
__device__ __forceinline__ unsigned cvtpk(float lo, float hi) { unsigned r; asm volatile("v_cvt_pk_bf16_f32 %0, %1, %2" : "=v"(r) : "v"(lo), "v"(hi)); return r; }
__device__ __forceinline__ void partialSM(f32x16& p0, f32x16& p1, float& m_reg, float& mn, float& alpha) {
  constexpr float C = SCALE * 1.4426950408889634f;
  float pmax = p0[0]; for (int r = 1; r < 16; ++r) pmax = fmaxf(pmax, p0[r]); for (int r = 0; r < 16; ++r) pmax = fmaxf(pmax, p1[r]);
  { auto rr = __builtin_amdgcn_permlane32_swap(__float_as_uint(pmax), __float_as_uint(pmax), false, false);
    pmax = fmaxf(__uint_as_float(rr[0]), __uint_as_float(rr[1])); }
  if (__builtin_expect(__all(pmax - m_reg <= THR / SCALE), 1)) { mn = m_reg; alpha = 1.f; }
  else { mn = fmaxf(m_reg, pmax); alpha = __builtin_amdgcn_exp2f((m_reg - mn) * C); m_reg = mn; }
  float mnC = -mn * C;
  for (int r = 0; r < 16; ++r) p0[r] = fmaf(p0[r], C, mnC); for (int r = 0; r < 16; ++r) p1[r] = fmaf(p1[r], C, mnC);
  for (int r = 0; r < 16; ++r) p0[r] = __builtin_amdgcn_exp2f(p0[r]);
}
__device__ __forceinline__ void finishSM(f32x16& p0, f32x16& p1, float alpha, float& l_reg, bf16x8& pa0, bf16x8& pa1, bf16x8& pa2, bf16x8& pa3) {
  for (int r = 0; r < 16; ++r) p1[r] = __builtin_amdgcn_exp2f(p1[r]);
  float ps = 0; for (int r = 0; r < 16; ++r) ps += p0[r]; for (int r = 0; r < 16; ++r) ps += p1[r];
  { auto rr = __builtin_amdgcn_permlane32_swap(__float_as_uint(ps), __float_as_uint(ps), false, false);
    ps = __uint_as_float(rr[0]) + __uint_as_float(rr[1]); }
  l_reg = l_reg * alpha + ps;
#define PK4(P, BASE, OUT) do { unsigned a0 = cvtpk(P[BASE + 0], P[BASE + 1]), a1 = cvtpk(P[BASE + 2], P[BASE + 3]);   \
    unsigned b0 = cvtpk(P[BASE + 4], P[BASE + 5]), b1 = cvtpk(P[BASE + 6], P[BASE + 7]);                              \
    auto r0 = __builtin_amdgcn_permlane32_swap(a0, b0, false, false); auto r1 = __builtin_amdgcn_permlane32_swap(a1, b1, false, false); \
    u32x4 w = {r0[0], r1[0], r0[1], r1[1]}; OUT = *reinterpret_cast<bf16x8*>(&w); } while (0)
  PK4(p0, 0, pa0); PK4(p0, 8, pa1); PK4(p1, 0, pa2); PK4(p1, 8, pa3);
#undef PK4
}
__device__ __forceinline__ void qkt(f32x16& p0, f32x16& p1, const char* Ks, const bf16x8* qr, int r32, int hi) {
  p0 = f32x16{}; p1 = f32x16{};
  for (int d0 = 0; d0 < 8; ++d0) { int cb = (d0 * 16 + hi * 8) * 2;
    bf16x8 b0 = *reinterpret_cast<const bf16x8*>(Ks + KSWZ(r32, cb));
    bf16x8 b1 = *reinterpret_cast<const bf16x8*>(Ks + KSWZ(32 + r32, cb));
    p0 = __builtin_amdgcn_mfma_f32_32x32x16_bf16(b0, qr[d0], p0, 0, 0, 0);
    p1 = __builtin_amdgcn_mfma_f32_32x32x16_bf16(b1, qr[d0], p1, 0, 0, 0); }
}
__device__ __forceinline__ int v_st(int k, int c) { const int kk = (k & ~0xC) | ((k & 4) << 1) | ((k & 8) >> 1); return ((kk >> 3) * 4 + (c >> 5)) * 512 + ((kk & 7) * 32 + (c & 31)) * 2; }
__device__ __forceinline__ int v_rd_base(int lane) { return ((lane & 3) << 3) | (((lane >> 2) & 3) << 6) | (((lane >> 4) & 1) << 5) | (((lane >> 5) & 1) << 8); }
constexpr int v_rd_off(int d0, int ks, int half) { return d0 * 512 + ks * 4096 + half * 2048; }
template <int OFF> __device__ __forceinline__ s16x4 tr_read(int vb) {
  s16x4 r; asm volatile("ds_read_b64_tr_b16 %0, %1 offset:%2" : "=&v"(r) : "v"(vb), "i"(OFF) : "memory"); return r;
}
#define PKLH(L, H) (bf16x8){L[0], L[1], L[2], L[3], H[0], H[1], H[2], H[3]}
template <int D0> __device__ __forceinline__ void pv_one(f32x16& od, int vb, bf16x8 pa0, bf16x8 pa1, bf16x8 pa2, bf16x8 pa3) {
  const s16x4 l0 = tr_read<v_rd_off(D0, 0, 0)>(vb), h0 = tr_read<v_rd_off(D0, 0, 1)>(vb), l1 = tr_read<v_rd_off(D0, 1, 0)>(vb), h1 = tr_read<v_rd_off(D0, 1, 1)>(vb);
  const s16x4 l2 = tr_read<v_rd_off(D0, 2, 0)>(vb), h2 = tr_read<v_rd_off(D0, 2, 1)>(vb), l3 = tr_read<v_rd_off(D0, 3, 0)>(vb), h3 = tr_read<v_rd_off(D0, 3, 1)>(vb);
  asm volatile("s_waitcnt lgkmcnt(0)" ::: "memory"); SBAR();
  od = __builtin_amdgcn_mfma_f32_32x32x16_bf16(pa0, PKLH(l0, h0), od, 0, 0, 0);
  od = __builtin_amdgcn_mfma_f32_32x32x16_bf16(pa1, PKLH(l1, h1), od, 0, 0, 0);
  od = __builtin_amdgcn_mfma_f32_32x32x16_bf16(pa2, PKLH(l2, h2), od, 0, 0, 0);
  od = __builtin_amdgcn_mfma_f32_32x32x16_bf16(pa3, PKLH(l3, h3), od, 0, 0, 0);
}
__device__ __forceinline__ void pv_d0(f32x16* o, int vb, bf16x8 pa0, bf16x8 pa1, bf16x8 pa2, bf16x8 pa3) {
  pv_one<0>(o[0], vb, pa0, pa1, pa2, pa3); pv_one<1>(o[1], vb, pa0, pa1, pa2, pa3); pv_one<2>(o[2], vb, pa0, pa1, pa2, pa3); pv_one<3>(o[3], vb, pa0, pa1, pa2, pa3);
}
__device__ __forceinline__ void attn_dense_body(bf16_t* __restrict__ Qb, const bf16_t* __restrict__ Kh, const bf16_t* __restrict__ Vh, int seq, char* lds) {
  int tid_l = threadIdx.x; asm volatile("" : "+v"(tid_l)); const int tid = tid_l, wid = tid >> 6, lane = tid & 63, r32 = lane & 31, hi = lane >> 5;
  char* V_lds = lds; char* K_lds = lds + 2 * SHM_V;
  float* wsf = (float*)(lds + 2 * SHM_V + 2 * SHM_K) + wid * 64; float* li_l = wsf; float* al_l = wsf + 32;
  float m_reg = -1e30f, l_reg = 0; f32x16 o[4] = {}; bf16x8 qr[8];
  const bf16_t* Qw = Qb + (long)(wid * QBLK + r32) * LDQ + hi * 8;
#pragma unroll
  for (int d0 = 0; d0 < 8; ++d0) qr[d0] = *reinterpret_cast<const bf16x8*>(Qw + d0 * 16);
  const int sr = tid >> 4, sc = (tid & 15) * 8, vst0 = v_st(sr, sc), vst1 = v_st(32 + sr, sc);
  const int vb0 = (int)(uintptr_t)V_lds + v_rd_base(lane);
  struct { bf16x8 vs0, vs1, ks0, ks1; } sr_[1];
#define SLOAD(i, k0) do { sr_[i].vs0 = *reinterpret_cast<const bf16x8*>(&Vh[(long)((k0) + sr) * LDK + sc]); sr_[i].vs1 = *reinterpret_cast<const bf16x8*>(&Vh[(long)((k0) + 32 + sr) * LDK + sc]); \
    sr_[i].ks0 = *reinterpret_cast<const bf16x8*>(&Kh[(long)((k0) + sr) * LDK + sc]); sr_[i].ks1 = *reinterpret_cast<const bf16x8*>(&Kh[(long)((k0) + 32 + sr) * LDK + sc]); } while (0)
#define SWRITE(b, i) do { *(bf16x8*)(V_lds + (b) * SHM_V + vst0) = sr_[i].vs0;          \
    *(bf16x8*)(V_lds + (b) * SHM_V + vst1) = sr_[i].vs1; int kc = sc * 2;               \
    *(bf16x8*)(K_lds + (b) * SHM_K + KSWZ(sr, kc)) = sr_[i].ks0;                       \
    *(bf16x8*)(K_lds + (b) * SHM_K + KSWZ(32 + sr, kc)) = sr_[i].ks1; } while (0)
#define SWAIT() asm volatile("s_waitcnt vmcnt(0)" ::: "memory")
#define RESC(a) do { if (__any((a) < 1.f)) { if (hi == 0) al_l[r32] = (a); asm volatile("s_waitcnt lgkmcnt(0)" ::: "memory"); \
    for (int d = 0; d < 4; ++d) for (int r = 0; r < 16; ++r) o[d][r] *= al_l[crow(r, hi)]; } } while (0)
  f32x16 pA0, pA1, pB0, pB1; float mnA, mnB, alA, alB; bf16x8 pa0, pa1, pa2, pa3; const int NT = seq / KVBLK;
  constexpr int SE = 0, SO = 0;
  SLOAD(SE, 0); asm volatile("s_waitcnt vmcnt(0)" ::: "memory"); SWRITE(0, SE); __syncthreads();
  qkt(pA0, pA1, K_lds, qr, r32, hi); partialSM(pA0, pA1, m_reg, mnA, alA);
  SLOAD(SO, KVBLK);
  SWAIT(); SWRITE(1, SO); __syncthreads();
  for (int j = 1; j + 1 < NT; j += 2) {
    SBAR(); qkt(pB0, pB1, K_lds + SHM_K, qr, r32, hi);
    finishSM(pA0, pA1, alA, l_reg, pa0, pa1, pa2, pa3); SBAR();
    SLOAD(SO, (j + 1) * KVBLK); SBAR();
    pv_d0(o, vb0, pa0, pa1, pa2, pa3); partialSM(pB0, pB1, m_reg, mnB, alB);
    __syncthreads(); SWAIT(); SWRITE(0, SE);
    RESC(alB); __syncthreads();
    SBAR(); qkt(pA0, pA1, K_lds, qr, r32, hi);
    finishSM(pB0, pB1, alB, l_reg, pa0, pa1, pa2, pa3); SBAR();
    SLOAD(SE, (j + 2) * KVBLK); SBAR();
    pv_d0(o, vb0 + (int)SHM_V, pa0, pa1, pa2, pa3); partialSM(pA0, pA1, m_reg, mnA, alA);
    __syncthreads(); SWAIT(); SWRITE(1, SO);
    RESC(alA); __syncthreads();
  }
  SBAR(); qkt(pB0, pB1, K_lds + SHM_K, qr, r32, hi);
  finishSM(pA0, pA1, alA, l_reg, pa0, pa1, pa2, pa3); SBAR();
  pv_d0(o, vb0, pa0, pa1, pa2, pa3); partialSM(pB0, pB1, m_reg, mnB, alB);
  __syncthreads(); RESC(alB);
  finishSM(pB0, pB1, alB, l_reg, pa0, pa1, pa2, pa3); SBAR();
  pv_d0(o, vb0 + (int)SHM_V, pa0, pa1, pa2, pa3);
  if (hi == 0) li_l[r32] = l_reg; asm volatile("s_waitcnt lgkmcnt(0)" ::: "memory");
  float rli[16];
#pragma unroll
  for (int r = 0; r < 16; ++r) rli[r] = __builtin_amdgcn_rcpf(li_l[crow(r, hi)]);
  bf16_t* qo = Qb + (long)(wid * QBLK + 4 * hi) * LDQ + r32; const bf16_t* zo = qo + (long)((OFF_ZB - OFF_QB) / 2);
  unsigned short zz[64];
#pragma unroll
  for (int r = 0; r < 16; ++r) { const int ro = ((r & 3) + 8 * (r >> 2)) * LDQ;
    zz[4 * r] = zo[ro]; zz[4 * r + 1] = zo[ro + 32]; zz[4 * r + 2] = zo[ro + 64]; zz[4 * r + 3] = zo[ro + 96]; }
  asm volatile("" ::: "memory");
#pragma unroll
  for (int r = 0; r < 16; ++r) { const int ro = ((r & 3) + 8 * (r >> 2)) * LDQ;
    const float v0 = o[0][r] * rli[r] * bf2f(zz[4 * r]), v1 = o[1][r] * rli[r] * bf2f(zz[4 * r + 1]), v2 = o[2][r] * rli[r] * bf2f(zz[4 * r + 2]), v3 = o[3][r] * rli[r] * bf2f(zz[4 * r + 3]);
    qo[ro] = (bf16_t)(cvtpk(v0, v0) & 0xffffu); qo[ro + 32] = (bf16_t)(cvtpk(v1, v1) & 0xffffu); qo[ro + 64] = (bf16_t)(cvtpk(v2, v2) & 0xffffu); qo[ro + 96] = (bf16_t)(cvtpk(v3, v3) & 0xffffu); }
#undef SLOAD
#undef SWRITE
#undef SWAIT
#undef RESC
}
}

namespace ml {
using att::crow; using att::cvtpk; using att::v_st; using att::v_rd_base; using att::v_rd_off; using att::tr_read;
constexpr int O_QS = 0, O_KS = 17408, O_C0 = 34816, O_KTR = 69632, O_VTR = 86016, O_VW = 102400, O_SP = 118784, O_F = 128000;
constexpr int NCH = 132;
template <int KS> __device__ __forceinline__ bf16x8 trfrag(int vb) {
  const s16x4 l = tr_read<v_rd_off(0, KS, 0)>(vb), h = tr_read<v_rd_off(0, KS, 1)>(vb);
  asm volatile("s_waitcnt lgkmcnt(0)" ::: "memory"); SBAR();
  return PKLH(l, h);
}
__device__ __forceinline__ bf16x8 scale_frag(bf16x8 v, const float* we) {
  const u32x4 w = *reinterpret_cast<const u32x4*>(&v); float f[8]; unpack8(w, f);
  const float4 s0 = *(const float4*)we, s1 = *(const float4*)(we + 4);
  f[0] *= s0.x; f[1] *= s0.y; f[2] *= s0.z; f[3] *= s0.w; f[4] *= s1.x; f[5] *= s1.y; f[6] *= s1.z; f[7] *= s1.w;
  const u32x4 o = pack8(f); return *reinterpret_cast<const bf16x8*>(&o);
}
__device__ __forceinline__ int chunk_row0(int c, int b, bool rev) {
  if (!rev) return c < 4 ? M_TOK + b * CTXL + 64 * c : b * SEQ + 64 * (c - 4);
  return c < 4 ? M_TOK + b * CTXL + 64 * (3 - c) : b * SEQ + 64 * (131 - c);
}
__device__ __forceinline__ void gate_scan(float gi, float gf, float bi, float bfb, float& m0, float* S, int lane, int jn) {
  const float li = gi + bi, xf = gf + bfb; const float lf = fminf(xf, 0.f) - __logf(1.0f + __expf(-fabsf(xf)));
  float bb = lf;
#define DPP_F(x, old, ctrl, rmask, bc) __int_as_float(__builtin_amdgcn_update_dpp(__float_as_int(old), __float_as_int(x), ctrl, rmask, 0xf, bc))
  bb += DPP_F(bb, 0.f, 0x111, 0xf, true); bb += DPP_F(bb, 0.f, 0x112, 0xf, true); bb += DPP_F(bb, 0.f, 0x114, 0xf, true); bb += DPP_F(bb, 0.f, 0x118, 0xf, true);
  bb += DPP_F(bb, 0.f, 0x142, 0xa, true); bb += DPP_F(bb, 0.f, 0x143, 0xc, true);
  const float g = li - bb; float cm = g; const float NI = -3.0e38f;
  cm = fmaxf(cm, DPP_F(cm, NI, 0x111, 0xf, false)); cm = fmaxf(cm, DPP_F(cm, NI, 0x112, 0xf, false)); cm = fmaxf(cm, DPP_F(cm, NI, 0x114, 0xf, false)); cm = fmaxf(cm, DPP_F(cm, NI, 0x118, 0xf, false));
  cm = fmaxf(cm, DPP_F(cm, NI, 0x142, 0xa, false)); cm = fmaxf(cm, DPP_F(cm, NI, 0x143, 0xc, false));
#undef DPP_F
  const float Mx = fmaxf(m0, cm), m = bb + Mx, a = __expf(m0 - Mx), em = __expf(-m);
  const float bL = __int_as_float(__builtin_amdgcn_readlane(__float_as_int(bb), 63)), ML = __int_as_float(__builtin_amdgcn_readlane(__float_as_int(Mx), 63)), aend = __int_as_float(__builtin_amdgcn_readlane(__float_as_int(a), 63));
  S[jn] = g; S[64 + jn] = Mx; S[128 + jn] = a; S[192 + jn] = em; S[256 + jn] = __expf(g - ML); if (lane == 0) S[320] = aend;
  m0 = bL + ML;
}
__device__ void mlstm_scan(const Params& p, char* lds, int item) {
  int tid_l = threadIdx.x; asm volatile("" : "+v"(tid_l)); const int tid = tid_l, wid = __builtin_amdgcn_readfirstlane(tid >> 6), lane = tid & 63, r32 = lane & 31, hi = lane >> 5;
  const int dir = item & 1, vs = (item >> 1) & 1, bh = item >> 2, b = bh >> 3, h = bh & 7;
  const bool rev = dir != 0, flip = !rev;
  const bf16_t* QK = (const bf16_t*)(p.ws + OFF_QAKA); const bf16_t* VA = (const bf16_t*)(p.ws + OFF_VA); const float* GT = (const float*)(p.ws + OFF_GATES);
  bf16_t* H = (bf16_t*)(p.ws + (rev ? OFF_HB : OFF_HF));
  float* F = (float*)(lds + O_F); float *NQ = F + 768, *RS = F + 832, *N0 = F + 960, *GSL = F + 1088, *PN = F + 1216;
  for (int i = tid; i < 128 * 272 / 4; i += 512) ((unsigned*)(lds + O_C0))[i] = 0u;
  if (tid < 128) N0[tid] = 0.f;
  f32x16 cacc0 = {}, cacc1 = {}; f32x16 acc1 = {}; float nreg = 0.f, m0 = -1e30f, aend_prev = 0.f; bool npend = false;
  const float bi = p.in[7][dir * 16 + h], bfb = p.in[7][dir * 16 + 8 + h];
  const int qrow0 = tid >> 4, qc = (tid & 15) * 8;
  const int jnat = 63 - lane, jg = flip ? lane : jnat;
  bf16x8 q0, q1, k0, k1, v0, v1; float gi1 = 0.f, gf1 = 0.f;
  u32x2 hw0 = {0u, 0u}, hw1 = {0u, 0u}, hw2 = {0u, 0u}, hw3 = {0u, 0u}; bf16_t* hpend = nullptr;
  { const int R0 = chunk_row0(0, b, rev); const bf16_t* qp = QK + (size_t)(R0 + qrow0) * 2048 + h * 128 + qc; const bf16_t* vp = VA + (size_t)(R0 + qrow0) * 2048 + h * 256 + vs * 128 + qc;
    q0 = *(const bf16x8*)qp; q1 = *(const bf16x8*)(qp + 32 * 2048); k0 = *(const bf16x8*)(qp + 1024); k1 = *(const bf16x8*)(qp + 1024 + 32 * 2048);
    v0 = *(const bf16x8*)vp; v1 = *(const bf16x8*)(vp + 32 * 2048);
    if (wid == 0) { const float g0i = GT[(size_t)(R0 + jg) * 32 + dir * 16 + h], g0f = GT[(size_t)(R0 + jg) * 32 + dir * 16 + 8 + h];
      const int R1 = chunk_row0(1, b, rev); gi1 = GT[(size_t)(R1 + jg) * 32 + dir * 16 + h]; gf1 = GT[(size_t)(R1 + jg) * 32 + dir * 16 + 8 + h];
      gate_scan(g0i, g0f, bi, bfb, m0, F, lane, jnat); } }
  const int w4 = wid & 3, t_hi = w4 >> 1, t_lo = w4 & 1;
  const int vt = wid >> 1, jt = wid & 1;
  for (int c = 0; c < NCH; ++c) {
    const int R0 = chunk_row0(c, b, rev); const bool isctx = c < 4;
    float* S = F + (c & 1) * 384; float *G = S, *MX = S + 64, *A = S + 128, *EM = S + 192, *WE = S + 256;
    __syncthreads();
    { const int ra = flip ? 63 - qrow0 : qrow0, rb = flip ? 31 - qrow0 : qrow0 + 32;
    *(bf16x8*)(lds + O_QS + ra * 272 + qc * 2) = q0; *(bf16x8*)(lds + O_QS + rb * 272 + qc * 2) = q1;
    *(bf16x8*)(lds + O_KS + ra * 272 + qc * 2) = k0; *(bf16x8*)(lds + O_KS + rb * 272 + qc * 2) = k1;
    *(bf16x8*)(lds + O_KTR + v_st(ra, qc)) = k0; *(bf16x8*)(lds + O_KTR + v_st(rb, qc)) = k1;
    *(bf16x8*)(lds + O_VTR + v_st(ra, qc)) = v0; *(bf16x8*)(lds + O_VTR + v_st(rb, qc)) = v1;
    { const float wa = WE[ra], wb = WE[rb]; float f[8];
      unpack8(*reinterpret_cast<const u32x4*>(&v0), f);
#pragma unroll
      for (int e = 0; e < 8; ++e) f[e] *= wa;
      *(u32x4*)(lds + O_VW + v_st(ra, qc)) = pack8(f);
      unpack8(*reinterpret_cast<const u32x4*>(&v1), f);
#pragma unroll
      for (int e = 0; e < 8; ++e) f[e] *= wb;
      *(u32x4*)(lds + O_VW + v_st(rb, qc)) = pack8(f); } }
    if (hpend) { *(u32x2*)(hpend) = hw0; *(u32x2*)(hpend + 8) = hw1; *(u32x2*)(hpend + 16) = hw2; *(u32x2*)(hpend + 24) = hw3; hpend = nullptr; }
    if (npend && tid < 128) { nreg = aend_prev * nreg + ((PN[tid] + PN[128 + tid]) + (PN[256 + tid] + PN[384 + tid])); N0[tid] = nreg; }
    npend = true;
    if (wid == 0) { GSL[lane] = gi1; GSL[64 + lane] = gf1;
      if (c + 2 < NCH) { const int R2 = chunk_row0(c + 2, b, rev); gi1 = GT[(size_t)(R2 + jg) * 32 + dir * 16 + h]; gf1 = GT[(size_t)(R2 + jg) * 32 + dir * 16 + 8 + h]; } }
    if (c + 1 < NCH) { const int R1 = chunk_row0(c + 1, b, rev); const bf16_t* qp = QK + (size_t)(R1 + qrow0) * 2048 + h * 128 + qc; const bf16_t* vp = VA + (size_t)(R1 + qrow0) * 2048 + h * 256 + vs * 128 + qc;
      q0 = *(const bf16x8*)qp; q1 = *(const bf16x8*)(qp + 32 * 2048); k0 = *(const bf16x8*)(qp + 1024); k1 = *(const bf16x8*)(qp + 1024 + 32 * 2048);
      v0 = *(const bf16x8*)vp; v1 = *(const bf16x8*)(vp + 32 * 2048); }
    __syncthreads();
    if (wid < 4) {
      f32x16 pS = {};
      const char* ka = lds + O_KS + (32 * t_hi + r32) * 272 + hi * 16; const char* qb = lds + O_QS + (32 * t_lo + r32) * 272 + hi * 16;
#pragma unroll
      for (int d0 = 0; d0 < 8; ++d0) pS = __builtin_amdgcn_mfma_f32_32x32x16_bf16(*(const bf16x8*)(ka + d0 * 32), *(const bf16x8*)(qb + d0 * 32), pS, 0, 0, 0);
      const int j = 32 * t_lo + r32; const float mxj = MX[j]; float ps = 0.f;
#pragma unroll
      for (int r = 0; r < 16; ++r) { const int s = 32 * t_hi + crow(r, hi); const bool ok = (s >= j);
        const float arg = ok ? (G[s] - mxj) : -1e30f; const float wv = __builtin_amdgcn_exp2f(arg * 1.4426950408889634f); pS[r] *= wv; ps += pS[r]; }
      ps += __shfl_xor(ps, 32); if (hi == 0) RS[t_hi * 64 + j] = ps;
#pragma unroll
      for (int g4 = 0; g4 < 4; ++g4) { u32x2 w; w.x = cvtpk(pS[4 * g4], pS[4 * g4 + 1]); w.y = cvtpk(pS[4 * g4 + 2], pS[4 * g4 + 3]);
        *(u32x2*)(lds + O_SP + j * 144 + (32 * t_hi + 8 * g4 + 4 * hi) * 2) = w; }
    } else {
      const int t4 = tid - 256, jq = t4 >> 2, part = t4 & 3; float sum = 0.f;
      const char* qrow = lds + O_QS + jq * 272 + part * 64;
#pragma unroll
      for (int i = 0; i < 4; ++i) { float f[8]; unpack8(*(const u32x4*)(qrow + 16 * i), f);
#pragma unroll
        for (int e = 0; e < 8; ++e) sum += f[e] * N0[part * 32 + 8 * i + e]; }
      sum += __shfl_xor(sum, 1); sum += __shfl_xor(sum, 2); if (part == 0) NQ[jq] = sum;
    }
    { acc1 = f32x16{};
      const char* ca = lds + O_C0 + (32 * vt + r32) * 272 + hi * 16; const char* qb = lds + O_QS + (32 * jt + r32) * 272 + hi * 16;
#pragma unroll
      for (int d0 = 0; d0 < 8; ++d0) acc1 = __builtin_amdgcn_mfma_f32_32x32x16_bf16(*(const bf16x8*)(ca + d0 * 32), *(const bf16x8*)(qb + d0 * 32), acc1, 0, 0, 0); }
    __syncthreads();
    const float aend = S[320];
    if (wid == 0 && c + 1 < NCH) gate_scan(GSL[lane], GSL[64 + lane], bi, bfb, m0, F + ((c + 1) & 1) * 384, lane, jnat);
    {
      f32x16 acc2 = {};
      const int vbv = (int)(uintptr_t)(lds + O_VTR) + v_rd_base(lane) + vt * 512;
      const char* sb = lds + O_SP + (32 * jt + r32) * 144 + hi * 16;
      const s16x4 l0 = tr_read<v_rd_off(0, 0, 0)>(vbv), h0 = tr_read<v_rd_off(0, 0, 1)>(vbv), l1 = tr_read<v_rd_off(0, 1, 0)>(vbv), h1 = tr_read<v_rd_off(0, 1, 1)>(vbv);
      const s16x4 l2 = tr_read<v_rd_off(0, 2, 0)>(vbv), h2 = tr_read<v_rd_off(0, 2, 1)>(vbv), l3 = tr_read<v_rd_off(0, 3, 0)>(vbv), h3 = tr_read<v_rd_off(0, 3, 1)>(vbv);
      const bf16x8 s0 = *(const bf16x8*)(sb), s1 = *(const bf16x8*)(sb + 32), s2 = *(const bf16x8*)(sb + 64), s3 = *(const bf16x8*)(sb + 96);
      asm volatile("s_waitcnt lgkmcnt(0)" ::: "memory"); SBAR();
      acc2 = __builtin_amdgcn_mfma_f32_32x32x16_bf16(PKLH(l0, h0), s0, acc2, 0, 0, 0);
      acc2 = __builtin_amdgcn_mfma_f32_32x32x16_bf16(PKLH(l1, h1), s1, acc2, 0, 0, 0);
      acc2 = __builtin_amdgcn_mfma_f32_32x32x16_bf16(PKLH(l2, h2), s2, acc2, 0, 0, 0);
      acc2 = __builtin_amdgcn_mfma_f32_32x32x16_bf16(PKLH(l3, h3), s3, acc2, 0, 0, 0);
      const int j = 32 * jt + r32; const float aj = A[j]; const float den = aj * NQ[j] + RS[j] + RS[64 + j];
      const float inv = 1.0f / fmaxf(fabsf(den), EM[j]);
      if (!isctx) { hpend = H + (size_t)(R0 + (flip ? 63 - j : j)) * 2048 + h * 256 + vs * 128 + 32 * vt + 4 * hi;
#define HPK(g4) (u32x2){cvtpk((aj * acc1[4 * g4] + acc2[4 * g4]) * inv, (aj * acc1[4 * g4 + 1] + acc2[4 * g4 + 1]) * inv), cvtpk((aj * acc1[4 * g4 + 2] + acc2[4 * g4 + 2]) * inv, (aj * acc1[4 * g4 + 3] + acc2[4 * g4 + 3]) * inv)}
        hw0 = HPK(0); hw1 = HPK(1); hw2 = HPK(2); hw3 = HPK(3);
#undef HPK
      }
    }
    { const int d = tid & 127, q4 = tid >> 7; float s = 0.f;
#pragma unroll
      for (int si = 0; si < 16; ++si) s += WE[16 * q4 + si] * bf2f(*(const bf16_t*)(lds + O_KS + (16 * q4 + si) * 272 + d * 2));
      PN[q4 * 128 + d] = s; }
    aend_prev = aend;
    { const int dt = wid & 3, vp2 = (wid >> 2) * 2;
      const int kb = (int)(uintptr_t)(lds + O_KTR) + v_rd_base(lane) + dt * 512;
      const int vb2 = (int)(uintptr_t)(lds + O_VW) + v_rd_base(lane) + vp2 * 512;
      const s16x4 kl0 = tr_read<v_rd_off(0, 0, 0)>(kb), kh0 = tr_read<v_rd_off(0, 0, 1)>(kb), kl1 = tr_read<v_rd_off(0, 1, 0)>(kb), kh1 = tr_read<v_rd_off(0, 1, 1)>(kb);
      const s16x4 kl2 = tr_read<v_rd_off(0, 2, 0)>(kb), kh2 = tr_read<v_rd_off(0, 2, 1)>(kb), kl3 = tr_read<v_rd_off(0, 3, 0)>(kb), kh3 = tr_read<v_rd_off(0, 3, 1)>(kb);
      const s16x4 vl0 = tr_read<v_rd_off(0, 0, 0)>(vb2), vh0 = tr_read<v_rd_off(0, 0, 1)>(vb2), vl1 = tr_read<v_rd_off(0, 1, 0)>(vb2), vh1 = tr_read<v_rd_off(0, 1, 1)>(vb2);
      const s16x4 vl2 = tr_read<v_rd_off(0, 2, 0)>(vb2), vh2 = tr_read<v_rd_off(0, 2, 1)>(vb2), vl3 = tr_read<v_rd_off(0, 3, 0)>(vb2), vh3 = tr_read<v_rd_off(0, 3, 1)>(vb2);
      const s16x4 wl0 = tr_read<v_rd_off(1, 0, 0)>(vb2), wh0 = tr_read<v_rd_off(1, 0, 1)>(vb2), wl1 = tr_read<v_rd_off(1, 1, 0)>(vb2), wh1 = tr_read<v_rd_off(1, 1, 1)>(vb2);
      const s16x4 wl2 = tr_read<v_rd_off(1, 2, 0)>(vb2), wh2 = tr_read<v_rd_off(1, 2, 1)>(vb2), wl3 = tr_read<v_rd_off(1, 3, 0)>(vb2), wh3 = tr_read<v_rd_off(1, 3, 1)>(vb2);
      asm volatile("s_waitcnt lgkmcnt(0)" ::: "memory"); SBAR();
#pragma unroll
      for (int r = 0; r < 16; ++r) { cacc0[r] *= aend; cacc1[r] *= aend; }
      const bf16x8 ka0 = PKLH(kl0, kh0), ka1 = PKLH(kl1, kh1), ka2 = PKLH(kl2, kh2), ka3 = PKLH(kl3, kh3);
      cacc0 = __builtin_amdgcn_mfma_f32_32x32x16_bf16(ka0, PKLH(vl0, vh0), cacc0, 0, 0, 0);
      cacc1 = __builtin_amdgcn_mfma_f32_32x32x16_bf16(ka0, PKLH(wl0, wh0), cacc1, 0, 0, 0);
      cacc0 = __builtin_amdgcn_mfma_f32_32x32x16_bf16(ka1, PKLH(vl1, vh1), cacc0, 0, 0, 0);
      cacc1 = __builtin_amdgcn_mfma_f32_32x32x16_bf16(ka1, PKLH(wl1, wh1), cacc1, 0, 0, 0);
      cacc0 = __builtin_amdgcn_mfma_f32_32x32x16_bf16(ka2, PKLH(vl2, vh2), cacc0, 0, 0, 0);
      cacc1 = __builtin_amdgcn_mfma_f32_32x32x16_bf16(ka2, PKLH(wl2, wh2), cacc1, 0, 0, 0);
      cacc0 = __builtin_amdgcn_mfma_f32_32x32x16_bf16(ka3, PKLH(vl3, vh3), cacc0, 0, 0, 0);
      cacc1 = __builtin_amdgcn_mfma_f32_32x32x16_bf16(ka3, PKLH(wl3, wh3), cacc1, 0, 0, 0);
#pragma unroll
      for (int g4 = 0; g4 < 4; ++g4) { u32x2 w; w.x = cvtpk(cacc0[4 * g4], cacc0[4 * g4 + 1]); w.y = cvtpk(cacc0[4 * g4 + 2], cacc0[4 * g4 + 3]);
        *(u32x2*)(lds + O_C0 + (32 * vp2 + r32) * 272 + (32 * dt + 8 * g4 + 4 * hi) * 2) = w;
        u32x2 x; x.x = cvtpk(cacc1[4 * g4], cacc1[4 * g4 + 1]); x.y = cvtpk(cacc1[4 * g4 + 2], cacc1[4 * g4 + 3]);
        *(u32x2*)(lds + O_C0 + (32 * vp2 + 32 + r32) * 272 + (32 * dt + 8 * g4 + 4 * hi) * 2) = x; }
    }
  }
  if (hpend) { *(u32x2*)(hpend) = hw0; *(u32x2*)(hpend + 8) = hw1; *(u32x2*)(hpend + 16) = hw2; *(u32x2*)(hpend + 24) = hw3; }
  __syncthreads();
}
}

__device__ void phase4_mixers(const Params& p, char* lds) {
  bf16_t* QB = (bf16_t*)(p.ws + OFF_QB);
  const bf16_t* KA = (const bf16_t*)(p.ws + OFF_KALL); const bf16_t* VAl = (const bf16_t*)(p.ws + OFF_VALL);
  const bool sched = gridDim.x == 256; const int bx = blockIdx.x;
  for (int item = bx; item < 128; item += gridDim.x) ml::mlstm_scan(p, lds, item);
  const int nslots = sched ? 9 : (2048 + (int)gridDim.x - 1) / (int)gridDim.x;
  for (int sl = (sched && bx < 128) ? 2 : 0; sl < nslots; ++sl) {
    int i;
    if (sched) i = sl < 2 ? sl * 128 + (bx - 128) : 256 + (sl - 2) * 256 + (bx < 128 ? 128 + bx : bx - 128);
    else { i = sl * (int)gridDim.x + bx; if (i >= 2048) break; }
    const int g = i >> 7, b = g >> 2, kvh = g & 3, hq = kvh * 4 + ((i >> 5) & 3), qb = i & 31;
    const size_t qoff = (size_t)(b * SEQ + qb * 256) * 2048 + hq * 128, koff = (size_t)b * SKV * 512 + kvh * 128;
    att::attn_dense_body(QB + qoff, KA + koff, VAl + koff, SKV, lds);
    __syncthreads();
  }
}

#define GRID_SYNC() do { asm volatile("s_waitcnt vmcnt(0) lgkmcnt(0)" ::: "memory"); grid.sync(); } while (0)
__global__ void __launch_bounds__(512, 2) fwd_megakernel(Params p) {
  extern __shared__ __attribute__((aligned(16))) unsigned char lds[];
  cg::grid_group grid = cg::this_grid();
  unsigned char* ws = p.ws;
  PG8_LAS unsigned char* lds3 = (PG8_LAS unsigned char*)lds;
  phase0_prep(p, lds);
  GRID_SYNC();
  phase1_ln_mod(p);
  GRID_SYNC();
  { pg8::Gemm g{(const bf16_t*)(ws + OFF_U), (const bf16_t*)(ws + OFF_WT_IN), M_ALL, N1P, 2048}; InProjOrder S; S.init((int)gridDim.x, (int)blockIdx.x);
    Epi1 E{ws, (unsigned char*)p.out}; pg8::gemm_phase<Epi1, InProjOrder, true, true>(lds3, g, S, E); }
  GRID_SYNC();
  phase3_elem(p);
  GRID_SYNC();
  phase4_mixers(p, (char*)lds);
  GRID_SYNC();
  phase5_gate(p);
  GRID_SYNC();
  { pg8::Gemm g{(const bf16_t*)(ws + OFF_OZ), (const bf16_t*)(ws + OFF_WT_BA), M_TOK, 2048, 2048}; pg8::StaticOrder S; S.init(M_TOK, 2048, (int)gridDim.x, (int)blockIdx.x);
    Epi2a E{(bf16_t*)(ws + OFF_TMP), (const bf16_t*)p.out}; pg8::gemm_phase<Epi2a, pg8::StaticOrder, true, true>(lds3, g, S, E); }
  __syncthreads();
  { pg8::Gemm g{(const bf16_t*)(ws + OFF_QB), (const bf16_t*)(ws + OFF_WT_BB), M_TOK, 2048, 2048}; pg8::StaticOrder S; S.init(M_TOK, 2048, (int)gridDim.x, (int)blockIdx.x);
    Epi2b E{(const bf16_t*)(ws + OFF_TMP), (const bf16_t*)p.out + (size_t)M_TOK * 2048, (bf16_t*)(ws + OFF_MERGED)}; pg8::gemm_phase<Epi2b, pg8::StaticOrder, true, true>(lds3, g, S, E); }
  GRID_SYNC();
  { pg8::Gemm g{(const bf16_t*)(ws + OFF_MERGED), (const bf16_t*)(ws + OFF_WT_OUT), M_TOK, 2048, 2048}; pg8::StaticOrder S; S.init(M_TOK, 2048, (int)gridDim.x, (int)blockIdx.x);
    Epi3 E{p.in[0], (const float*)(ws + OFF_MOD), p.out}; pg8::gemm_phase<Epi3, pg8::StaticOrder, true, true>(lds3, g, S, E); }
  GRID_SYNC();
  phase8_final_ln(p);
}

extern "C" void kernel_launch(void* const* d_in, const int* in_sizes, int n_in, void* d_out, int out_size, void* d_ws, size_t ws_size, hipStream_t stream) {
  static int grid_blocks = 0;
  if (!grid_blocks) {
    if (n_in != 18 || out_size != M_TOK * DM || ws_size < WS_END) { fprintf(stderr, "kernel_launch: unexpected shapes (n_in %d out %d ws %zu need %zu)\n", n_in, out_size, ws_size, (size_t)WS_END); grid_blocks = -1; return; }
    int dev = 0, cus = 0, per_cu = 0;
    (void)hipGetDevice(&dev);
    (void)hipDeviceGetAttribute(&cus, hipDeviceAttributeMultiprocessorCount, dev);
    (void)hipFuncSetAttribute((const void*)fwd_megakernel, hipFuncAttributeMaxDynamicSharedMemorySize, LDS_BYTES);
    (void)hipOccupancyMaxActiveBlocksPerMultiprocessor(&per_cu, fwd_megakernel, 512, LDS_BYTES);
    if (per_cu < 1) per_cu = 1;
    grid_blocks = cus * per_cu;
  }
  if (grid_blocks < 0) return;
  Params p{};
  for (int i = 0; i < 18; ++i) p.in[i] = (const float*)d_in[i];
  p.out = (float*)d_out; p.ws = (unsigned char*)d_ws;
  void* args[] = {&p};
  hipError_t e = hipLaunchCooperativeKernel((void*)fwd_megakernel, dim3(grid_blocks), dim3(512), args, LDS_BYTES, stream);
  if (e != hipSuccess) fprintf(stderr, "cooperative launch failed: %s (grid %d)\n", hipGetErrorString(e), grid_blocks);
}
```
